# Optimizing an MI355X kernel written in HIP

```python
import math
import jax, jax.numpy as jnp
from jax import lax
import numpy as np

D_MODEL = 1024
BATCH = 16
SEQ = 2048
DEPTH = 2
DEC_BATCH = 32
DEC_SEQ = 32
PAST_LEN = 1024

CHUNK = 64
N_EVEN = (DEPTH + 1) // 2
N_ODD = DEPTH // 2
D_MIX = D_MODEL
D_FF = 2816
EPS = 1e-6

A_HEADS = 4
A_KEY = 128
A_VAL = 128
A_WIDTH = A_HEADS * A_VAL
HGRN_BLOCK = 64
B_GROUP_DIM = 16
B_WIDTH = D_MIX - A_WIDTH
B_GROUPS = B_WIDTH // B_GROUP_DIM
B_STATE = 64
DT_MIN = 1e-3
DT_MAX = 1e-1
LAMBDA_RE_CEIL = -1e-4
C_CHUNK = 128
C_WIDTH = 512
C_GROUPS = 4
C_GROUP_DIM = C_WIDTH // C_GROUPS
D_HEADS = 8
Q_LORA = 256
KV_LORA = 128
NOPE_DIM = 64
ROPE_DIM = 32
V_DIM = 64
QK_DIM = NOPE_DIM + ROPE_DIM
D_WIDTH = D_HEADS * V_DIM
ROPE_BASE = 10000.0
Q_BLOCK = 128

A_QK = A_HEADS * A_KEY
AB_IN = 2 * A_QK + 2 * A_WIDTH + B_WIDTH
AB_SPLITS = [A_QK, 2 * A_QK, 2 * A_QK + A_WIDTH, 2 * A_QK + 2 * A_WIDTH]
CD_IN = 2 * C_WIDTH + Q_LORA + KV_LORA + ROPE_DIM
CD_SPLITS = [C_WIDTH, 2 * C_WIDTH, 2 * C_WIDTH + Q_LORA, 2 * C_WIDTH + Q_LORA + KV_LORA]

kernel_name = "hybrid_streaming_encoder_step"


def rmsnorm(x, g):
    xf = x.astype(jnp.float32)
    y = xf * lax.rsqrt(jnp.mean(xf * xf, axis=-1, keepdims=True) + EPS)
    return y.astype(x.dtype) * g


def swiglu(h, w_gate, w_up, w_down):
    return (jax.nn.silu(h @ w_gate) * (h @ w_up)) @ w_down


def _hgrn2_block(S, blk):
    q, k, v, logf = blk
    L = q.shape[2]
    b = jnp.cumsum(logf, axis=2)
    causal = jnp.tril(jnp.ones((L, L), dtype=bool))[:, :, None]
    diff = b[:, :, :, None, :] - b[:, :, None, :, :]
    decay = jnp.exp(jnp.where(causal, diff, -jnp.inf))
    att = jnp.einsum('bhtsn,bhsn->bhts', q[:, :, :, None, :] * decay, k)
    o = jnp.einsum('bhts,bhsv->bhtv', att, v) + jnp.einsum('bhtn,bhnv->bhtv', q * jnp.exp(b), S)
    b_end = b[:, :, -1:, :]
    S_new = jnp.exp(b_end[:, :, 0, :, None]) * S + jnp.einsum('bhsn,bhsv->bhnv', k * jnp.exp(b_end - b), v)
    return S_new, o


def hgrn2_mix(q, fz, iv, gz, S0, lb, out_g):
    Bsz, T, _ = q.shape
    L = min(HGRN_BLOCK, T)
    nc = T // L
    f = lb + (1.0 - lb) * jax.nn.sigmoid(fz.astype(jnp.float32))

    def to_blocks(t, d):
        return t.astype(jnp.float32).reshape(Bsz, nc, L, A_HEADS, d).transpose(1, 0, 3, 2, 4)

    S_T, o = lax.scan(_hgrn2_block, S0.astype(jnp.float32),
                      (to_blocks(q, A_KEY), to_blocks(1.0 - f, A_KEY),
                       to_blocks(iv, A_VAL), to_blocks(jnp.log(f), A_KEY)))
    o = o.transpose(1, 0, 3, 2, 4).reshape(Bsz, T, A_HEADS, A_VAL)
    gate = jax.nn.sigmoid(gz.astype(jnp.float32)).reshape(Bsz, T, A_HEADS, A_VAL)
    y = rmsnorm(o, out_g) * gate
    return y.reshape(Bsz, T, A_WIDTH).astype(q.dtype), S_T


def _ssm_combine(e1, e2):
    a1, b1 = e1
    a2, b2 = e2
    return a2 * a1, a2 * b1 + b2


def s5_mix(u, x0_re, x0_im, lam_re, lam_im, log_dt, b_re, b_im, c_re, c_im, d, w_glu, b_glu):
    Bsz, T, _ = u.shape
    f32 = jnp.float32
    ug = u.astype(f32).reshape(Bsz, T, B_GROUPS, B_GROUP_DIM)
    lam = lax.complex(jnp.minimum(lam_re.astype(f32), LAMBDA_RE_CEIL), lam_im.astype(f32))
    dt = jnp.exp(log_dt.astype(f32))[:, None]
    lam_bar = jnp.exp(lam * dt)
    b_bar = ((lam_bar - 1.0) / lam)[:, :, None] * lax.complex(b_re.astype(f32), b_im.astype(f32))
    bu = jnp.einsum('gph,btgh->tbgp', b_bar, ug.astype(jnp.complex64))
    x0 = lax.complex(x0_re.astype(f32), x0_im.astype(f32))
    bu = bu.at[0].add(lam_bar * x0)
    a = jnp.broadcast_to(lam_bar, (T, 1, B_GROUPS, B_STATE))
    _, xs = lax.associative_scan(_ssm_combine, (a, bu), axis=0)
    y = (jnp.einsum('ghp,tbgp->btgh', c_re.astype(f32), xs.real)
         - jnp.einsum('ghp,tbgp->btgh', c_im.astype(f32), xs.imag)
         + d.astype(f32) * ug)
    z = jax.nn.gelu(y.reshape(Bsz, T, B_WIDTH))
    out = z * jax.nn.sigmoid(z @ w_glu.astype(f32) + b_glu.astype(f32))
    x_T = xs[-1]
    return out.astype(u.dtype), x_T.real, x_T.imag


def gmlp_mix(u, v, v_norm, w_s, b_s):
    Bsz, T, _ = v.shape
    L = min(T, C_CHUNK)
    vn = rmsnorm(v, v_norm)
    vc = vn.reshape(Bsz, T // L, L, C_GROUPS, C_GROUP_DIM)
    ws = jnp.tril(w_s[:, :L, :L])
    s = jnp.einsum('gts,bcsgd->bctgd', ws, vc) + b_s[:, :L].T[:, :, None]
    return u * s.reshape(Bsz, T, C_WIDTH), vn[:, T - L:]


def rope_cos_sin(pos):
    half = ROPE_DIM // 2
    inv = ROPE_BASE ** (-jnp.arange(half, dtype=jnp.float32) / half)
    ang = pos.astype(jnp.float32)[:, None] * inv[None, :]
    return jnp.cos(ang), jnp.sin(ang)


def apply_rope(x, cos, sin):
    half = ROPE_DIM // 2
    x1, x2 = x[..., :half], x[..., half:]
    cos = cos.astype(x.dtype)
    sin = sin.astype(x.dtype)
    return jnp.concatenate([x1 * cos - x2 * sin, x1 * sin + x2 * cos], axis=-1)


def attend(q, k, v, qpos, kpos):
    s = jnp.einsum('bqhd,bkhd->bhqk', q, k).astype(jnp.float32) * (QK_DIM ** -0.5)
    visible = (kpos[None, :] // CHUNK) <= (qpos[:, None] // CHUNK)
    p = jax.nn.softmax(jnp.where(visible, s, -jnp.inf), axis=-1).astype(v.dtype)
    return jnp.einsum('bhqk,bkhd->bqhd', p, v)


def attend_query_blocks(q, k, v, qpos, kpos):
    Bsz, T, H, Dq = q.shape
    nb = T // Q_BLOCK
    qb = q.reshape(Bsz, nb, Q_BLOCK, H, Dq).transpose(1, 0, 2, 3, 4)
    pb = qpos.reshape(nb, Q_BLOCK)
    o = lax.map(lambda blk: attend(blk[0], k, v, blk[1], kpos), (qb, pb))
    return o.transpose(1, 0, 2, 3, 4).reshape(Bsz, T, H, V_DIM)


def mla_mix(cq_lin, ckv_lin, kpe_lin, pos, past_ckv, past_kpe,
            q_norm, w_uq, kv_norm, w_ukv, q_gain, k_gain):
    Bsz, T, _ = cq_lin.shape
    cos, sin = rope_cos_sin(pos)
    q = (rmsnorm(cq_lin, q_norm) @ w_uq).reshape(Bsz, T, D_HEADS, QK_DIM)
    q = jnp.concatenate([q[..., :NOPE_DIM],
                         apply_rope(q[..., NOPE_DIM:], cos[:, None], sin[:, None])], axis=-1)
    q = rmsnorm(q, q_gain)
    ckv = rmsnorm(ckv_lin, kv_norm)
    kpe = apply_rope(kpe_lin, cos, sin)
    if past_ckv is None:
        ckv_all, kpe_all, kpos = ckv, kpe, pos
    else:
        n_past = past_ckv.shape[1]
        ckv_all = jnp.concatenate([past_ckv.astype(ckv.dtype), ckv], axis=1)
        kpe_all = jnp.concatenate([past_kpe.astype(kpe.dtype), kpe], axis=1)
        kpos = jnp.concatenate([jnp.arange(n_past, dtype=pos.dtype), pos])
    S = ckv_all.shape[1]
    kv = (ckv_all @ w_ukv).reshape(Bsz, S, D_HEADS, NOPE_DIM + V_DIM)
    k = jnp.concatenate([kv[..., :NOPE_DIM],
                         jnp.broadcast_to(kpe_all[:, :, None, :], (Bsz, S, D_HEADS, ROPE_DIM))], axis=-1)
    k = rmsnorm(k, k_gain)
    v = kv[..., NOPE_DIM:]
    if past_ckv is None:
        o = attend_query_blocks(q, k, v, pos, kpos)
    else:
        o = attend(q, k, v, pos, kpos)
    return o.reshape(Bsz, T, D_WIDTH), ckv, kpe


def trunk(x, pos, w, past):
    Bsz = x.shape[0]
    lb_all = jnp.cumsum(jax.nn.softmax(w['hgrn_lb_logits'].astype(jnp.float32), axis=0), axis=0)
    hgrn_new, s5re_new, s5im_new, gv_new, ckv_new, kpe_new = [], [], [], [], [], []
    for l in range(DEPTH):
        j = l // 2
        x = x + 0.5 * swiglu(rmsnorm(x, w['ffn1_norm'][l]), w['ffn1_w_gate'][l], w['ffn1_w_up'][l], w['ffn1_w_down'][l])
        h = rmsnorm(x, w['mix_norm'][l])
        if l % 2 == 0:
            q, fz, iv, gz, u = jnp.split(h @ w['ab_w_in'][j], AB_SPLITS, axis=-1)
            if past is None:
                S0 = jnp.zeros((Bsz, A_HEADS, A_KEY, A_VAL), jnp.float32)
                x0_re = jnp.zeros((Bsz, B_GROUPS, B_STATE), jnp.float32)
                x0_im = jnp.zeros((Bsz, B_GROUPS, B_STATE), jnp.float32)
            else:
                S0, x0_re, x0_im = past[0][j], past[1][j], past[2][j]
            a_out, S_T = hgrn2_mix(q, fz, iv, gz, S0, lb_all[l], w['hgrn_out_norm'][j])
            b_out, xr, xi = s5_mix(u, x0_re, x0_im, w['s5_lambda_re'][j], w['s5_lambda_im'][j], w['s5_log_dt'][j],
                                   w['s5_b_re'][j], w['s5_b_im'][j], w['s5_c_re'][j], w['s5_c_im'][j],
                                   w['s5_d'][j], w['s5_w_glu'][j], w['s5_b_glu'][j])
            mixed = jnp.concatenate([a_out, b_out], axis=-1) @ w['ab_w_out'][j]
            hgrn_new.append(S_T)
            s5re_new.append(xr)
            s5im_new.append(xi)
        else:
            uc, vc, cq, ckv_lin, kpe_lin = jnp.split(h @ w['cd_w_in'][j], CD_SPLITS, axis=-1)
            c_out, v_rows = gmlp_mix(jax.nn.gelu(uc), jax.nn.gelu(vc), w['gmlp_v_norm'][j],
                                     w['gmlp_w_s'][j], w['gmlp_b_s'][j])
            if past is None:
                past_ckv, past_kpe = None, None
            else:
                past_ckv, past_kpe = past[3][j], past[4][j]
            d_out, ckv, kpe = mla_mix(cq, ckv_lin, kpe_lin, pos, past_ckv, past_kpe,
                                      w['mla_q_norm'][j], w['mla_w_uq'][j], w['mla_kv_norm'][j],
                                      w['mla_w_ukv'][j], w['mla_q_gain'][j], w['mla_k_gain'][j])
            mixed = jnp.concatenate([c_out, d_out], axis=-1) @ w['cd_w_out'][j]
            gv_new.append(v_rows)
            ckv_new.append(ckv)
            kpe_new.append(kpe)
        x = x + mixed
        x = x + 0.5 * swiglu(rmsnorm(x, w['ffn2_norm'][l]), w['ffn2_w_gate'][l], w['ffn2_w_up'][l], w['ffn2_w_down'][l])
    return x, (jnp.stack(hgrn_new), jnp.stack(s5re_new), jnp.stack(s5im_new),
               jnp.stack(gv_new), jnp.stack(ckv_new), jnp.stack(kpe_new))


def setup_inputs(seed: int = 0) -> dict:
    key = jax.random.key(seed)
    keys = jax.random.split(key, 64)
    counter = [0]

    def nk():
        counter[0] += 1
        return keys[counter[0] - 1]

    def nrm(shape, scale=1.0):
        return scale * jax.random.normal(nk(), shape, jnp.float32)

    def gain(shape):
        return 1.0 + 0.01 * jax.random.normal(nk(), shape, jnp.float32)

    inp = {}
    inp['x_prompt'] = nrm((BATCH, SEQ, D_MODEL))
    inp['x_sample'] = nrm((DEC_BATCH, DEC_SEQ, D_MODEL))
    inp['state_hgrn'] = nrm((N_EVEN, DEC_BATCH, A_HEADS, A_KEY, A_VAL), 0.5)
    inp['state_s5_re'] = nrm((N_EVEN, DEC_BATCH, B_GROUPS, B_STATE), 0.1)
    inp['state_s5_im'] = nrm((N_EVEN, DEC_BATCH, B_GROUPS, B_STATE), 0.1)
    inp['cache_mla_ckv'] = nrm((N_ODD, DEC_BATCH, PAST_LEN, KV_LORA))
    inp['cache_mla_kpe'] = nrm((N_ODD, DEC_BATCH, PAST_LEN, ROPE_DIM))
    inp['ffn1_norm'] = gain((DEPTH, D_MODEL))
    inp['ffn1_w_gate'] = nrm((DEPTH, D_MODEL, D_FF), D_MODEL ** -0.5)
    inp['ffn1_w_up'] = nrm((DEPTH, D_MODEL, D_FF), D_MODEL ** -0.5)
    inp['ffn1_w_down'] = nrm((DEPTH, D_FF, D_MODEL), D_FF ** -0.5)
    inp['mix_norm'] = gain((DEPTH, D_MODEL))
    inp['ffn2_norm'] = gain((DEPTH, D_MODEL))
    inp['ffn2_w_gate'] = nrm((DEPTH, D_MODEL, D_FF), D_MODEL ** -0.5)
    inp['ffn2_w_up'] = nrm((DEPTH, D_MODEL, D_FF), D_MODEL ** -0.5)
    inp['ffn2_w_down'] = nrm((DEPTH, D_FF, D_MODEL), D_FF ** -0.5)
    inp['ab_w_in'] = nrm((N_EVEN, D_MODEL, AB_IN), D_MODEL ** -0.5)
    inp['hgrn_lb_logits'] = nrm((DEPTH + 1, A_QK), 0.5)
    inp['hgrn_out_norm'] = gain((N_EVEN, A_VAL))
    inp['s5_lambda_re'] = -0.5 + nrm((N_EVEN, B_GROUPS, B_STATE), 0.01)
    inp['s5_lambda_im'] = (jnp.broadcast_to(jnp.pi * jnp.arange(B_STATE, dtype=jnp.float32), (N_EVEN, B_GROUPS, B_STATE))
                           + nrm((N_EVEN, B_GROUPS, B_STATE), 0.01))
    inp['s5_log_dt'] = jax.random.uniform(nk(), (N_EVEN, B_GROUPS), jnp.float32,
                                          minval=math.log(DT_MIN), maxval=math.log(DT_MAX))
    inp['s5_b_re'] = nrm((N_EVEN, B_GROUPS, B_STATE, B_GROUP_DIM), (2 * B_GROUP_DIM) ** -0.5)
    inp['s5_b_im'] = nrm((N_EVEN, B_GROUPS, B_STATE, B_GROUP_DIM), (2 * B_GROUP_DIM) ** -0.5)
    inp['s5_c_re'] = nrm((N_EVEN, B_GROUPS, B_GROUP_DIM, B_STATE), B_STATE ** -0.5)
    inp['s5_c_im'] = nrm((N_EVEN, B_GROUPS, B_GROUP_DIM, B_STATE), B_STATE ** -0.5)
    inp['s5_d'] = nrm((N_EVEN, B_GROUPS, B_GROUP_DIM))
    inp['s5_w_glu'] = nrm((N_EVEN, B_WIDTH, B_WIDTH), B_WIDTH ** -0.5)
    inp['s5_b_glu'] = nrm((N_EVEN, B_WIDTH), 0.01)
    inp['ab_w_out'] = nrm((N_EVEN, D_MIX, D_MODEL), D_MIX ** -0.5)
    inp['cd_w_in'] = nrm((N_ODD, D_MODEL, CD_IN), D_MODEL ** -0.5)
    inp['gmlp_v_norm'] = gain((N_ODD, C_WIDTH))
    inp['gmlp_w_s'] = nrm((N_ODD, C_GROUPS, C_CHUNK, C_CHUNK), C_CHUNK ** -0.5)
    inp['gmlp_b_s'] = gain((N_ODD, C_GROUPS, C_CHUNK))
    inp['mla_q_norm'] = gain((N_ODD, Q_LORA))
    inp['mla_w_uq'] = nrm((N_ODD, Q_LORA, D_HEADS * QK_DIM), Q_LORA ** -0.5)
    inp['mla_kv_norm'] = gain((N_ODD, KV_LORA))
    inp['mla_w_ukv'] = nrm((N_ODD, KV_LORA, D_HEADS * (NOPE_DIM + V_DIM)), KV_LORA ** -0.5)
    inp['mla_q_gain'] = gain((N_ODD, QK_DIM))
    inp['mla_k_gain'] = gain((N_ODD, QK_DIM))
    inp['cd_w_out'] = nrm((N_ODD, D_MIX, D_MODEL), D_MIX ** -0.5)
    return inp


def reference(x_prompt, x_sample, state_hgrn, state_s5_re, state_s5_im, cache_mla_ckv, cache_mla_kpe,
              ffn1_norm, ffn1_w_gate, ffn1_w_up, ffn1_w_down, mix_norm,
              ffn2_norm, ffn2_w_gate, ffn2_w_up, ffn2_w_down,
              ab_w_in, hgrn_lb_logits, hgrn_out_norm, s5_lambda_re, s5_lambda_im, s5_log_dt,
              s5_b_re, s5_b_im, s5_c_re, s5_c_im, s5_d, s5_w_glu, s5_b_glu, ab_w_out,
              cd_w_in, gmlp_v_norm, gmlp_w_s, gmlp_b_s, mla_q_norm, mla_w_uq, mla_kv_norm,
              mla_w_ukv, mla_q_gain, mla_k_gain, cd_w_out):
    w = dict(ffn1_norm=ffn1_norm, ffn1_w_gate=ffn1_w_gate, ffn1_w_up=ffn1_w_up, ffn1_w_down=ffn1_w_down,
             mix_norm=mix_norm, ffn2_norm=ffn2_norm, ffn2_w_gate=ffn2_w_gate, ffn2_w_up=ffn2_w_up,
             ffn2_w_down=ffn2_w_down, ab_w_in=ab_w_in, hgrn_lb_logits=hgrn_lb_logits,
             hgrn_out_norm=hgrn_out_norm, s5_lambda_re=s5_lambda_re, s5_lambda_im=s5_lambda_im,
             s5_log_dt=s5_log_dt, s5_b_re=s5_b_re, s5_b_im=s5_b_im, s5_c_re=s5_c_re, s5_c_im=s5_c_im,
             s5_d=s5_d, s5_w_glu=s5_w_glu, s5_b_glu=s5_b_glu, ab_w_out=ab_w_out, cd_w_in=cd_w_in,
             gmlp_v_norm=gmlp_v_norm, gmlp_w_s=gmlp_w_s, gmlp_b_s=gmlp_b_s, mla_q_norm=mla_q_norm,
             mla_w_uq=mla_w_uq, mla_kv_norm=mla_kv_norm, mla_w_ukv=mla_w_ukv, mla_q_gain=mla_q_gain,
             mla_k_gain=mla_k_gain, cd_w_out=cd_w_out)
    past_len = cache_mla_ckv.shape[2]
    pos_prompt = jnp.arange(x_prompt.shape[1], dtype=jnp.int32)
    pos_sample = past_len + jnp.arange(x_sample.shape[1], dtype=jnp.int32)
    y_prompt, st_p = trunk(x_prompt, pos_prompt, w, None)
    y_sample, st_s = trunk(x_sample, pos_sample, w,
                           (state_hgrn, state_s5_re, state_s5_im, cache_mla_ckv, cache_mla_kpe))
    hgrn_p, s5re_p, s5im_p, gv_p, ckv_p, kpe_p = st_p
    hgrn_s, s5re_s, s5im_s, gv_s, ckv_s, kpe_s = st_s
    return (y_prompt, y_sample, hgrn_p, hgrn_s, s5re_p, s5im_p, s5re_s, s5im_s,
            gv_p, gv_s, ckv_p, kpe_p, ckv_s, kpe_s)
```

```cpp
#include <hip/hip_runtime.h>
#include <hip/hip_cooperative_groups.h>
#include <cstdio>
#include <cstdint>
namespace cg = cooperative_groups;
namespace pg8 {
#define PG8_LAS __attribute__((address_space(3)))
typedef unsigned short bf16_t;
typedef short bf16x8 __attribute__((ext_vector_type(8)));
typedef float f32x4 __attribute__((ext_vector_type(4)));
typedef unsigned u32x4 __attribute__((ext_vector_type(4)));
constexpr int BM = 256, BK = 64, HALF = 128, HTB = HALF * BK * 2  , STAGE_BYTES = 8 * HTB, NXCD = 8, WGM = 8;

__host__ __device__ __forceinline__ int lds_byte(int r, int c) { const int st = (r >> 4) * 2 + (c >> 5), rr = r & 15, cc = c & 31, ob = rr * 64 + cc * 2; return st * 1024 + (ob ^ (((ob >> 9) & 1) << 5)); }
__host__ __device__ __forceinline__ void stage_rc(int b, int& R, int& C) { const int st = b / 1024, sb = b % 1024, swz = sb ^ (((sb >> 9) & 1) << 5); R = (st >> 1) * 16 + swz / 64; C = (st & 1) * 32 + (swz % 64) / 2; }
__host__ __device__ __forceinline__ int perm32(int rho) { const int n = rho >> 4, i = rho & 15; return 8 * (i >> 2) + 4 * n + (i & 3); }

struct Unit { int pm, pn; };
struct Gemm { const bf16_t* A; const bf16_t* Bt; int M, N, K; int Kl = 0; };

struct StaticOrder {
    int nM, nN, nwg, G, c;
    __host__ __device__ void init(int M, int N, int G_, int c_) { nM = M / BM; nN = N / BM; nwg = nM * nN; G = G_; c = c_; }
    __host__ __device__ bool next(int i, Unit& u) const {
        const long L = (long)i * G + c; if (L >= nwg) return false;
        int wgid = (int)L; { const int q = nwg / NXCD, r = nwg % NXCD, xcd = wgid % NXCD, off = wgid / NXCD; wgid = (xcd < r ? xcd * (q + 1) : r * (q + 1) + (xcd - r) * q) + off; }
        const int nig = WGM * nN, gid = wgid / nig, fm = gid * WGM, gsz = (nM - fm) < WGM ? (nM - fm) : WGM;
        u.pm = fm + ((wgid % nig) % gsz); u.pn = (wgid % nig) / gsz; return true;
    }
    __device__ __forceinline__ void a_ready(const Unit&) const {}
    __device__ __forceinline__ void done(const Unit&) const {}
};

typedef __bf16 bf16x2_cv __attribute__((ext_vector_type(2))); typedef float f32x2_cv __attribute__((ext_vector_type(2)));
__device__ __forceinline__ unsigned cvt_pk_bf16(float lo, float hi) { const f32x2_cv v = {lo, hi}; const bf16x2_cv b = __builtin_convertvector(v, bf16x2_cv); return __builtin_bit_cast(unsigned, b); }

template <class Epi, class Sched, bool ALIGN_EPI = false, bool SP2 = false>
__device__ __forceinline__ void gemm_phase(PG8_LAS unsigned char* lds, const Gemm g, const Sched& S, const Epi& E, const int wvs) {
    int tid_; asm volatile("v_mbcnt_lo_u32_b32 %0, -1, 0\n\tv_mbcnt_hi_u32_b32 %0, -1, %0" : "=v"(tid_)); tid_ += wvs * 64;
    const int tid = tid_, wid = __builtin_amdgcn_readfirstlane(tid >> 6), lane = tid & 63, wr = wid >> 2, wc = wid & 3, fr = lane & 15, fq = lane >> 4;
    const int K = g.K, nt = (g.Kl ? g.Kl : K) / BK;
    unsigned voffA[2], voffB[2];
#pragma unroll
    for (int i = 0; i < 2; ++i) { int R, C; stage_rc(tid * 16 + i * 8192, R, C); const int Rb = Epi::PERM ? ((R & ~31) + perm32(R & 31)) : R;
        voffA[i] = (unsigned)(R * K + C) * 2u; voffB[i] = (unsigned)(Rb * K + C) * 2u; }
    const size_t kstep = (size_t)(BK * 2);
    const size_t hstep = (size_t)HALF * K * 2;
    const size_t tstep = 2 * hstep;
    const unsigned ldsw = (unsigned)wid * 1024u;
    const int aoff = lds_byte(wr * 64 + fr, fq * 8), boff = lds_byte(wc * 32 + fr, fq * 8);
#define PG8_SA(b, h) (((b) * 2 + (h)) * HTB)
#define PG8_SB(b, h) ((4 + (b) * 2 + (h)) * HTB)
#define PG8_STAGE(bufoff, gbase, voff) do { _Pragma("unroll") for (int _i = 0; _i < 2; ++_i) \
        __builtin_amdgcn_global_load_lds((const unsigned*)((const char*)(gbase) + (voff)[_i]), (PG8_LAS unsigned*)(lds + (bufoff) + ldsw + _i * 8192), 16, 0, 0); } while (0)
#define PG8_LDA(dst, b, h) do { _Pragma("unroll") for (int m = 0; m < 4; ++m) _Pragma("unroll") for (int k = 0; k < 2; ++k) dst[m][k] = *(const PG8_LAS bf16x8*)(lds + PG8_SA(b, h) + aoff + m * 2048 + k * 1024); } while (0)
#define PG8_LDB(dst, b, h) do { _Pragma("unroll") for (int n = 0; n < 2; ++n) _Pragma("unroll") for (int k = 0; k < 2; ++k) dst[n][k] = *(const PG8_LAS bf16x8*)(lds + PG8_SB(b, h) + boff + n * 2048 + k * 1024); } while (0)
#define PG8_MMA(ai, bj, At, Bt) do { __builtin_amdgcn_s_setprio(1); _Pragma("unroll") for (int m = 0; m < 4; ++m) _Pragma("unroll") for (int n = 0; n < 2; ++n) _Pragma("unroll") for (int k = 0; k < 2; ++k) \
        acc[ai][bj][m][n] = __builtin_amdgcn_mfma_f32_16x16x32_bf16(Bt[n][k], At[m][k], acc[ai][bj][m][n], 0, 0, 0); __builtin_amdgcn_s_setprio(0); } while (0)
#define PG8_WAIT_V(n) asm volatile("s_waitcnt vmcnt(" #n ")" ::: "memory")
#define PG8_WAIT_L(n) asm volatile("s_waitcnt lgkmcnt(" #n ")" ::: "memory")
#define PG8_BAR __builtin_amdgcn_s_barrier()
#define PG8_SCHED __builtin_amdgcn_sched_barrier(0)
    Unit cur, nxt; int ui = 0;
    if (!S.next(0, cur)) return;
    f32x4 acc[2][2][4][2];
#pragma unroll
    for (int a = 0; a < 2; ++a)
#pragma unroll
        for (int b = 0; b < 2; ++b)
#pragma unroll
            for (int m = 0; m < 4; ++m)
#pragma unroll
                for (int n = 0; n < 2; ++n) acc[a][b][m][n] = (f32x4){0.f, 0.f, 0.f, 0.f};
    bf16x8 At[4][2], B0[2][2], B1[2][2];
    const char* cA = (const char*)g.A + (size_t)cur.pm * tstep; const char* cB = (const char*)g.Bt + (size_t)cur.pn * tstep;
    S.a_ready(cur);
    if constexpr (SP2) {
        PG8_STAGE(PG8_SB(0, 0), cB, voffB); PG8_STAGE(PG8_SB(0, 1), cB + hstep, voffB); PG8_STAGE(PG8_SA(0, 0), cA, voffA); PG8_STAGE(PG8_SA(0, 1), cA + hstep, voffA);
        if (wr == 1) PG8_BAR;
        PG8_WAIT_V(2); PG8_BAR;
        PG8_STAGE(PG8_SB(1, 0), cB + kstep, voffB); PG8_STAGE(PG8_SA(1, 0), cA + kstep, voffA); PG8_STAGE(PG8_SB(1, 1), cB + hstep + kstep, voffB);
        PG8_WAIT_V(6); PG8_BAR;
    } else {
        PG8_STAGE(PG8_SB(0, 0), cB, voffB); PG8_STAGE(PG8_SA(0, 0), cA, voffA); PG8_STAGE(PG8_SB(0, 1), cB + hstep, voffB); PG8_STAGE(PG8_SA(0, 1), cA + hstep, voffA);
        if (wr == 1) PG8_BAR;
        PG8_WAIT_V(4); PG8_BAR;
        PG8_STAGE(PG8_SB(1, 0), cB + kstep, voffB); PG8_STAGE(PG8_SA(1, 0), cA + kstep, voffA); PG8_STAGE(PG8_SB(1, 1), cB + hstep + kstep, voffB);
        PG8_WAIT_V(6); PG8_BAR;
    }
    for (;;) {
        const bool has_next = S.next(ui + 1, nxt);
        const char* nA = has_next ? (const char*)g.A + (size_t)nxt.pm * tstep : cA; const char* nB = has_next ? (const char*)g.Bt + (size_t)nxt.pn * tstep : cB;
        for (int t = 0; t < nt; t += 2) {
            const bool last = (t == nt - 2);
            const char* a1 = cA + (size_t)(t + 1) * kstep;
            const char* a2 = last ? nA : cA + (size_t)(t + 2) * kstep; const char* b2 = last ? nB : cB + (size_t)(t + 2) * kstep;
            const char* a3 = a2 + kstep; const char* b3 = b2 + kstep;
            if (last && has_next) S.a_ready(nxt);
            if constexpr (SP2) {
            PG8_LDB(B0, 0, 0); PG8_LDB(B1, 0, 1); PG8_SCHED; PG8_LDA(At, 0, 0); PG8_STAGE(PG8_SA(1, 1), a1 + hstep, voffA);
            PG8_WAIT_V(8); PG8_WAIT_L(0); PG8_BAR; PG8_MMA(0, 0, At, B0); PG8_MMA(0, 1, At, B1); PG8_BAR; PG8_SCHED;
            PG8_LDA(At, 0, 1); PG8_STAGE(PG8_SB(0, 0), b2, voffB); PG8_STAGE(PG8_SB(0, 1), b2 + hstep, voffB); PG8_STAGE(PG8_SA(0, 0), a2, voffA);
            PG8_WAIT_V(8); PG8_WAIT_L(0); PG8_BAR; PG8_MMA(1, 0, At, B0); PG8_MMA(1, 1, At, B1); PG8_BAR; PG8_SCHED;
            PG8_LDB(B0, 1, 0); PG8_LDB(B1, 1, 1); PG8_SCHED; PG8_LDA(At, 1, 0); PG8_STAGE(PG8_SA(0, 1), a2 + hstep, voffA);
            PG8_WAIT_V(8); PG8_WAIT_L(0); PG8_BAR; PG8_MMA(0, 0, At, B0); PG8_MMA(0, 1, At, B1); PG8_BAR; PG8_SCHED;
            PG8_LDA(At, 1, 1); PG8_STAGE(PG8_SB(1, 0), b3, voffB); PG8_STAGE(PG8_SB(1, 1), b3 + hstep, voffB); PG8_STAGE(PG8_SA(1, 0), a3, voffA);
            PG8_WAIT_V(8); PG8_WAIT_L(0); PG8_BAR; PG8_MMA(1, 0, At, B0); PG8_MMA(1, 1, At, B1); PG8_BAR; PG8_SCHED;
            } else {
            PG8_LDB(B0, 0, 0); PG8_SCHED; PG8_LDA(At, 0, 0); PG8_STAGE(PG8_SA(1, 1), a1 + hstep, voffA);
            PG8_WAIT_L(8); PG8_BAR; PG8_WAIT_L(0); PG8_MMA(0, 0, At, B0); PG8_BAR; PG8_SCHED;
            PG8_LDB(B1, 0, 1); PG8_STAGE(PG8_SB(0, 0), b2, voffB);
            PG8_BAR; PG8_WAIT_L(0); PG8_MMA(0, 1, At, B1); PG8_BAR;
            PG8_LDA(At, 0, 1); PG8_STAGE(PG8_SA(0, 0), a2, voffA);
            PG8_BAR; PG8_WAIT_L(0); PG8_MMA(1, 0, At, B0); PG8_BAR; PG8_SCHED;
            PG8_STAGE(PG8_SB(0, 1), b2 + hstep, voffB);
            PG8_WAIT_V(6); PG8_BAR; PG8_MMA(1, 1, At, B1); PG8_BAR;
            PG8_LDB(B0, 1, 0); PG8_SCHED; PG8_LDA(At, 1, 0); PG8_STAGE(PG8_SA(0, 1), a2 + hstep, voffA);
            PG8_WAIT_L(8); PG8_BAR; PG8_WAIT_L(0); PG8_MMA(0, 0, At, B0); PG8_BAR; PG8_SCHED;
            PG8_LDB(B1, 1, 1); PG8_STAGE(PG8_SB(1, 0), b3, voffB);
            PG8_BAR; PG8_WAIT_L(0); PG8_MMA(0, 1, At, B1); PG8_BAR;
            PG8_LDA(At, 1, 1); PG8_STAGE(PG8_SA(1, 0), a3, voffA);
            PG8_BAR; PG8_WAIT_L(0); PG8_MMA(1, 0, At, B0); PG8_BAR; PG8_SCHED;
            PG8_STAGE(PG8_SB(1, 1), b3 + hstep, voffB);
            PG8_WAIT_V(6); PG8_BAR; PG8_MMA(1, 1, At, B1); PG8_BAR;
            }
        }
        if constexpr (ALIGN_EPI) { if (wr == 0) PG8_BAR; }
        if constexpr (!Epi::AFTER_DRAIN) { E(acc, cur, wr, wc, fr, fq); S.done(cur); }
        if (!has_next) break;
#pragma unroll
        for (int a = 0; a < 2; ++a)
#pragma unroll
            for (int b = 0; b < 2; ++b)
#pragma unroll
                for (int m = 0; m < 4; ++m)
#pragma unroll
                    for (int n = 0; n < 2; ++n) acc[a][b][m][n] = (f32x4){0.f, 0.f, 0.f, 0.f};
        cur = nxt; cA = nA; cB = nB; ++ui;
        if constexpr (ALIGN_EPI) { if (wr == 1) PG8_BAR; }
    }
    PG8_WAIT_V(0);
    if constexpr (!ALIGN_EPI) { if (wr == 0) PG8_BAR; }
    PG8_BAR;
    if constexpr (Epi::AFTER_DRAIN) { E.fused(acc, cur, wr, wc, fr, fq, lds, wid, lane); S.done(cur); }
#undef PG8_SA
#undef PG8_SB
#undef PG8_STAGE
#undef PG8_LDA
#undef PG8_LDB
#undef PG8_MMA
#undef PG8_WAIT_V
#undef PG8_WAIT_L
#undef PG8_BAR
#undef PG8_SCHED
}
}

#ifndef REP_PH
#define REP_PH -1
#endif
#ifndef MK_PER_PHASE
#define MK_PER_PHASE 0
#endif
#define LAS __attribute__((address_space(3)))
using pg8::bf16_t; using pg8::bf16x8; using pg8::f32x4; using pg8::Unit; using pg8::cvt_pk_bf16;
typedef unsigned u32x2 __attribute__((ext_vector_type(2)));
typedef unsigned u32x4 __attribute__((ext_vector_type(4)));
typedef float f32x2 __attribute__((ext_vector_type(2)));

constexpr int MP = 32768, MS = 1024, M = MP + MS, D = 1024, FF = 2816;
constexpr int KVR = 32768 + 32 * 1056;
constexpr float EPS = 1e-6f;
constexpr int NPH = 17;

constexpr size_t OUT_Y = 0;
constexpr size_t OUT_HGRN_P = 34603008, OUT_HGRN_S = OUT_HGRN_P + 1048576;
constexpr size_t OUT_S5RE_P = OUT_HGRN_S + 2097152, OUT_S5IM_P = OUT_S5RE_P + 32768;
constexpr size_t OUT_S5RE_S = OUT_S5IM_P + 32768, OUT_S5IM_S = OUT_S5RE_S + 65536;
constexpr size_t OUT_GV_P = OUT_S5IM_S + 65536, OUT_GV_S = OUT_GV_P + 1048576;
constexpr size_t OUT_CKV_P = OUT_GV_S + 524288, OUT_KPE_P = OUT_CKV_P + 4194304;
constexpr size_t OUT_CKV_S = OUT_KPE_P + 1048576, OUT_KPE_S = OUT_CKV_S + 131072;
constexpr size_t OUT_TOTAL = OUT_KPE_S + 32768;

constexpr size_t al256(size_t x) { return (x + 255) & ~(size_t)255; }
constexpr size_t SZ_GU = (size_t)5632 * 1024 * 2, SZ_DN = (size_t)1024 * 2816 * 2;
constexpr size_t W_GU0 = 0;
constexpr size_t W_DN0 = W_GU0 + 4 * SZ_GU;
constexpr size_t W_AB = W_DN0 + 4 * SZ_DN;
constexpr size_t W_ABO = W_AB + (size_t)2560 * 1024 * 2;
constexpr size_t W_GLU = W_ABO + (size_t)1024 * 1024 * 2;
constexpr size_t W_CD = W_GLU + (size_t)512 * 512 * 2;
constexpr size_t W_CDO = W_CD + (size_t)1536 * 1024 * 2;
constexpr size_t W_UQ = W_CDO + (size_t)1024 * 1024 * 2;
constexpr size_t W_UKV = W_UQ + (size_t)768 * 256 * 2;
constexpr size_t T_LAMBAR = W_UKV + (size_t)1024 * 128 * 2;
constexpr size_t T_BBT = T_LAMBAR + 2048 * 8;
constexpr size_t T_CCT = T_BBT + 65536 * 2;
constexpr size_t T_ROPE = T_CCT + 65536 * 2;
constexpr size_t T_LB = T_ROPE + 32768 * 8;
constexpr size_t T_WS = T_LB + 2048;
constexpr size_t A_XB = T_WS + 65536 * 2;
constexpr size_t A_SSQ = A_XB + (size_t)M * 1024 * 2;
constexpr size_t A_SSV = A_SSQ + (size_t)M * 16 * 4;
constexpr size_t A_SSCQ = A_SSV + (size_t)M * 8 * 4;
constexpr size_t A_SSCKV = A_SSCQ + (size_t)M * 4 * 4;
constexpr size_t A_SSQN = A_SSCKV + (size_t)M * 4 * 4;
constexpr size_t A_SSQR = A_SSQN + (size_t)M * 8 * 4;
constexpr size_t A_SSK = A_SSQR + (size_t)M * 8 * 4;
constexpr size_t A_CTL = al256(A_SSK + (size_t)KVR * 4);
constexpr size_t R0 = A_CTL + 16384;
constexpr size_t SZ_H = (size_t)M * 512 * 2;
constexpr size_t R_ACT = R0;
constexpr size_t R_MIX = R0;
constexpr size_t R_QT = R_MIX + 2 * SZ_H, R_KH = R_QT + SZ_H, R_KTT = R_KH + SZ_H, R_VTT = R_KTT + SZ_H;
constexpr size_t R_GB = R_VTT + SZ_H, R_UB = R_GB + SZ_H, R_OB = R_UB + SZ_H, R_ZB = R_OB + SZ_H;
constexpr size_t R_LDEC = R_ZB + SZ_H;
constexpr size_t R_END0 = R_LDEC + (size_t)(M / 16) * 512 * 4;
constexpr size_t R_VG = R_MIX + 2 * SZ_H;
constexpr size_t R_CQB = R_VG + SZ_H;
constexpr size_t R_CKVG = R_CQB + (size_t)M * 256 * 2;
constexpr size_t R_KPEB = R_CKVG + (size_t)KVR * 128 * 2;
constexpr size_t R_QF = R_KPEB + (size_t)KVR * 32 * 4;
constexpr size_t R_KF = R_QF + (size_t)M * 768 * 2;
constexpr size_t R_VT = R_KF + (size_t)KVR * 768 * 2;
constexpr size_t R_END1 = R_VT + (size_t)KVR * 512 * 2;
constexpr size_t R_PART = al256(R_ACT + (size_t)M * FF * 2);
constexpr size_t R_ENDA = R_PART + (size_t)176 * 65536 * 4;
constexpr size_t WS_END = (R_END1 > R_END0 ? (R_END1 > R_ENDA ? R_END1 : R_ENDA) : (R_END0 > R_ENDA ? R_END0 : R_ENDA));
static_assert(WS_END <= (size_t)536870912, "workspace map exceeds 512 MiB");

constexpr int LDS_BYTES = 147456;

template <class T> __device__ __forceinline__ T* gp(T* p) { return p; }
__device__ __forceinline__ float sum4(f32x4 a) { return (a.x + a.y) + (a.z + a.w); }
__device__ __forceinline__ float bf2f(unsigned short h) { return __uint_as_float((unsigned)h << 16); }
__device__ __forceinline__ void st_bf4(bf16_t* p, f32x4 v) { u32x2 w; w.x = cvt_pk_bf16(v.x, v.y); w.y = cvt_pk_bf16(v.z, v.w); *(u32x2*)p = w; }
__device__ __forceinline__ unsigned short bf1(float v) { return (unsigned short)(cvt_pk_bf16(v, 0.f) & 0xffffu); }
__device__ __forceinline__ float sigmoidf_(float x) { return __builtin_amdgcn_rcpf(1.f + __expf(-x)); }
__device__ __forceinline__ float gelu_tanh(float x) { const float y = 1.5957691216057308f * (x + 0.044715f * x * x * x); return x * __builtin_amdgcn_rcpf(1.f + __expf(-y)); }
__device__ __forceinline__ float rstd16(const float* ssq, int row) { const f32x4* p = (const f32x4*)(ssq + (size_t)row * 16); return rsqrtf((sum4(p[0]) + sum4(p[1]) + sum4(p[2]) + sum4(p[3])) * (1.f / 1024.f) + EPS); }
__device__ __forceinline__ int kvrow_of(int row) { return row < MP ? row : MP + ((row - MP) >> 5) * 1056 + 1024 + ((row - MP) & 31); }
__device__ __forceinline__ int pos_of(int row) { return row < MP ? (row & 2047) : 1024 + ((row - MP) & 31); }
__device__ __forceinline__ bf16x8 mk8(u32x2 a, u32x2 b) { u32x4 w; w.x = a.x; w.y = a.y; w.z = b.x; w.w = b.y; return __builtin_bit_cast(bf16x8, w); }
__device__ __forceinline__ f32x4 mfma16(bf16x8 a, bf16x8 b, f32x4 c) { return __builtin_amdgcn_mfma_f32_16x16x32_bf16(a, b, c, 0, 0, 0); }
#define LDSWAIT() asm volatile("s_waitcnt lgkmcnt(0)" ::: "memory")

#define EPI_ROWS_BEGIN _Pragma("unroll") for (int ai = 0; ai < 2; ++ai) _Pragma("unroll") for (int m = 0; m < 4; ++m) { const int row = u.pm * 256 + ai * 128 + wr * 64 + m * 16 + fr;
#define EPI_ROWS_END }

struct EpiGU {
    static constexpr bool PERM = false, AFTER_DRAIN = false;
    const float* ssq; bf16_t* act;
    __device__ __forceinline__ void operator()(const f32x4 (&acc)[2][2][4][2], const Unit& u, int wr, int wc, int fr, int fq) const {
        asm volatile("" : "+v"(fr), "+v"(fq));
        EPI_ROWS_BEGIN
            const float rs = rstd16(ssq, row);
#pragma unroll
            for (int n = 0; n < 2; ++n) { const f32x4 g = acc[ai][0][m][n] * rs, up = acc[ai][1][m][n] * rs; f32x4 a;
                a.x = g.x * sigmoidf_(g.x) * up.x; a.y = g.y * sigmoidf_(g.y) * up.y; a.z = g.z * sigmoidf_(g.z) * up.z; a.w = g.w * sigmoidf_(g.w) * up.w;
                st_bf4(act + (size_t)row * FF + u.pn * 128 + wc * 32 + n * 16 + fq * 4, a); }
        EPI_ROWS_END
    }
};
struct EpiRes {
    static constexpr bool PERM = false, AFTER_DRAIN = false;
    const float* xin0; const float* xin1; float* xout; bf16_t* xb; float* ssq; float scale;
    __device__ __forceinline__ void do_row(int row, int pn, int wc, int fq, const f32x4& a00, const f32x4& a01, const f32x4& a10, const f32x4& a11) const {
        const float* src = row < MP ? xin0 + (size_t)row * D : xin1 + (size_t)(row - MP) * D; float ss = 0.f;
#pragma unroll
        for (int bj = 0; bj < 2; ++bj)
#pragma unroll
            for (int n = 0; n < 2; ++n) { const int col = pn * 256 + bj * 128 + wc * 32 + n * 16 + fq * 4;
                const f32x4 o = *(const f32x4*)(src + col) + (bj ? (n ? a11 : a10) : (n ? a01 : a00)) * scale;
                *(f32x4*)(xout + (size_t)row * D + col) = o; st_bf4(xb + (size_t)row * D + col, o); ss += sum4(o * o); }
        ss += __shfl_xor(ss, 16); ss += __shfl_xor(ss, 32);
        if (fq == 0) ssq[(size_t)row * 16 + pn * 4 + wc] = ss;
    }
    __device__ __forceinline__ void operator()(const f32x4 (&acc)[2][2][4][2], const Unit& u, int wr, int wc, int fr, int fq) const {
        asm volatile("" : "+v"(fr), "+v"(fq));
        EPI_ROWS_BEGIN
            do_row(row, u.pn, wc, fq, acc[ai][0][m][0], acc[ai][0][m][1], acc[ai][1][m][0], acc[ai][1][m][1]);
        EPI_ROWS_END
    }
};
struct EpiAB {
    static constexpr bool PERM = false, AFTER_DRAIN = false;
    const float* ssq; const float* lb; bf16_t* QT; bf16_t* KH; bf16_t* KTT; bf16_t* VTT; bf16_t* GB; bf16_t* UB; float* LDEC;
    __device__ __forceinline__ void operator()(const f32x4 (&acc)[2][2][4][2], const Unit& u, int wr, int wc, int fr, int fq) const {
        asm volatile("" : "+v"(fr), "+v"(fq));
        if (u.pn < 4) {
            const int h = u.pn;
            EPI_ROWS_BEGIN
                const float rs = rstd16(ssq, row); const int blk = row >> 4;
#pragma unroll
                for (int n = 0; n < 2; ++n) { const int cl = h * 128 + wc * 32 + n * 16 + fq * 4; const f32x4 lbv = *(const f32x4*)(lb + cl);
                    f32x4 qt, kh, dec; float kt[4];
#pragma unroll
                    for (int j = 0; j < 4; ++j) { const float q = acc[ai][0][m][n][j] * rs, fz = acc[ai][1][m][n][j] * rs;
                        const float f = lbv[j] + (1.f - lbv[j]) * sigmoidf_(fz); float b = __logf(f);
#pragma unroll
                        for (int d = 1; d < 16; d <<= 1) { const float t = __shfl_up(b, d, 16); if (fr >= d) b += t; }
                        const float bend = __shfl(b, 15, 16); const float kk = 1.f - f;
                        qt[j] = q * __expf(b); kh[j] = kk * __expf(-b); kt[j] = kk * __expf(bend - b); dec[j] = __expf(bend); }
                    st_bf4(QT + (size_t)row * 512 + cl, qt); st_bf4(KH + (size_t)row * 512 + cl, kh);
#pragma unroll
                    for (int j = 0; j < 4; ++j) KTT[(size_t)blk * 8192 + (cl + j) * 16 + fr] = bf1(kt[j]);
                    if (fr == 15) *(f32x4*)(LDEC + (size_t)blk * 512 + cl) = dec; }
            EPI_ROWS_END
        } else if (u.pn < 6) {
            EPI_ROWS_BEGIN
                const float rs = rstd16(ssq, row); const int blk = row >> 4;
#pragma unroll
                for (int bj = 0; bj < 2; ++bj)
#pragma unroll
                    for (int n = 0; n < 2; ++n) { const int cl = (u.pn - 4) * 256 + bj * 128 + wc * 32 + n * 16 + fq * 4;
#pragma unroll
                        for (int j = 0; j < 4; ++j) VTT[(size_t)blk * 8192 + (cl + j) * 16 + fr] = bf1(acc[ai][bj][m][n][j] * rs); }
            EPI_ROWS_END
        } else if (u.pn < 8) {
            EPI_ROWS_BEGIN
                const float rs = rstd16(ssq, row);
#pragma unroll
                for (int bj = 0; bj < 2; ++bj)
#pragma unroll
                    for (int n = 0; n < 2; ++n) { const int cl = (u.pn - 6) * 256 + bj * 128 + wc * 32 + n * 16 + fq * 4; const f32x4 v = acc[ai][bj][m][n] * rs; f32x4 s;
                        s.x = sigmoidf_(v.x); s.y = sigmoidf_(v.y); s.z = sigmoidf_(v.z); s.w = sigmoidf_(v.w); st_bf4(GB + (size_t)row * 512 + cl, s); }
            EPI_ROWS_END
        } else {
            EPI_ROWS_BEGIN
                const float rs = rstd16(ssq, row);
#pragma unroll
                for (int bj = 0; bj < 2; ++bj)
#pragma unroll
                    for (int n = 0; n < 2; ++n) { const int cl = (u.pn - 8) * 256 + bj * 128 + wc * 32 + n * 16 + fq * 4; st_bf4(UB + (size_t)row * 512 + cl, acc[ai][bj][m][n] * rs); }
            EPI_ROWS_END
        }
    }
};
struct EpiGLU {
    static constexpr bool PERM = false, AFTER_DRAIN = false;
    const bf16_t* ZB; const float* bglu; bf16_t* MIX;
    __device__ __forceinline__ void operator()(const f32x4 (&acc)[2][2][4][2], const Unit& u, int wr, int wc, int fr, int fq) const {
        asm volatile("" : "+v"(fr), "+v"(fq));
        EPI_ROWS_BEGIN
#pragma unroll
            for (int bj = 0; bj < 2; ++bj)
#pragma unroll
                for (int n = 0; n < 2; ++n) { const int col = u.pn * 256 + bj * 128 + wc * 32 + n * 16 + fq * 4;
                    const u32x2 zz = *(const u32x2*)(ZB + (size_t)row * 512 + col); const f32x4 bv = *(const f32x4*)(bglu + col); const f32x4 a = acc[ai][bj][m][n] + bv; f32x4 o;
                    o.x = __uint_as_float(zz.x << 16) * sigmoidf_(a.x); o.y = __uint_as_float(zz.x & 0xffff0000u) * sigmoidf_(a.y);
                    o.z = __uint_as_float(zz.y << 16) * sigmoidf_(a.z); o.w = __uint_as_float(zz.y & 0xffff0000u) * sigmoidf_(a.w);
                    st_bf4(MIX + (size_t)row * 1024 + 512 + col, o); }
        EPI_ROWS_END
    }
};
struct EpiCD {
    static constexpr bool PERM = false, AFTER_DRAIN = false;
    const float* ssq; const float* vnorm; const float* kvnorm; const f32x2* rope; bf16_t* MIX; bf16_t* VG; float* SSV; bf16_t* CQB; float* SSCQ; bf16_t* CKVG; float* SSCKV; float* KPEB; float* SSK; float* out;
    __device__ __forceinline__ void operator()(const f32x4 (&acc)[2][2][4][2], const Unit& u, int wr, int wc, int fr, int fq) const {
        asm volatile("" : "+v"(fr), "+v"(fq));
        if (u.pn < 2) {
            EPI_ROWS_BEGIN
                const float rs = rstd16(ssq, row);
#pragma unroll
                for (int bj = 0; bj < 2; ++bj)
#pragma unroll
                    for (int n = 0; n < 2; ++n) { const int cl = u.pn * 256 + bj * 128 + wc * 32 + n * 16 + fq * 4; const f32x4 v = acc[ai][bj][m][n] * rs; f32x4 g;
                        g.x = gelu_tanh(v.x); g.y = gelu_tanh(v.y); g.z = gelu_tanh(v.z); g.w = gelu_tanh(v.w); st_bf4(MIX + (size_t)row * 1024 + cl, g); }
            EPI_ROWS_END
        } else if (u.pn < 4) {
            EPI_ROWS_BEGIN
                const float rs = rstd16(ssq, row); float ss = 0.f;
#pragma unroll
                for (int bj = 0; bj < 2; ++bj)
#pragma unroll
                    for (int n = 0; n < 2; ++n) { const int cl = (u.pn - 2) * 256 + bj * 128 + wc * 32 + n * 16 + fq * 4; const f32x4 v = acc[ai][bj][m][n] * rs; f32x4 g;
                        g.x = gelu_tanh(v.x); g.y = gelu_tanh(v.y); g.z = gelu_tanh(v.z); g.w = gelu_tanh(v.w); ss += sum4(g * g);
                        st_bf4(VG + (size_t)row * 512 + cl, g * *(const f32x4*)(vnorm + cl)); }
                ss += __shfl_xor(ss, 16); ss += __shfl_xor(ss, 32);
                if (fq == 0) SSV[(size_t)row * 8 + (u.pn - 2) * 4 + wc] = ss;
            EPI_ROWS_END
        } else if (u.pn == 4) {
            EPI_ROWS_BEGIN
                const float rs = rstd16(ssq, row); float ss = 0.f;
#pragma unroll
                for (int bj = 0; bj < 2; ++bj)
#pragma unroll
                    for (int n = 0; n < 2; ++n) { const int cl = bj * 128 + wc * 32 + n * 16 + fq * 4; const f32x4 v = acc[ai][bj][m][n] * rs; ss += sum4(v * v); st_bf4(CQB + (size_t)row * 256 + cl, v); }
                ss += __shfl_xor(ss, 16); ss += __shfl_xor(ss, 32);
                if (fq == 0) SSCQ[(size_t)row * 4 + wc] = ss;
            EPI_ROWS_END
        } else {
            EPI_ROWS_BEGIN
                const float rs = rstd16(ssq, row); const int kvr = kvrow_of(row); float ss = 0.f;
                float* ock = row < MP ? out + OUT_CKV_P + (size_t)row * 128 : out + OUT_CKV_S + (size_t)(row - MP) * 128;
#pragma unroll
                for (int n = 0; n < 2; ++n) { const int cl = wc * 32 + n * 16 + fq * 4; const f32x4 v = acc[ai][0][m][n] * rs; ss += sum4(v * v);
                    const f32x4 g = v * *(const f32x4*)(kvnorm + cl); st_bf4(CKVG + (size_t)kvr * 128 + cl, g); *(f32x4*)(ock + cl) = g; }
                ss += __shfl_xor(ss, 16); ss += __shfl_xor(ss, 32);
                if (fq == 0) SSCKV[(size_t)row * 4 + wc] = ss;
                if (wc == 0) {
                    const int pos = pos_of(row); float* okp = row < MP ? out + OUT_KPE_P + (size_t)row * 32 : out + OUT_KPE_S + (size_t)(row - MP) * 32;
                    const f32x4 x1 = acc[ai][1][m][0] * rs, x2 = acc[ai][1][m][1] * rs; f32x4 o1, o2; float s2 = 0.f;
#pragma unroll
                    for (int j = 0; j < 4; ++j) { const f32x2 cs = rope[pos * 16 + fq * 4 + j]; o1[j] = x1[j] * cs.x - x2[j] * cs.y; o2[j] = x1[j] * cs.y + x2[j] * cs.x; }
                    s2 = sum4(o1 * o1) + sum4(o2 * o2); s2 += __shfl_xor(s2, 16); s2 += __shfl_xor(s2, 32);
                    *(f32x4*)(okp + fq * 4) = o1; *(f32x4*)(okp + 16 + fq * 4) = o2;
                    *(f32x4*)(KPEB + (size_t)kvr * 32 + fq * 4) = o1; *(f32x4*)(KPEB + (size_t)kvr * 32 + 16 + fq * 4) = o2;
                    if (fq == 0) SSK[kvr] = s2;
                }
            EPI_ROWS_END
        }
    }
};
struct EpiQ {
    static constexpr bool PERM = false, AFTER_DRAIN = false;
    const float* SSCQ; const float* qgain; const f32x2* rope; bf16_t* QF; float* SSQN; float* SSQR;
    __device__ __forceinline__ void operator()(const f32x4 (&acc)[2][2][4][2], const Unit& u, int wr, int wc, int fr, int fq) const {
        asm volatile("" : "+v"(fr), "+v"(fq));
        if (u.pn < 2) {
            const int head = u.pn * 4 + wc;
            EPI_ROWS_BEGIN
                const float rs = rsqrtf(sum4(*(const f32x4*)(SSCQ + (size_t)row * 4)) * (1.f / 256.f) + EPS); float ss = 0.f;
#pragma unroll
                for (int bj = 0; bj < 2; ++bj)
#pragma unroll
                    for (int n = 0; n < 2; ++n) { const int d = bj * 32 + n * 16 + fq * 4; const f32x4 v = acc[ai][bj][m][n] * rs; ss += sum4(v * v);
                        st_bf4(QF + (size_t)row * 768 + head * 96 + d, v * *(const f32x4*)(qgain + d)); }
                ss += __shfl_xor(ss, 16); ss += __shfl_xor(ss, 32);
                if (fq == 0) SSQN[(size_t)row * 8 + head] = ss;
            EPI_ROWS_END
        } else {
            EPI_ROWS_BEGIN
                const float rs = rsqrtf(sum4(*(const f32x4*)(SSCQ + (size_t)row * 4)) * (1.f / 256.f) + EPS); const int pos = pos_of(row);
#pragma unroll
                for (int bj = 0; bj < 2; ++bj) { const int head = 2 * wc + bj; const f32x4 x1 = acc[ai][bj][m][0] * rs, x2 = acc[ai][bj][m][1] * rs; f32x4 o1, o2;
#pragma unroll
                    for (int j = 0; j < 4; ++j) { const f32x2 cs = rope[pos * 16 + fq * 4 + j]; o1[j] = x1[j] * cs.x - x2[j] * cs.y; o2[j] = x1[j] * cs.y + x2[j] * cs.x; }
                    float ss = sum4(x1 * x1) + sum4(x2 * x2); ss += __shfl_xor(ss, 16); ss += __shfl_xor(ss, 32);
                    st_bf4(QF + (size_t)row * 768 + head * 96 + 64 + fq * 4, o1 * *(const f32x4*)(qgain + 64 + fq * 4));
                    st_bf4(QF + (size_t)row * 768 + head * 96 + 80 + fq * 4, o2 * *(const f32x4*)(qgain + 80 + fq * 4));
                    if (fq == 0) SSQR[(size_t)row * 8 + head] = ss; }
            EPI_ROWS_END
        }
    }
};
struct EpiKV {
    static constexpr bool PERM = false, AFTER_DRAIN = false;
    const float* SSCKV; const float* SSK; const float* KPEB; const float* kgain; bf16_t* KF; bf16_t* VT;
    __device__ __forceinline__ float rstd_kv(int kvr) const {
        int row;
        if (kvr < MP) row = kvr; else { const int rel = kvr - MP, b = rel / 1056, j = rel - b * 1056; if (j < 1024) return 1.f; row = MP + b * 32 + (j - 1024); }
        return rsqrtf(sum4(*(const f32x4*)(SSCKV + (size_t)row * 4)) * (1.f / 128.f) + EPS);
    }
    __device__ __forceinline__ void operator()(const f32x4 (&acc)[2][2][4][2], const Unit& u, int wr, int wc, int fr, int fq) const {
        asm volatile("" : "+v"(fr), "+v"(fq));
        if (u.pn < 2) {
            const int head = u.pn * 4 + wc;
            EPI_ROWS_BEGIN
                const float rs = rstd_kv(row); float ss = 0.f;
#pragma unroll
                for (int bj = 0; bj < 2; ++bj)
#pragma unroll
                    for (int n = 0; n < 2; ++n) { const f32x4 v = acc[ai][bj][m][n] * rs; ss += sum4(v * v); }
                ss += __shfl_xor(ss, 16); ss += __shfl_xor(ss, 32);
                const float rk = rsqrtf((ss + SSK[row]) * (1.f / 96.f) + EPS);
#pragma unroll
                for (int bj = 0; bj < 2; ++bj)
#pragma unroll
                    for (int n = 0; n < 2; ++n) { const int d = bj * 32 + n * 16 + fq * 4; st_bf4(KF + (size_t)row * 768 + head * 96 + d, acc[ai][bj][m][n] * (rs * rk) * *(const f32x4*)(kgain + d)); }
                const f32x4 p0 = *(const f32x4*)(KPEB + (size_t)row * 32 + fq * 8), p1 = *(const f32x4*)(KPEB + (size_t)row * 32 + fq * 8 + 4);
                st_bf4(KF + (size_t)row * 768 + head * 96 + 64 + fq * 8, p0 * rk * *(const f32x4*)(kgain + 64 + fq * 8));
                st_bf4(KF + (size_t)row * 768 + head * 96 + 68 + fq * 8, p1 * rk * *(const f32x4*)(kgain + 68 + fq * 8));
            EPI_ROWS_END
        } else {
            EPI_ROWS_BEGIN
                const float rs = rstd_kv(row); int seq0, key, L;
                if (row < MP) { seq0 = row & ~2047; key = row & 2047; L = 2048; } else { const int rel = row - MP, b = rel / 1056; seq0 = MP + b * 1056; key = rel - b * 1056; L = 1056; }
                bf16_t* base = VT + (size_t)seq0 * 512 + key;
#pragma unroll
                for (int bj = 0; bj < 2; ++bj)
#pragma unroll
                    for (int n = 0; n < 2; ++n) { const int c = (u.pn - 2) * 256 + bj * 128 + wc * 32 + n * 16 + fq * 4;
#pragma unroll
                        for (int j = 0; j < 4; ++j) base[(size_t)(c + j) * L] = bf1(acc[ai][bj][m][n][j] * rs); }
            EPI_ROWS_END
        }
    }
};

struct Args { const float* in[41]; float* out; unsigned char* ws; int ph_lo, ph_hi; };

__device__ __forceinline__ void tr_item(const float* W, int ldw, int col0, const float* gain, bf16_t* WT, int K, int drow0, int k0, LAS float* scr, int lane, bool zero) {
    const int c = lane & 7;
    if (zero) {
#pragma unroll
        for (int j = 0; j < 4; ++j) { const int n = (lane >> 3) + 8 * j; *(u32x4*)(WT + (size_t)(drow0 + n) * K + k0 + 8 * c) = (u32x4){0u, 0u, 0u, 0u}; }
        return;
    }
    float tv[32];
#pragma unroll
    for (int i = 0; i < 32; ++i) { const int kk = 2 * i + (lane >> 5); tv[i] = W[(size_t)(k0 + kk) * ldw + col0 + (lane & 31)]; }
    if (gain) {
#pragma unroll
        for (int i = 0; i < 32; ++i) tv[i] *= gain[k0 + 2 * i + (lane >> 5)]; }
#pragma unroll
    for (int i = 0; i < 32; ++i) scr[(2 * i + (lane >> 5)) * 33 + (lane & 31)] = tv[i];
    LDSWAIT();
#pragma unroll
    for (int j = 0; j < 4; ++j) { const int n = (lane >> 3) + 8 * j; const LAS float* s = scr + (8 * c) * 33 + n;
        u32x4 o; o.x = cvt_pk_bf16(s[0 * 33], s[1 * 33]); o.y = cvt_pk_bf16(s[2 * 33], s[3 * 33]); o.z = cvt_pk_bf16(s[4 * 33], s[5 * 33]); o.w = cvt_pk_bf16(s[6 * 33], s[7 * 33]);
        *(u32x4*)(WT + (size_t)(drow0 + n) * K + k0 + 8 * c) = o; }
    LDSWAIT();
}
__device__ __forceinline__ void sincos_d(double a, double& s, double& c) {
    const double q = rint(a * 0.6366197723675814); double r = fma(-q, 1.5707963267948966, a); r = fma(-q, 6.123233995736766e-17, r);
    const double r2 = r * r;
    const double sr = r * (1.0 + r2 * (-1.0 / 6 + r2 * (1.0 / 120 + r2 * (-1.0 / 5040 + r2 * (1.0 / 362880 + r2 * (-1.0 / 39916800 + r2 * (1.0 / 6227020800.0 + r2 * (-1.0 / 1307674368000.0))))))));
    const double cr = 1.0 + r2 * (-0.5 + r2 * (1.0 / 24 + r2 * (-1.0 / 720 + r2 * (1.0 / 40320 + r2 * (-1.0 / 3628800 + r2 * (1.0 / 479001600 + r2 * (-1.0 / 87178291200.0 + r2 * (1.0 / 20922789888000.0))))))));
    const int n = ((int)q) & 3;
    s = (n == 0) ? sr : (n == 1) ? cr : (n == 2) ? -sr : -cr;
    c = (n == 0) ? cr : (n == 1) ? -sr : (n == 2) ? -cr : sr;
}
__device__ __forceinline__ double exp_d(double x) {
    const double y = x * 0.0625; double t = 1.0 + y * (1.0 + y * (0.5 + y * (1.0 / 6 + y * (1.0 / 24 + y * (1.0 / 120 + y * (1.0 / 720 + y * (1.0 / 5040 + y * (1.0 / 40320 + y * (1.0 / 362880 + y * (1.0 / 3628800 + y * (1.0 / 39916800 + y * (1.0 / 479001600 + y * (1.0 / 6227020800.0)))))))))))));
    t *= t; t *= t; t *= t; t *= t; return t;
}

constexpr int I_GU = 16 * 176, I_DN = 44 * 32, I_AB = 16 * 80, I_ABO = 16 * 32, I_GLU = 8 * 16, I_CD = 16 * 48, I_CDO = 16 * 32, I_UQ = 4 * 24, I_UKV = 2 * 32;
constexpr int NIT = 4 * I_GU + 4 * I_DN + I_AB + I_ABO + I_GLU + I_CD + I_CDO + I_UQ + I_UKV;
constexpr int I_L0 = I_AB + I_ABO + I_GLU, I_L1 = I_CD + I_CDO + I_UQ + I_UKV, IT_MISC = 4 * I_GU + 4 * I_DN;
constexpr int NIT_A = I_GU + I_DN + I_L0, NIT_B1 = I_GU + I_DN, NIT_B2 = I_GU + I_DN + I_L1, NIT_B3 = I_GU + I_DN;
__device__ __forceinline__ int item_of(int set, int idx) {
    if (idx < I_GU) return set * I_GU + idx; idx -= I_GU;
    if (idx < I_DN) return 4 * I_GU + set * I_DN + idx; idx -= I_DN;
    return set == 0 ? IT_MISC + idx : IT_MISC + I_L0 + idx;
}
__device__ __forceinline__ void weight_item(const Args& a, unsigned char* ws, int it, LAS float* scr, int lane) {
        int r = it;
        if (r < 4 * I_GU) { const int w = r / I_GU; r -= w * I_GU; const int l = w >> 1, f2 = w & 1; const int kb = r / 176, nbk = r % 176, pn = nbk >> 3, t32 = nbk & 7, bj = t32 >> 2;
            const float* Wg = gp(a.in[f2 ? 13 : 8]) + (size_t)l * 1024 * FF; const float* Wu = gp(a.in[f2 ? 14 : 9]) + (size_t)l * 1024 * FF; const float* gn = gp(a.in[f2 ? 12 : 7]) + l * 1024;
            tr_item(bj ? Wu : Wg, FF, pn * 128 + (t32 & 3) * 32, gn, (bf16_t*)(ws + W_GU0 + w * SZ_GU), 1024, nbk * 32, kb * 64, scr, lane, false); return; }
        r -= 4 * I_GU;
        if (r < 4 * I_DN) { const int w = r / I_DN; r -= w * I_DN; const int l = w >> 1, f2 = w & 1; const int kb = r / 32, nbk = r % 32;
            tr_item(gp(a.in[f2 ? 15 : 10]) + (size_t)l * FF * 1024, 1024, nbk * 32, nullptr, (bf16_t*)(ws + W_DN0 + w * SZ_DN), FF, nbk * 32, kb * 64, scr, lane, false); return; }
        r -= 4 * I_DN;
        if (r < I_AB) { const int kb = r / 80, nbk = r % 80, pn = nbk >> 3; int col0 = nbk * 32; if (pn < 4) { const int bj = (nbk & 7) >> 2; col0 = bj * 512 + pn * 128 + (nbk & 3) * 32; }
            tr_item(gp(a.in[16]), 2560, col0, gp(a.in[11]), (bf16_t*)(ws + W_AB), 1024, nbk * 32, kb * 64, scr, lane, false); return; }
        r -= I_AB;
        if (r < I_ABO) { const int kb = r / 32, nbk = r % 32; tr_item(gp(a.in[29]), 1024, nbk * 32, nullptr, (bf16_t*)(ws + W_ABO), 1024, nbk * 32, kb * 64, scr, lane, false); return; }
        r -= I_ABO;
        if (r < I_GLU) { const int kb = r / 16, nbk = r % 16; tr_item(gp(a.in[27]), 512, nbk * 32, nullptr, (bf16_t*)(ws + W_GLU), 512, nbk * 32, kb * 64, scr, lane, false); return; }
        r -= I_GLU;
        if (r < I_CD) { const int kb = r / 48, nbk = r % 48; tr_item(gp(a.in[30]), 1440, nbk * 32, gp(a.in[11]) + 1024, (bf16_t*)(ws + W_CD), 1024, nbk * 32, kb * 64, scr, lane, nbk >= 45); return; }
        r -= I_CD;
        if (r < I_CDO) { const int kb = r / 32, nbk = r % 32; tr_item(gp(a.in[40]), 1024, nbk * 32, nullptr, (bf16_t*)(ws + W_CDO), 1024, nbk * 32, kb * 64, scr, lane, false); return; }
        r -= I_CDO;
        if (r < I_UQ) { const int kb = r / 24, nbk = r % 24, pn = nbk >> 3, t32 = nbk & 7, bj = t32 >> 2, wc = t32 & 3; const int col0 = pn < 2 ? (pn * 4 + wc) * 96 + 32 * bj : (2 * wc + bj) * 96 + 64;
            tr_item(gp(a.in[35]), 768, col0, gp(a.in[34]), (bf16_t*)(ws + W_UQ), 256, nbk * 32, kb * 64, scr, lane, false); return; }
        r -= I_UQ;
        { const int kb = r / 32, nbk = r % 32, pn = nbk >> 3, t32 = nbk & 7, bj = t32 >> 2, wc = t32 & 3; int col0;
            if (pn < 2) col0 = (pn * 4 + wc) * 128 + 32 * bj; else { const int tc0 = t32 * 32; col0 = ((pn - 2) * 4 + (tc0 >> 6)) * 128 + 64 + (tc0 & 63); }
            tr_item(gp(a.in[37]), 1024, col0, nullptr, (bf16_t*)(ws + W_UKV), 128, nbk * 32, kb * 64, scr, lane, false); }
}

__device__ __forceinline__ void prologue(const Args& a, LAS unsigned char* lds, int G, const int wvs) {
    int tid_; asm volatile("v_mbcnt_lo_u32_b32 %0, -1, 0\n\tv_mbcnt_hi_u32_b32 %0, -1, %0" : "=v"(tid_)); tid_ += wvs * 64;
    const int tid = tid_, lane = tid & 63, wave = tid >> 6, bid = blockIdx.x;
    unsigned char* ws = gp(a.ws);
    LAS float* scr = (LAS float*)(lds + wave * 16384);
    const int gw = bid * 8 + wave, NGW = G * 8;
    if (G == 256) { for (int idx = gw; idx < NIT_A; idx += NGW) weight_item(a, ws, item_of(0, idx), scr, lane); }
    else { for (int it = gw; it < NIT; it += NGW) weight_item(a, ws, it, scr, lane); }
    { bf16_t* XB = (bf16_t*)(ws + A_XB); float* SSQ = (float*)(ws + A_SSQ);
      for (int row0 = gw * 2; row0 < M; row0 += NGW * 2) {
          const float* s0 = row0 < MP ? gp(a.in[0]) + (size_t)row0 * D : gp(a.in[1]) + (size_t)(row0 - MP) * D; const float* s1 = s0 + D;
          f32x4 v0[4], v1[4]; float ss0 = 0.f, ss1 = 0.f;
#pragma unroll
          for (int j = 0; j < 4; ++j) { v0[j] = ((const f32x4*)s0)[lane + 64 * j]; v1[j] = ((const f32x4*)s1)[lane + 64 * j]; }
#pragma unroll
          for (int j = 0; j < 4; ++j) { ss0 += sum4(v0[j] * v0[j]); ss1 += sum4(v1[j] * v1[j]); st_bf4(XB + (size_t)row0 * D + (lane + 64 * j) * 4, v0[j]); st_bf4(XB + (size_t)(row0 + 1) * D + (lane + 64 * j) * 4, v1[j]); }
#pragma unroll
          for (int o = 1; o < 64; o <<= 1) { ss0 += __shfl_xor(ss0, o); ss1 += __shfl_xor(ss1, o); }
          if (lane < 4) ((f32x4*)(SSQ + (size_t)row0 * 16))[lane] = (f32x4){lane == 0 ? ss0 : 0.f, 0.f, 0.f, 0.f};
          else if (lane < 8) ((f32x4*)(SSQ + (size_t)(row0 + 1) * 16))[lane - 4] = (f32x4){lane == 4 ? ss1 : 0.f, 0.f, 0.f, 0.f};
      } }
    const int gid = bid * 512 + tid, NT = G * 512;
    for (int i = gid; i < 65536; i += NT) {
        const int g = i >> 11, c = (i >> 4) & 127, h = i & 15, p = c & 63;
        const double lr = fmin((double)gp(a.in[19])[g * 64 + p], -1e-4), li = (double)gp(a.in[20])[g * 64 + p], dt = exp_d((double)gp(a.in[21])[g]);
        double sn, cs; sincos_d(li * dt, sn, cs); const double er = exp_d(lr * dt); const double br = er * cs, bi = er * sn;
        const double nr = br - 1.0, ni = bi, den = lr * lr + li * li; const double fr_ = (nr * lr + ni * li) / den, fi_ = (ni * lr - nr * li) / den;
        const double Br = (double)gp(a.in[22])[(g * 64 + p) * 16 + h], Bi = (double)gp(a.in[23])[(g * 64 + p) * 16 + h];
        const double vr = fr_ * Br - fi_ * Bi, vi = fr_ * Bi + fi_ * Br;
        ((bf16_t*)(ws + T_BBT))[i] = bf1((float)(c < 64 ? vr : vi));
        if (h == 0 && c < 64) ((f32x2*)(ws + T_LAMBAR))[g * 64 + p] = (f32x2){(float)br, (float)bi};
    }
    for (int i = gid; i < 65536; i += NT) {
        const int g = i >> 11, h = (i >> 7) & 15, k = i & 127;
        ((bf16_t*)(ws + T_CCT))[i] = bf1(k < 64 ? gp(a.in[24])[(g * 16 + h) * 64 + k] : -gp(a.in[25])[(g * 16 + h) * 64 + (k - 64)]);
    }
    for (int i = gid; i < 32768; i += NT) {
        const int pos = i >> 4, k = i & 15; const double inv = exp_d(-(double)k * (9.210340371976184 / 16.0)); double sn, cs; sincos_d((double)pos * inv, sn, cs);
        ((f32x2*)(ws + T_ROPE))[i] = (f32x2){(float)cs, (float)sn};
    }
    for (int i = gid; i < 512; i += NT) {
        const float l0 = gp(a.in[17])[i], l1 = gp(a.in[17])[512 + i], l2 = gp(a.in[17])[1024 + i]; const float mx = fmaxf(l0, fmaxf(l1, l2));
        const float e0 = __expf(l0 - mx), e1 = __expf(l1 - mx), e2 = __expf(l2 - mx); ((float*)(ws + T_LB))[i] = e0 / (e0 + e1 + e2);
    }
    if (gid == 0) {
        float gq = 0.f, gk = 0.f; for (int d = 0; d < 96; ++d) { gq = fmaxf(gq, fabsf(gp(a.in[38])[d])); gk = fmaxf(gk, fabsf(gp(a.in[39])[d])); }
        ((float*)(ws + A_CTL))[60] = 9.797958971132712f * gq * gk * 1.001f * 1.4426950408889634f; }
    for (int i = gid; i < 65536; i += NT) {
        const int t = (i >> 7) & 127, s = i & 127; ((bf16_t*)(ws + T_WS))[i] = bf1(s <= t ? gp(a.in[32])[i] : 0.f);
    }
}

__device__ __forceinline__ void hgrn_task(const int wvs, unsigned char* ws, unsigned char* ldsg, int rowbase, int nblk, const float* S0, float* Sout, int h) {
    int tid_; asm volatile("v_mbcnt_lo_u32_b32 %0, -1, 0\n\tv_mbcnt_hi_u32_b32 %0, -1, %0" : "=v"(tid_)); tid_ += wvs * 64;
    const int tid = tid_, lane = tid & 63, w = tid >> 6, fr = lane & 15, fq = lane >> 4;
    constexpr int PITCH = 136;
    const bf16_t* QT = (const bf16_t*)(ws + R_QT); const bf16_t* KH = (const bf16_t*)(ws + R_KH); const bf16_t* KTT = (const bf16_t*)(ws + R_KTT); const bf16_t* VTT = (const bf16_t*)(ws + R_VTT);
    const float* LDEC = (const float*)(ws + R_LDEC); bf16_t* OB = (bf16_t*)(ws + R_OB);
    f32x4 S[8];
#pragma unroll
    for (int vt = 0; vt < 8; ++vt)
#pragma unroll
        for (int j = 0; j < 4; ++j) S[vt][j] = S0 ? S0[(size_t)(16 * w + 4 * fq + j) * 128 + 16 * vt + fr] : 0.f;
    const u32x2 z2 = {0u, 0u};
    bf16x8 qf[4], kf[4]; u32x2 vown, ktf, vf[8]; f32x4 dec;
#define HG_LOAD(Q, K, VO, KT, VF, DE, rb_) do { const int rbx = (rb_); const size_t gbx = (size_t)(rbx >> 4) * 8192; \
        _Pragma("unroll") for (int ks = 0; ks < 4; ++ks) { Q[ks] = *(const bf16x8*)(QT + (size_t)(rbx + fr) * 512 + h * 128 + ks * 32 + fq * 8); K[ks] = *(const bf16x8*)(KH + (size_t)(rbx + fr) * 512 + h * 128 + ks * 32 + fq * 8); } \
        VO = *(const u32x2*)(VTT + gbx + (size_t)(h * 128 + 16 * w + fr) * 16 + 4 * fq); KT = *(const u32x2*)(KTT + gbx + (size_t)(h * 128 + 16 * w + fr) * 16 + 4 * fq); \
        _Pragma("unroll") for (int vt = 0; vt < 8; ++vt) VF[vt] = *(const u32x2*)(VTT + gbx + (size_t)(h * 128 + 16 * vt + fr) * 16 + 4 * fq); \
        DE = *(const f32x4*)(LDEC + (size_t)(rbx >> 4) * 512 + h * 128 + 16 * w + 4 * fq); } while (0)
    HG_LOAD(qf, kf, vown, ktf, vf, dec, rowbase);
    for (int blk = 0; blk < nblk; ++blk) {
        const int rb = rowbase + 16 * blk;
        bf16_t* sl = (bf16_t*)(ldsg + (blk & 1) * (128 * PITCH * 2));
#pragma unroll
        for (int vt = 0; vt < 8; ++vt) st_bf4(sl + (16 * vt + fr) * PITCH + 16 * w + 4 * fq, S[vt]);
        bf16x8 qn[4], kn[4]; u32x2 vown_n, ktf_n, vfn[8]; f32x4 dec_n;
        HG_LOAD(qn, kn, vown_n, ktf_n, vfn, dec_n, rowbase + 16 * (blk + 1 < nblk ? blk + 1 : blk));
        __syncthreads();
        f32x4 o = {0.f, 0.f, 0.f, 0.f}, pt = {0.f, 0.f, 0.f, 0.f};
#pragma unroll
        for (int ks = 0; ks < 4; ++ks) { const bf16x8 sf = *(const bf16x8*)(sl + (16 * w + fr) * PITCH + ks * 32 + fq * 8); o = mfma16(qf[ks], sf, o); pt = mfma16(kf[ks], qf[ks], pt); }
#pragma unroll
        for (int j = 0; j < 4; ++j) if (4 * fq + j > fr) pt[j] = 0.f;
        u32x2 pp; pp.x = cvt_pk_bf16(pt[0], pt[1]); pp.y = cvt_pk_bf16(pt[2], pt[3]);
        o = mfma16(mk8(pp, z2), mk8(vown, z2), o);
#pragma unroll
        for (int j = 0; j < 4; ++j) OB[(size_t)(rb + 4 * fq + j) * 512 + h * 128 + 16 * w + fr] = bf1(o[j]);
        const bf16x8 ka = mk8(ktf, z2);
#pragma unroll
        for (int vt = 0; vt < 8; ++vt) { S[vt] = S[vt] * dec; S[vt] = mfma16(ka, mk8(vf[vt], z2), S[vt]); }
#pragma unroll
        for (int ks = 0; ks < 4; ++ks) { qf[ks] = qn[ks]; kf[ks] = kn[ks]; }
        vown = vown_n; ktf = ktf_n; dec = dec_n;
#pragma unroll
        for (int vt = 0; vt < 8; ++vt) vf[vt] = vfn[vt];
    }
#undef HG_LOAD
#pragma unroll
    for (int vt = 0; vt < 8; ++vt)
#pragma unroll
        for (int j = 0; j < 4; ++j) Sout[(size_t)(16 * w + 4 * fq + j) * 128 + 16 * vt + fr] = S[vt][j];
    __syncthreads();
}

__device__ __forceinline__ void hgrn_prompt(const int wvs, unsigned char* ws, unsigned char* ldsg, int rowbase, float* Sout, int h) {
    int tid_; asm volatile("v_mbcnt_lo_u32_b32 %0, -1, 0\n\tv_mbcnt_hi_u32_b32 %0, -1, %0" : "=v"(tid_)); tid_ += wvs * 64;
    const int tid = tid_, lane = tid & 63, w = tid >> 6, fr = lane & 15, fq = lane >> 4;
    constexpr int PITCH = 136, SBUF = 128 * PITCH * 2, QP = 136, SLOT = 2 * 16 * QP * 2 + 2 * 4096 + 512, NBLK = 128, DEP = 8;
    const bf16_t* QT = (const bf16_t*)(ws + R_QT); const bf16_t* KH = (const bf16_t*)(ws + R_KH); const bf16_t* KTT = (const bf16_t*)(ws + R_KTT); const bf16_t* VTT = (const bf16_t*)(ws + R_VTT);
    const float* LDEC = (const float*)(ws + R_LDEC); bf16_t* OB = (bf16_t*)(ws + R_OB);
    unsigned char* ring = ldsg + 2 * SBUF;
    const int t2 = tid & 255; const bool lo = tid < 256;
    const bf16_t* gA = (lo ? QT : KH) + (size_t)(rowbase + (t2 >> 4)) * 512 + h * 128 + (t2 & 15) * 8;
    const bf16_t* gB = (lo ? VTT : KTT) + (size_t)(rowbase >> 4) * 8192 + (size_t)h * 128 * 16 + t2 * 8;
    const float* gD = LDEC + (size_t)(rowbase >> 4) * 512 + h * 128 + (tid & 31) * 4;
    const int lA = (lo ? 0 : 16 * QP * 2) + ((t2 >> 4) * QP + (t2 & 15) * 8) * 2, lB = 2 * 16 * QP * 2 + (lo ? 0 : 4096) + t2 * 16, lD = 2 * 16 * QP * 2 + 8192 + (tid & 31) * 16;
    u32x4 ra[DEP], rb_[DEP]; f32x4 rd[DEP];
#pragma unroll
    for (int s = 0; s < DEP; ++s) { ra[s] = *(const u32x4*)(gA + (size_t)s * 8192); rb_[s] = *(const u32x4*)(gB + (size_t)s * 8192); rd[s] = *(const f32x4*)(gD + (size_t)s * 512); }
    f32x4 S[8];
#pragma unroll
    for (int vt = 0; vt < 8; ++vt) S[vt] = (f32x4){0.f, 0.f, 0.f, 0.f};
    const u32x2 z2 = {0u, 0u};
    *(u32x4*)(ring + lA) = ra[0]; *(u32x4*)(ring + lB) = rb_[0]; if (tid < 32) *(f32x4*)(ring + lD) = rd[0];
    ra[0] = *(const u32x4*)(gA + (size_t)DEP * 8192); rb_[0] = *(const u32x4*)(gB + (size_t)DEP * 8192); rd[0] = *(const f32x4*)(gD + (size_t)DEP * 512);
    for (int b0 = 0; b0 < NBLK; b0 += DEP) {
#pragma unroll
        for (int s = 0; s < DEP; ++s) {
            const int blk = b0 + s, rb = rowbase + 16 * blk;
            bf16_t* sl = (bf16_t*)(ldsg + (blk & 1) * SBUF);
#pragma unroll
            for (int vt = 0; vt < 8; ++vt) st_bf4(sl + (16 * vt + fr) * PITCH + 16 * w + 4 * fq, S[vt]);
            asm volatile("s_waitcnt lgkmcnt(0)" ::: "memory"); __builtin_amdgcn_s_barrier(); asm volatile("" ::: "memory");
            { constexpr int dummy = 0; (void)dummy; const int sn = (s + 1) % DEP; unsigned char* slot = ring + ((blk + 1) & 1) * SLOT;
              *(u32x4*)(slot + lA) = ra[sn]; *(u32x4*)(slot + lB) = rb_[sn]; if (tid < 32) *(f32x4*)(slot + lD) = rd[sn];
              const int nb = blk + 1 + DEP < NBLK ? blk + 1 + DEP : NBLK - 1;
              ra[sn] = *(const u32x4*)(gA + (size_t)nb * 8192); rb_[sn] = *(const u32x4*)(gB + (size_t)nb * 8192); rd[sn] = *(const f32x4*)(gD + (size_t)nb * 512); }
            const unsigned char* cur = ring + (blk & 1) * SLOT; const bf16_t* Qs = (const bf16_t*)cur; const bf16_t* Ks = (const bf16_t*)(cur + 16 * QP * 2); const bf16_t* Vs = (const bf16_t*)(cur + 2 * 16 * QP * 2); const bf16_t* KTs = Vs + 2048;
            const f32x4 dec = *(const f32x4*)(cur + 2 * 16 * QP * 2 + 8192 + (16 * w + 4 * fq) * 4);
            f32x4 o = {0.f, 0.f, 0.f, 0.f}, pt = {0.f, 0.f, 0.f, 0.f};
#pragma unroll
            for (int ks = 0; ks < 4; ++ks) { const bf16x8 qf = *(const bf16x8*)(Qs + fr * QP + ks * 32 + fq * 8), kf = *(const bf16x8*)(Ks + fr * QP + ks * 32 + fq * 8);
                const bf16x8 sf = *(const bf16x8*)(sl + (16 * w + fr) * PITCH + ks * 32 + fq * 8); o = mfma16(qf, sf, o); pt = mfma16(kf, qf, pt); }
#pragma unroll
            for (int j = 0; j < 4; ++j) if (4 * fq + j > fr) pt[j] = 0.f;
            u32x2 pp; pp.x = cvt_pk_bf16(pt[0], pt[1]); pp.y = cvt_pk_bf16(pt[2], pt[3]);
            o = mfma16(mk8(pp, z2), mk8(*(const u32x2*)(Vs + (16 * w + fr) * 16 + 4 * fq), z2), o);
#pragma unroll
            for (int j = 0; j < 4; ++j) OB[(size_t)(rb + 4 * fq + j) * 512 + h * 128 + 16 * w + fr] = bf1(o[j]);
            const bf16x8 ka = mk8(*(const u32x2*)(KTs + (16 * w + fr) * 16 + 4 * fq), z2);
#pragma unroll
            for (int vt = 0; vt < 8; ++vt) { S[vt] = S[vt] * dec; S[vt] = mfma16(ka, mk8(*(const u32x2*)(Vs + (16 * vt + fr) * 16 + 4 * fq), z2), S[vt]); }
        }
    }
#pragma unroll
    for (int vt = 0; vt < 8; ++vt)
#pragma unroll
        for (int j = 0; j < 4; ++j) Sout[(size_t)(16 * w + 4 * fq + j) * 128 + 16 * vt + fr] = S[vt][j];
    __syncthreads();
}

__device__ __forceinline__ void s5_task(const int wvs, unsigned char* ws, unsigned char* ldsw, const float* dvec, int rowbase, int nblk, const float* x0re, const float* x0im, float* ore, float* oim, int g) {
    int tid_; asm volatile("v_mbcnt_lo_u32_b32 %0, -1, 0\n\tv_mbcnt_hi_u32_b32 %0, -1, %0" : "=v"(tid_)); tid_ += wvs * 64;
    const int lane = tid_ & 63, fr = lane & 15, fq = lane >> 4;
    constexpr int BP = 132, XP = 136;
    float* buf = (float*)ldsw; bf16_t* xb = (bf16_t*)(ldsw + 16 * BP * 4);
    const bf16_t* UB = (const bf16_t*)(ws + R_UB); bf16_t* ZB = (bf16_t*)(ws + R_ZB);
    const f32x2 lam = ((const f32x2*)(ws + T_LAMBAR))[g * 64 + lane];
    float xr = x0re ? x0re[lane] : 0.f, xi = x0im ? x0im[lane] : 0.f;
    const u32x2 z2 = {0u, 0u};
    bf16x8 Bf[8], Cf[4];
#pragma unroll
    for (int nt = 0; nt < 8; ++nt) Bf[nt] = mk8(*(const u32x2*)((const bf16_t*)(ws + T_BBT) + (size_t)(g * 128 + 16 * nt + fr) * 16 + 4 * fq), z2);
#pragma unroll
    for (int ks = 0; ks < 4; ++ks) Cf[ks] = *(const bf16x8*)((const bf16_t*)(ws + T_CCT) + (size_t)(g * 16 + fr) * 128 + 32 * ks + 8 * fq);
    const float dv = dvec[g * 16 + fr];
    u32x2 ucur = *(const u32x2*)(UB + (size_t)(rowbase + fr) * 512 + g * 16 + 4 * fq);
    unsigned short uv[4];
#pragma unroll
    for (int j = 0; j < 4; ++j) uv[j] = UB[(size_t)(rowbase + 4 * fq + j) * 512 + g * 16 + fr];
    for (int blk = 0; blk < nblk; ++blk) {
        const int rb = rowbase + 16 * blk; const int rbn = rowbase + 16 * (blk + 1 < nblk ? blk + 1 : blk);
        const bf16x8 uf = mk8(ucur, z2);
        const u32x2 unext = *(const u32x2*)(UB + (size_t)(rbn + fr) * 512 + g * 16 + 4 * fq);
        unsigned short uvn[4];
#pragma unroll
        for (int j = 0; j < 4; ++j) uvn[j] = UB[(size_t)(rbn + 4 * fq + j) * 512 + g * 16 + fr];
#pragma unroll
        for (int nt = 0; nt < 8; ++nt) { const f32x4 d = mfma16(uf, Bf[nt], (f32x4){0.f, 0.f, 0.f, 0.f});
#pragma unroll
            for (int j = 0; j < 4; ++j) buf[(4 * fq + j) * BP + 16 * nt + fr] = d[j]; }
        LDSWAIT();
#pragma unroll
        for (int t = 0; t < 16; ++t) { const float br = buf[t * BP + lane], bi = buf[t * BP + 64 + lane];
            const float nr = lam.x * xr - lam.y * xi + br, ni = lam.x * xi + lam.y * xr + bi; xr = nr; xi = ni;
            xb[t * XP + lane] = bf1(nr); xb[t * XP + 64 + lane] = bf1(ni); }
        LDSWAIT();
        f32x4 y = {0.f, 0.f, 0.f, 0.f};
#pragma unroll
        for (int ks = 0; ks < 4; ++ks) y = mfma16(*(const bf16x8*)(xb + fr * XP + 32 * ks + 8 * fq), Cf[ks], y);
#pragma unroll
        for (int j = 0; j < 4; ++j) { const size_t idx = (size_t)(rb + 4 * fq + j) * 512 + g * 16 + fr; ZB[idx] = bf1(gelu_tanh(y[j] + dv * bf2f(uv[j]))); }
        LDSWAIT();
        ucur = unext;
#pragma unroll
        for (int j = 0; j < 4; ++j) uv[j] = uvn[j];
    }
    ore[lane] = xr; oim[lane] = xi;
}

__device__ __forceinline__ void spatial_unit(const int wvs, const Args& a, unsigned char* ldsg, int rb, int L, int gg, float* vout  ) {
    unsigned char* ws = gp(a.ws);
    int tid_; asm volatile("v_mbcnt_lo_u32_b32 %0, -1, 0\n\tv_mbcnt_hi_u32_b32 %0, -1, %0" : "=v"(tid_)); tid_ += wvs * 64;
    const int tid = tid_, lane = tid & 63, w = tid >> 6, fr = lane & 15, fq = lane >> 4;
    const int TP = L + 8, cm = (L >> 3) - 1;
    bf16_t* T = (bf16_t*)ldsg; const bf16_t* VG = (const bf16_t*)(ws + R_VG); const float* SSV = (const float*)(ws + A_SSV); bf16_t* MIX = (bf16_t*)(ws + R_MIX);
    for (int it = tid; it < L * 16; it += 512) { const int s = it >> 4, dg = it & 15; const int row = rb + s;
        const f32x4 p0 = *(const f32x4*)(SSV + (size_t)row * 8), p1 = *(const f32x4*)(SSV + (size_t)row * 8 + 4); const float rs = rsqrtf((sum4(p0) + sum4(p1)) * (1.f / 512.f) + EPS);
        const u32x4 raw = *(const u32x4*)(VG + (size_t)row * 512 + gg * 128 + dg * 8); float v[8];
        v[0] = __uint_as_float(raw.x << 16) * rs; v[1] = __uint_as_float(raw.x & 0xffff0000u) * rs; v[2] = __uint_as_float(raw.y << 16) * rs; v[3] = __uint_as_float(raw.y & 0xffff0000u) * rs;
        v[4] = __uint_as_float(raw.z << 16) * rs; v[5] = __uint_as_float(raw.z & 0xffff0000u) * rs; v[6] = __uint_as_float(raw.w << 16) * rs; v[7] = __uint_as_float(raw.w & 0xffff0000u) * rs;
#pragma unroll
        for (int i = 0; i < 8; ++i) T[(dg * 8 + i) * TP + ((((s >> 3) ^ (dg & cm)) << 3) | (s & 7))] = bf1(v[i]);
        if (vout) { *(f32x4*)(vout + (size_t)s * 512 + gg * 128 + dg * 8) = (f32x4){v[0], v[1], v[2], v[3]}; *(f32x4*)(vout + (size_t)s * 512 + gg * 128 + dg * 8 + 4) = (f32x4){v[4], v[5], v[6], v[7]}; }
    }
    __syncthreads();
    if (16 * w < L) {
        const bf16_t* WS = (const bf16_t*)(ws + T_WS) + (size_t)gg * 16384;
        f32x4 acc[8];
#pragma unroll
        for (int dt = 0; dt < 8; ++dt) acc[dt] = (f32x4){0.f, 0.f, 0.f, 0.f};
        const int nks = (16 * w + 15) / 32 + 1;
        for (int ks = 0; ks < nks; ++ks) { const bf16x8 af = *(const bf16x8*)(WS + (size_t)(16 * w + fr) * 128 + 32 * ks + 8 * fq);
#pragma unroll
            for (int dt = 0; dt < 8; ++dt) acc[dt] = mfma16(af, *(const bf16x8*)(T + (16 * dt + fr) * TP + (((4 * ks + fq) ^ ((2 * dt + (fr >> 3)) & cm)) << 3)), acc[dt]); }
#pragma unroll
        for (int j = 0; j < 4; ++j) { const int t = 16 * w + 4 * fq + j; const float bs = gp(a.in[33])[gg * 128 + t];
#pragma unroll
            for (int dt = 0; dt < 8; ++dt) { const size_t idx = (size_t)(rb + t) * 1024 + gg * 128 + 16 * dt + fr; MIX[idx] = bf1(bf2f(MIX[idx]) * (acc[dt][j] + bs)); } }
    }
    __syncthreads();
}

__device__ __forceinline__ void attn_task(const int wvs, unsigned char* ws, int qrow0, int kvrow0, int nkeys, int L, int head) {
    int tid_; asm volatile("v_mbcnt_lo_u32_b32 %0, -1, 0\n\tv_mbcnt_hi_u32_b32 %0, -1, %0" : "=v"(tid_)); tid_ += wvs * 64;
    const int lane = tid_ & 63, fr = lane & 15, fq = lane >> 4;
    const bf16_t* QF = (const bf16_t*)(ws + R_QF); const bf16_t* KF = (const bf16_t*)(ws + R_KF); const bf16_t* VT = (const bf16_t*)(ws + R_VT);
    const float* SSQN = (const float*)(ws + A_SSQN); const float* SSQR = (const float*)(ws + A_SSQR); bf16_t* MIX = (bf16_t*)(ws + R_MIX);
    const int qrow = qrow0 + fr;
    bf16x8 qf[3];
#pragma unroll
    for (int ks = 0; ks < 3; ++ks) qf[ks] = *(const bf16x8*)(QF + (size_t)qrow * 768 + head * 96 + ks * 32 + fq * 8);
    const float sc = rsqrtf((SSQN[(size_t)qrow * 8 + head] + SSQR[(size_t)qrow * 8 + head]) * (1.f / 96.f) + EPS) * (0.10206207261596575f * 1.4426950408889634f);
    float mrun = -INFINITY, lrun = 0.f; f32x4 o[4];
#pragma unroll
    for (int dt = 0; dt < 4; ++dt) o[dt] = (f32x4){0.f, 0.f, 0.f, 0.f};
    const bf16_t* kp = KF + (size_t)(kvrow0 + fr) * 768 + head * 96 + fq * 8;
    const bf16_t* vp = VT + (size_t)kvrow0 * 512 + (size_t)(head * 64 + fr) * L + 4 * fq;
    bf16x8 ka[2][3]; u32x2 va[4][2];
#define AT_LOAD(KA, VA, k0_) do { const int kx = (k0_); \
        _Pragma("unroll") for (int hf = 0; hf < 2; ++hf) _Pragma("unroll") for (int ks = 0; ks < 3; ++ks) KA[hf][ks] = *(const bf16x8*)(kp + (size_t)(kx + 16 * hf) * 768 + ks * 32); \
        _Pragma("unroll") for (int dt = 0; dt < 4; ++dt) _Pragma("unroll") for (int hf = 0; hf < 2; ++hf) VA[dt][hf] = *(const u32x2*)(vp + (size_t)dt * 16 * L + kx + 16 * hf); } while (0)
    AT_LOAD(ka, va, 0);
    for (int k0 = 0; k0 < nkeys; k0 += 32) {
        bf16x8 kn[2][3]; u32x2 vn[4][2];
        AT_LOAD(kn, vn, (k0 + 32 < nkeys ? k0 + 32 : k0));
        f32x4 st[2];
#pragma unroll
        for (int hf = 0; hf < 2; ++hf) { st[hf] = (f32x4){0.f, 0.f, 0.f, 0.f};
#pragma unroll
            for (int ks = 0; ks < 3; ++ks) st[hf] = mfma16(ka[hf][ks], qf[ks], st[hf]); }
        const f32x4 s0 = st[0] * sc, s1 = st[1] * sc;
        float mx = fmaxf(fmaxf(fmaxf(s0.x, s0.y), fmaxf(s0.z, s0.w)), fmaxf(fmaxf(s1.x, s1.y), fmaxf(s1.z, s1.w)));
        mx = fmaxf(mx, __shfl_xor(mx, 16)); mx = fmaxf(mx, __shfl_xor(mx, 32));
        const float mnew = fmaxf(mrun, mx), alpha = exp2f(mrun - mnew); mrun = mnew;
        f32x4 p0, p1;
#pragma unroll
        for (int j = 0; j < 4; ++j) { p0[j] = exp2f(s0[j] - mnew); p1[j] = exp2f(s1[j] - mnew); }
        float ls = sum4(p0) + sum4(p1); ls += __shfl_xor(ls, 16); ls += __shfl_xor(ls, 32);
        lrun = lrun * alpha + ls;
        u32x2 pa, pb; pa.x = cvt_pk_bf16(p0[0], p0[1]); pa.y = cvt_pk_bf16(p0[2], p0[3]); pb.x = cvt_pk_bf16(p1[0], p1[1]); pb.y = cvt_pk_bf16(p1[2], p1[3]);
        const bf16x8 pf = mk8(pa, pb);
#pragma unroll
        for (int dt = 0; dt < 4; ++dt) { o[dt] = o[dt] * alpha; o[dt] = mfma16(mk8(va[dt][0], va[dt][1]), pf, o[dt]); }
#pragma unroll
        for (int hf = 0; hf < 2; ++hf) {
#pragma unroll
            for (int ks = 0; ks < 3; ++ks) ka[hf][ks] = kn[hf][ks];
#pragma unroll
            for (int dt = 0; dt < 4; ++dt) va[dt][hf] = vn[dt][hf]; }
    }
#undef AT_LOAD
    const float inv = 1.f / lrun;
#pragma unroll
    for (int dt = 0; dt < 4; ++dt) st_bf4(MIX + (size_t)qrow * 1024 + 512 + head * 64 + 16 * dt + 4 * fq, o[dt] * inv);
}

__device__ __forceinline__ void attn_unit(const int wvs, unsigned char* ws, unsigned char* ldsg, int b, int head, int qb) {
    int tid_; asm volatile("v_mbcnt_lo_u32_b32 %0, -1, 0\n\tv_mbcnt_hi_u32_b32 %0, -1, %0" : "=v"(tid_)); tid_ += wvs * 64;
    const int tid = tid_, lane = tid & 63, w = tid >> 6, fr = lane & 15, fq = lane >> 4;
    constexpr int KP = 104, VP = 72, KB_BYTES = 64 * KP * 2, VB_BYTES = 64 * VP * 2;
    const bf16_t* QF = (const bf16_t*)(ws + R_QF); const bf16_t* KF = (const bf16_t*)(ws + R_KF); const bf16_t* VT = (const bf16_t*)(ws + R_VT);
    const float* SSQN = (const float*)(ws + A_SSQN); const float* SSQR = (const float*)(ws + A_SSQR); bf16_t* MIX = (bf16_t*)(ws + R_MIX);
    const int kvrow0 = b * 2048, qrow = b * 2048 + qb * 128 + w * 16 + fr;
    const int ntiles = 2 * qb + 2, mytiles = 2 * qb + 1 + (w >> 2);
    bf16x8 qf[3];
#pragma unroll
    for (int ks = 0; ks < 3; ++ks) qf[ks] = *(const bf16x8*)(QF + (size_t)qrow * 768 + head * 96 + ks * 32 + fq * 8);
    const float sc = rsqrtf((SSQN[(size_t)qrow * 8 + head] + SSQR[(size_t)qrow * 8 + head]) * (1.f / 96.f) + EPS) * (0.10206207261596575f * 1.4426950408889634f);
    float mrun = -INFINITY, lrun = 0.f; f32x4 o[4];
#pragma unroll
    for (int dt = 0; dt < 4; ++dt) o[dt] = (f32x4){0.f, 0.f, 0.f, 0.f};
    const int kr0 = tid / 12, kc0 = tid - kr0 * 12, id1 = tid + 512, kr1 = id1 / 12, kc1 = id1 - kr1 * 12; const bool has1 = tid < 256;
    const bf16_t* kg0 = KF + (size_t)(kvrow0 + kr0) * 768 + head * 96 + kc0 * 8; const bf16_t* kg1 = KF + (size_t)(kvrow0 + kr1) * 768 + head * 96 + kc1 * 8;
    const bf16_t* vg = VT + (size_t)kvrow0 * 512 + (size_t)(head * 64 + (tid >> 3)) * 2048 + (tid & 7) * 8;
    const int kl0 = kr0 * KP + kc0 * 8, kl1 = kr1 * KP + kc1 * 8, vl = (tid >> 3) * VP + (tid & 7) * 8;
    u32x4 rk0, rk1 = {0u, 0u, 0u, 0u}, rv;
    rk0 = *(const u32x4*)kg0; if (has1) rk1 = *(const u32x4*)kg1; rv = *(const u32x4*)vg;
    { bf16_t* kb = (bf16_t*)ldsg; bf16_t* vb = (bf16_t*)(ldsg + 2 * KB_BYTES);
      *(u32x4*)(kb + kl0) = rk0; if (has1) *(u32x4*)(kb + kl1) = rk1; *(u32x4*)(vb + vl) = rv; }
    asm volatile("s_waitcnt lgkmcnt(0)" ::: "memory"); __builtin_amdgcn_s_barrier(); asm volatile("" ::: "memory");
    for (int j = 0; j < ntiles; ++j) {
        const bool more = j + 1 < ntiles;
        if (more) { rk0 = *(const u32x4*)(kg0 + (size_t)(j + 1) * 64 * 768); if (has1) rk1 = *(const u32x4*)(kg1 + (size_t)(j + 1) * 64 * 768); rv = *(const u32x4*)(vg + (j + 1) * 64); }
        if (j < mytiles) {
            const bf16_t* kb = (const bf16_t*)(ldsg + (j & 1) * KB_BYTES); const bf16_t* vb = (const bf16_t*)(ldsg + 2 * KB_BYTES + (j & 1) * VB_BYTES);
            f32x4 st[4];
#pragma unroll
            for (int g = 0; g < 4; ++g) { st[g] = (f32x4){0.f, 0.f, 0.f, 0.f};
#pragma unroll
                for (int ks = 0; ks < 3; ++ks) st[g] = mfma16(*(const bf16x8*)(kb + (16 * g + fr) * KP + ks * 32 + fq * 8), qf[ks], st[g]); }
            float mx = -INFINITY;
#pragma unroll
            for (int g = 0; g < 4; ++g) { st[g] = st[g] * sc; mx = fmaxf(mx, fmaxf(fmaxf(st[g].x, st[g].y), fmaxf(st[g].z, st[g].w))); }
            mx = fmaxf(mx, __shfl_xor(mx, 16)); mx = fmaxf(mx, __shfl_xor(mx, 32));
            const float mnew = fmaxf(mrun, mx), alpha = __builtin_amdgcn_exp2f(mrun - mnew); mrun = mnew;
            float ls = 0.f;
#pragma unroll
            for (int g = 0; g < 4; ++g) {
#pragma unroll
                for (int jj = 0; jj < 4; ++jj) { st[g][jj] = __builtin_amdgcn_exp2f(st[g][jj] - mnew); ls += st[g][jj]; } }
            ls += __shfl_xor(ls, 16); ls += __shfl_xor(ls, 32);
            lrun = lrun * alpha + ls;
#pragma unroll
            for (int dt = 0; dt < 4; ++dt) o[dt] = o[dt] * alpha;
#pragma unroll
            for (int s = 0; s < 2; ++s) {
                u32x2 pa, pb; pa.x = cvt_pk_bf16(st[2 * s][0], st[2 * s][1]); pa.y = cvt_pk_bf16(st[2 * s][2], st[2 * s][3]); pb.x = cvt_pk_bf16(st[2 * s + 1][0], st[2 * s + 1][1]); pb.y = cvt_pk_bf16(st[2 * s + 1][2], st[2 * s + 1][3]);
                const bf16x8 pf = mk8(pa, pb);
#pragma unroll
                for (int dt = 0; dt < 4; ++dt) { const u32x2 v0 = *(const u32x2*)(vb + (16 * dt + fr) * VP + 32 * s + 4 * fq), v1 = *(const u32x2*)(vb + (16 * dt + fr) * VP + 32 * s + 16 + 4 * fq);
                    o[dt] = mfma16(mk8(v0, v1), pf, o[dt]); }
            }
        }
        if (more) { bf16_t* kb = (bf16_t*)(ldsg + ((j + 1) & 1) * KB_BYTES); bf16_t* vb = (bf16_t*)(ldsg + 2 * KB_BYTES + ((j + 1) & 1) * VB_BYTES);
            *(u32x4*)(kb + kl0) = rk0; if (has1) *(u32x4*)(kb + kl1) = rk1; *(u32x4*)(vb + vl) = rv; }
        asm volatile("s_waitcnt lgkmcnt(0)" ::: "memory"); __builtin_amdgcn_s_barrier(); asm volatile("" ::: "memory");
    }
    const float inv = 1.f / lrun;
#pragma unroll
    for (int dt = 0; dt < 4; ++dt) st_bf4(MIX + (size_t)qrow * 1024 + 512 + head * 64 + 16 * dt + 4 * fq, o[dt] * inv);
}

__device__ __forceinline__ void attn_unit2(const int wvs, unsigned char* ws, unsigned char* ldsg, int b, int head, int qb) {
    int tid_; asm volatile("v_mbcnt_lo_u32_b32 %0, -1, 0\n\tv_mbcnt_hi_u32_b32 %0, -1, %0" : "=v"(tid_)); tid_ += wvs * 64;
    const int tid = tid_, lane = tid & 63, w = tid >> 6, fr = lane & 15, fq = lane >> 4;
    constexpr int KP = 104, VP = 72, KB_BYTES = 64 * KP * 2, VB_BYTES = 64 * VP * 2;
    const bf16_t* QF = (const bf16_t*)(ws + R_QF); const bf16_t* KF = (const bf16_t*)(ws + R_KF); const bf16_t* VT = (const bf16_t*)(ws + R_VT);
    const float* SSQN = (const float*)(ws + A_SSQN); const float* SSQR = (const float*)(ws + A_SSQR); bf16_t* MIX = (bf16_t*)(ws + R_MIX);
    const int kvrow0 = b * 2048, qrow0 = b * 2048 + qb * 256 + w * 32 + fr;
    const int ntiles = 4 * qb + 4, mytiles = 4 * qb + 1 + (w >> 1);
    const float nsm = -((const float*)(ws + A_CTL))[60];
    bf16x8 qf[2][3]; float sc[2], mrun[2], lrun[2]; f32x4 o[2][4];
#pragma unroll
    for (int r = 0; r < 2; ++r) { const int qrow = qrow0 + 16 * r;
#pragma unroll
        for (int ks = 0; ks < 3; ++ks) qf[r][ks] = *(const bf16x8*)(QF + (size_t)qrow * 768 + head * 96 + ks * 32 + fq * 8);
        sc[r] = rsqrtf((SSQN[(size_t)qrow * 8 + head] + SSQR[(size_t)qrow * 8 + head]) * (1.f / 96.f) + EPS) * (0.10206207261596575f * 1.4426950408889634f);
#pragma unroll
        for (int ks = 0; ks < 3; ++ks) { const u32x4 qw = __builtin_bit_cast(u32x4, qf[r][ks]); u32x4 qs;
            qs.x = cvt_pk_bf16(__uint_as_float(qw.x << 16) * sc[r], __uint_as_float(qw.x & 0xffff0000u) * sc[r]); qs.y = cvt_pk_bf16(__uint_as_float(qw.y << 16) * sc[r], __uint_as_float(qw.y & 0xffff0000u) * sc[r]);
            qs.z = cvt_pk_bf16(__uint_as_float(qw.z << 16) * sc[r], __uint_as_float(qw.z & 0xffff0000u) * sc[r]); qs.w = cvt_pk_bf16(__uint_as_float(qw.w << 16) * sc[r], __uint_as_float(qw.w & 0xffff0000u) * sc[r]);
            qf[r][ks] = __builtin_bit_cast(bf16x8, qs); }
        mrun[r] = 0.f; lrun[r] = 0.f;
#pragma unroll
        for (int dt = 0; dt < 4; ++dt) o[r][dt] = (f32x4){0.f, 0.f, 0.f, 0.f}; }
    const int kr0 = tid / 12, kc0 = tid - kr0 * 12, id1 = tid + 512, kr1 = id1 / 12, kc1 = id1 - kr1 * 12; const bool has1 = tid < 256;
    const bf16_t* kg0 = KF + (size_t)(kvrow0 + kr0) * 768 + head * 96 + kc0 * 8; const bf16_t* kg1 = KF + (size_t)(kvrow0 + kr1) * 768 + head * 96 + kc1 * 8;
    const bf16_t* vg = VT + (size_t)kvrow0 * 512 + (size_t)(head * 64 + (tid >> 3)) * 2048 + (tid & 7) * 8;
    const int kl0 = kr0 * KP + kc0 * 8, kl1 = kr1 * KP + kc1 * 8, vl = (tid >> 3) * VP + (tid & 7) * 8;
#define AT_COMPUTE \
        if (j < mytiles) { \
            const bf16_t* kb = (const bf16_t*)(ldsg + (j & 1) * KB_BYTES); const bf16_t* vb = (const bf16_t*)(ldsg + 2 * KB_BYTES + (j & 1) * VB_BYTES); \
            f32x4 st[2][4]; \
_Pragma("unroll") \
            for (int g = 0; g < 4; ++g) { st[0][g] = (f32x4){nsm, nsm, nsm, nsm}; st[1][g] = (f32x4){nsm, nsm, nsm, nsm}; \
_Pragma("unroll") \
                for (int ks = 0; ks < 3; ++ks) { const bf16x8 kf = *(const bf16x8*)(kb + (16 * g + fr) * KP + ks * 32 + fq * 8); st[0][g] = mfma16(kf, qf[0][ks], st[0][g]); st[1][g] = mfma16(kf, qf[1][ks], st[1][g]); } } \
_Pragma("unroll") \
            for (int r = 0; r < 2; ++r) { \
                float ls = 0.f; \
_Pragma("unroll") \
                for (int g = 0; g < 4; ++g) { \
_Pragma("unroll") \
                    for (int jj = 0; jj < 4; ++jj) { st[r][g][jj] = __builtin_amdgcn_exp2f(st[r][g][jj]); ls += st[r][g][jj]; } } \
                lrun[r] += ls; \
            } \
_Pragma("unroll") \
            for (int s = 0; s < 2; ++s) { \
                bf16x8 pf[2]; \
_Pragma("unroll") \
                for (int r = 0; r < 2; ++r) { u32x2 pa, pb; pa.x = cvt_pk_bf16(st[r][2 * s][0], st[r][2 * s][1]); pa.y = cvt_pk_bf16(st[r][2 * s][2], st[r][2 * s][3]); \
                    pb.x = cvt_pk_bf16(st[r][2 * s + 1][0], st[r][2 * s + 1][1]); pb.y = cvt_pk_bf16(st[r][2 * s + 1][2], st[r][2 * s + 1][3]); pf[r] = mk8(pa, pb); } \
_Pragma("unroll") \
                for (int dt = 0; dt < 4; ++dt) { const u32x2 v0 = *(const u32x2*)(vb + (16 * dt + fr) * VP + 32 * s + 4 * fq), v1 = *(const u32x2*)(vb + (16 * dt + fr) * VP + 32 * s + 16 + 4 * fq); \
                    const bf16x8 vf = mk8(v0, v1); o[0][dt] = mfma16(vf, pf[0], o[0][dt]); o[1][dt] = mfma16(vf, pf[1], o[1][dt]); } \
            } \
        }
    u32x4 ak0, ak1 = {0u, 0u, 0u, 0u}, av, bk0, bk1 = {0u, 0u, 0u, 0u}, bv;
    ak0 = *(const u32x4*)kg0; if (has1) ak1 = *(const u32x4*)kg1; av = *(const u32x4*)vg;
    { bf16_t* kb = (bf16_t*)ldsg; bf16_t* vb = (bf16_t*)(ldsg + 2 * KB_BYTES);
      *(u32x4*)(kb + kl0) = ak0; if (has1) *(u32x4*)(kb + kl1) = ak1; *(u32x4*)(vb + vl) = av; }
    ak0 = *(const u32x4*)(kg0 + (size_t)64 * 768); if (has1) ak1 = *(const u32x4*)(kg1 + (size_t)64 * 768); av = *(const u32x4*)(vg + 64);
    asm volatile("s_waitcnt lgkmcnt(0)" ::: "memory"); __builtin_amdgcn_s_barrier(); asm volatile("" ::: "memory");
#define AT_STEP(JJ, LK0, LK1, LV, WK0, WK1, WV) { const int j = (JJ); \
        { const int jn = j + 2 < ntiles ? j + 2 : ntiles - 1; LK0 = *(const u32x4*)(kg0 + (size_t)jn * 64 * 768); if (has1) LK1 = *(const u32x4*)(kg1 + (size_t)jn * 64 * 768); LV = *(const u32x4*)(vg + jn * 64); } \
        AT_COMPUTE \
        { bf16_t* kb = (bf16_t*)(ldsg + ((j + 1) & 1) * KB_BYTES); bf16_t* vb = (bf16_t*)(ldsg + 2 * KB_BYTES + ((j + 1) & 1) * VB_BYTES); \
          *(u32x4*)(kb + kl0) = WK0; if (has1) *(u32x4*)(kb + kl1) = WK1; *(u32x4*)(vb + vl) = WV; } \
        asm volatile("s_waitcnt lgkmcnt(0)" ::: "memory"); __builtin_amdgcn_s_barrier(); asm volatile("" ::: "memory"); }
    for (int j2 = 0; j2 < ntiles; j2 += 2) {
        AT_STEP(j2, bk0, bk1, bv, ak0, ak1, av)
        AT_STEP(j2 + 1, ak0, ak1, av, bk0, bk1, bv)
    }
#undef AT_STEP
#undef AT_COMPUTE
#pragma unroll
    for (int r = 0; r < 2; ++r) { float lt = lrun[r]; lt += __shfl_xor(lt, 16); lt += __shfl_xor(lt, 32); const float inv = 1.f / lt;
#pragma unroll
        for (int dt = 0; dt < 4; ++dt) st_bf4(MIX + (size_t)(qrow0 + 16 * r) * 1024 + 512 + head * 64 + 16 * dt + 4 * fq, o[r][dt] * inv); }
}

__device__ __forceinline__ void attn_sample(const int wvs, unsigned char* ws, unsigned char* ldsg, int b, int head) {
    int tid_; asm volatile("v_mbcnt_lo_u32_b32 %0, -1, 0\n\tv_mbcnt_hi_u32_b32 %0, -1, %0" : "=v"(tid_)); tid_ += wvs * 64;
    const int lane = tid_ & 63, w = tid_ >> 6, fr = lane & 15, fq = lane >> 4, sub = w & 1, kq = w >> 1;
    const bf16_t* QF = (const bf16_t*)(ws + R_QF); const bf16_t* KF = (const bf16_t*)(ws + R_KF); const bf16_t* VT = (const bf16_t*)(ws + R_VT);
    const float* SSQN = (const float*)(ws + A_SSQN); const float* SSQR = (const float*)(ws + A_SSQR); bf16_t* MIX = (bf16_t*)(ws + R_MIX);
    constexpr int L = 1056;
    const int qrow = MP + b * 32 + sub * 16 + fr, kvrow0 = MP + b * L;
    const float nsm = -((const float*)(ws + A_CTL))[60];
    const float sc = rsqrtf((SSQN[(size_t)qrow * 8 + head] + SSQR[(size_t)qrow * 8 + head]) * (1.f / 96.f) + EPS) * (0.10206207261596575f * 1.4426950408889634f);
    bf16x8 qf[3];
#pragma unroll
    for (int ks = 0; ks < 3; ++ks) { const u32x4 qw = *(const u32x4*)(QF + (size_t)qrow * 768 + head * 96 + ks * 32 + fq * 8); u32x4 qs;
        qs.x = cvt_pk_bf16(__uint_as_float(qw.x << 16) * sc, __uint_as_float(qw.x & 0xffff0000u) * sc); qs.y = cvt_pk_bf16(__uint_as_float(qw.y << 16) * sc, __uint_as_float(qw.y & 0xffff0000u) * sc);
        qs.z = cvt_pk_bf16(__uint_as_float(qw.z << 16) * sc, __uint_as_float(qw.z & 0xffff0000u) * sc); qs.w = cvt_pk_bf16(__uint_as_float(qw.w << 16) * sc, __uint_as_float(qw.w & 0xffff0000u) * sc);
        qf[ks] = __builtin_bit_cast(bf16x8, qs); }
    f32x4 o[4]; float lsum = 0.f;
#pragma unroll
    for (int dt = 0; dt < 4; ++dt) o[dt] = (f32x4){0.f, 0.f, 0.f, 0.f};
    const int s0 = kq == 0 ? 0 : 9 + 8 * (kq - 1), s1 = 9 + 8 * kq;
    const bf16_t* kp = KF + (size_t)(kvrow0 + fr) * 768 + head * 96 + fq * 8;
    const bf16_t* vp = VT + (size_t)kvrow0 * 512 + (size_t)(head * 64 + fr) * L + 4 * fq;
    bf16x8 ka[2][3]; u32x2 va[4][2];
#define AS_LOAD(KA, VA, k0_) do { const int kx = (k0_); \
        _Pragma("unroll") for (int hf = 0; hf < 2; ++hf) _Pragma("unroll") for (int ks = 0; ks < 3; ++ks) KA[hf][ks] = *(const bf16x8*)(kp + (size_t)(kx + 16 * hf) * 768 + ks * 32); \
        _Pragma("unroll") for (int dt = 0; dt < 4; ++dt) _Pragma("unroll") for (int hf = 0; hf < 2; ++hf) VA[dt][hf] = *(const u32x2*)(vp + (size_t)dt * 16 * L + kx + 16 * hf); } while (0)
    AS_LOAD(ka, va, 32 * s0);
    for (int s = s0; s < s1; ++s) {
        bf16x8 kn[2][3]; u32x2 vn[4][2];
        AS_LOAD(kn, vn, 32 * (s + 1 < s1 ? s + 1 : s));
        f32x4 st[2];
#pragma unroll
        for (int hf = 0; hf < 2; ++hf) { st[hf] = (f32x4){nsm, nsm, nsm, nsm};
#pragma unroll
            for (int ks = 0; ks < 3; ++ks) st[hf] = mfma16(ka[hf][ks], qf[ks], st[hf]); }
#pragma unroll
        for (int hf = 0; hf < 2; ++hf)
#pragma unroll
            for (int j = 0; j < 4; ++j) { st[hf][j] = __builtin_amdgcn_exp2f(st[hf][j]); lsum += st[hf][j]; }
        u32x2 pa, pb; pa.x = cvt_pk_bf16(st[0][0], st[0][1]); pa.y = cvt_pk_bf16(st[0][2], st[0][3]); pb.x = cvt_pk_bf16(st[1][0], st[1][1]); pb.y = cvt_pk_bf16(st[1][2], st[1][3]);
        const bf16x8 pf = mk8(pa, pb);
#pragma unroll
        for (int dt = 0; dt < 4; ++dt) o[dt] = mfma16(mk8(va[dt][0], va[dt][1]), pf, o[dt]);
#pragma unroll
        for (int hf = 0; hf < 2; ++hf) {
#pragma unroll
            for (int ks = 0; ks < 3; ++ks) ka[hf][ks] = kn[hf][ks];
#pragma unroll
            for (int dt = 0; dt < 4; ++dt) va[dt][hf] = vn[dt][hf]; }
    }
#undef AS_LOAD
    float* part = (float*)ldsg + (size_t)(w * 64 + lane) * 17;
#pragma unroll
    for (int dt = 0; dt < 4; ++dt)
#pragma unroll
        for (int j = 0; j < 4; ++j) part[dt * 4 + j] = o[dt][j];
    part[16] = lsum;
    __syncthreads();
    if (kq == 0) {
#pragma unroll
        for (int q2 = 1; q2 < 4; ++q2) { const float* pp = (const float*)ldsg + (size_t)((sub + 2 * q2) * 64 + lane) * 17;
#pragma unroll
            for (int dt = 0; dt < 4; ++dt)
#pragma unroll
                for (int j = 0; j < 4; ++j) o[dt][j] += pp[dt * 4 + j];
            lsum += pp[16]; }
        lsum += __shfl_xor(lsum, 16); lsum += __shfl_xor(lsum, 32);
        const float inv = 1.f / lsum;
#pragma unroll
        for (int dt = 0; dt < 4; ++dt) st_bf4(MIX + (size_t)qrow * 1024 + 512 + head * 64 + 16 * dt + 4 * fq, o[dt] * inv);
    }
    __syncthreads();
}

struct OneUnit { int pm, pn; bool has;
    __device__ __forceinline__ bool next(int i, Unit& u) const { if (i != 0 || !has) return false; u.pm = pm; u.pn = pn; return true; }
    __device__ __forceinline__ void a_ready(const Unit&) const {}
    __device__ __forceinline__ void done(const Unit&) const {} };
struct EpiPart { static constexpr bool PERM = false, AFTER_DRAIN = false; float* P;
    __device__ __forceinline__ void operator()(const f32x4 (&acc)[2][2][4][2], const Unit& u, int wr, int wc, int fr, int fq) const {
        asm volatile("" : "+v"(fr), "+v"(fq));
        const int t = (wr * 4 + wc) * 64 + fq * 16 + fr;
#pragma unroll
        for (int ai = 0; ai < 2; ++ai)
#pragma unroll
            for (int bj = 0; bj < 2; ++bj)
#pragma unroll
                for (int m = 0; m < 4; ++m)
#pragma unroll
                    for (int n = 0; n < 2; ++n) *(f32x4*)(P + ((size_t)((((ai * 2 + bj) * 4 + m) * 2 + n) * 512 + t)) * 4) = acc[ai][bj][m][n];
    } };
__device__ __forceinline__ void res_gemm(const int wvs, LAS unsigned char* ldsl, const bf16_t* A, const bf16_t* Bt, int K, int KS, const EpiRes& E, float* part, unsigned* cnt, int G, int bid) {
    const int NS = K / KS, NSU = 16 * NS;
    if (G < NSU || G * 8 < 1024) {
        pg8::Gemm g{A, Bt, M, 1024, K}; pg8::StaticOrder S; S.init(M, 1024, G, bid); pg8::gemm_phase<EpiRes, pg8::StaticOrder, true, true>(ldsl, g, S, E, wvs); return; }
    { const int su = bid, unit = su / NS, sl = su - unit * NS;
      pg8::Gemm g{A + (size_t)MP * K + (size_t)sl * KS, Bt + (size_t)sl * KS, MS, 1024, K, KS}; OneUnit S{unit >> 2, unit & 3, su < NSU};
      EpiPart EP{part + (size_t)su * 65536};
      pg8::gemm_phase<EpiPart, OneUnit, false, true>(ldsl, g, S, EP, wvs);
      int tid_; asm volatile("v_mbcnt_lo_u32_b32 %0, -1, 0\n\tv_mbcnt_hi_u32_b32 %0, -1, %0" : "=v"(tid_)); tid_ += wvs * 64;
      if (su < NSU) { asm volatile("s_waitcnt vmcnt(0)" ::: "memory"); __syncthreads();
          if (tid_ == 0) { __builtin_amdgcn_fence(__ATOMIC_RELEASE, "agent"); asm volatile("s_waitcnt vmcnt(0)" ::: "memory"); __hip_atomic_fetch_add(cnt, 1u, __ATOMIC_RELAXED, __HIP_MEMORY_SCOPE_AGENT); } } }
    { pg8::Gemm g{A, Bt, MP, 1024, K}; pg8::StaticOrder S; S.init(MP, 1024, G, bid); pg8::gemm_phase<EpiRes, pg8::StaticOrder, true, true>(ldsl, g, S, E, wvs); }
    { int lane_; asm volatile("v_mbcnt_lo_u32_b32 %0, -1, 0\n\tv_mbcnt_hi_u32_b32 %0, -1, %0" : "=v"(lane_));
      const int gw = bid * 8 + wvs;
      if (gw < 1024) {
          if (lane_ == 0) { while (__hip_atomic_load(cnt, __ATOMIC_RELAXED, __HIP_MEMORY_SCOPE_AGENT) < (unsigned)NSU) __builtin_amdgcn_s_sleep(2); }
          __builtin_amdgcn_fence(__ATOMIC_ACQUIRE, "agent"); asm volatile("s_waitcnt vmcnt(0)" ::: "memory");
          const int unit = gw >> 6, am = (gw >> 3) & 7, wv = gw & 7, ai = am >> 2, m = am & 3, t = wv * 64 + lane_, wr = wv >> 2, wc = wv & 3, fr = lane_ & 15, fq = lane_ >> 4;
          f32x4 v[2][2];
#pragma unroll
          for (int bj = 0; bj < 2; ++bj)
#pragma unroll
              for (int n = 0; n < 2; ++n) v[bj][n] = (f32x4){0.f, 0.f, 0.f, 0.f};
#pragma unroll 4
          for (int s = 0; s < NS; ++s) { const float* P = part + (size_t)(unit * NS + s) * 65536;
#pragma unroll
              for (int bj = 0; bj < 2; ++bj)
#pragma unroll
                  for (int n = 0; n < 2; ++n) v[bj][n] += *(const f32x4*)(P + ((size_t)((((ai * 2 + bj) * 4 + m) * 2 + n) * 512 + t)) * 4); }
          E.do_row((128 + (unit >> 2)) * 256 + ai * 128 + wr * 64 + m * 16 + fr, unit & 3, wc, fq, v[0][0], v[0][1], v[1][0], v[1][1]);
      } }
}

__device__ __forceinline__ void grid_bar(unsigned* ctl, unsigned k, const int wvs) {
    int tid_; asm volatile("v_mbcnt_lo_u32_b32 %0, -1, 0\n\tv_mbcnt_hi_u32_b32 %0, -1, %0" : "=v"(tid_)); tid_ += wvs * 64;
    asm volatile("s_waitcnt vmcnt(0) lgkmcnt(0)" ::: "memory");
    __syncthreads();
    if (tid_ == 0) {
        const unsigned G = gridDim.x;
        __builtin_amdgcn_fence(__ATOMIC_RELEASE, "agent");
        asm volatile("s_waitcnt vmcnt(0)" ::: "memory");
        if ((G & 7u) == 0u) {
            const unsigned x = blockIdx.x & 7u, gs = G >> 3; unsigned* arr = ctl + 256 + 64 * x; unsigned* rel = ctl + 1024 + 64 * x; unsigned* top = ctl + 128;
            const unsigned old = __hip_atomic_fetch_add(arr, 1u, __ATOMIC_RELAXED, __HIP_MEMORY_SCOPE_AGENT);
            if (old + 1u == gs * k) {
                __hip_atomic_fetch_add(top, 1u, __ATOMIC_RELAXED, __HIP_MEMORY_SCOPE_AGENT);
                while (__hip_atomic_load(top, __ATOMIC_RELAXED, __HIP_MEMORY_SCOPE_AGENT) < 8u * k) __builtin_amdgcn_s_sleep(1);
                __hip_atomic_fetch_add(rel, 1u, __ATOMIC_RELAXED, __HIP_MEMORY_SCOPE_AGENT);
            } else { while (__hip_atomic_load(rel, __ATOMIC_RELAXED, __HIP_MEMORY_SCOPE_AGENT) < k) __builtin_amdgcn_s_sleep(1); }
        } else {
            __hip_atomic_fetch_add(ctl, 1u, __ATOMIC_RELAXED, __HIP_MEMORY_SCOPE_AGENT);
            while (__hip_atomic_load(ctl, __ATOMIC_RELAXED, __HIP_MEMORY_SCOPE_AGENT) < G * k) __builtin_amdgcn_s_sleep(2);
        }
        __builtin_amdgcn_fence(__ATOMIC_ACQUIRE, "agent");
        asm volatile("s_waitcnt vmcnt(0)" ::: "memory");
    }
    __syncthreads();
}

#define XB_TMO      128
#define XB_XCNT(j)  (256  + 64 * (j))
#define XB_XSUB(j)  (1280 + 64 * (j))
#define XB_XGEN(j)  (2304 + 64 * (j))
#define XB_TOP      3328
#define XB_TOPGEN   3392
#define XCD_BAR_WORDS 3456
#define XB_SPIN_CAP (1u << 18)

__device__ __forceinline__ unsigned xb_ld(unsigned* p)              { return __hip_atomic_load(p, __ATOMIC_RELAXED, __HIP_MEMORY_SCOPE_AGENT); }
__device__ __forceinline__ unsigned xb_add(unsigned* p, unsigned v) { return __hip_atomic_fetch_add(p, v, __ATOMIC_RELAXED, __HIP_MEMORY_SCOPE_AGENT); }
__device__ __forceinline__ unsigned xb_xcc_id() { return (unsigned)__builtin_amdgcn_s_getreg((3 << 11) | 20) & 0xFu; }
#define XB_SPIN(cond, bar) do { unsigned _sp = 0; while (cond) { __builtin_amdgcn_s_sleep(1); \
    if ((++_sp & 255u) == 0u) { if (xb_ld(&(bar)[XB_TMO])) break; if (_sp > XB_SPIN_CAP) { atomicAdd(&(bar)[XB_TMO], 1u); break; } } } } while (0)

struct XcdBarrier {
    unsigned* bar; unsigned x;
    volatile LAS unsigned* st;
};

__device__ __forceinline__ XcdBarrier xcd_barrier_post(unsigned* bar, volatile LAS unsigned* st, const bool is_t0) {
    XcdBarrier b; b.bar = bar; b.x = xb_xcc_id(); b.st = st;
    if (is_t0) (void)xb_add(&bar[XB_XCNT(b.x)], 1u);
    return b;
}
__device__ __forceinline__ void xcd_barrier_complete(unsigned* bar, unsigned x, unsigned& nloc, unsigned& nx) {
    const unsigned G = gridDim.x * gridDim.y * gridDim.z;
    unsigned sum, cnt, mine, sp = 0u;
    for (;;) {
        sum = 0u; cnt = 0u; mine = 0u;
#pragma unroll
        for (unsigned j = 0; j < 16; ++j) { const unsigned c = xb_ld(&bar[XB_XCNT(j)]); sum += c; cnt += (c > 0u) ? 1u : 0u; mine = (j == x) ? c : mine; }
        if (sum == G) break;
        __builtin_amdgcn_s_sleep(1);
        if ((++sp & 255u) == 0u) { if (xb_ld(&bar[XB_TMO])) break; if (sp > XB_SPIN_CAP) { atomicAdd(&bar[XB_TMO], 1u); break; } }
    }
    nloc = mine > 0u ? mine : 1u; nx = cnt > 0u ? cnt : 1u;
}

__device__ __forceinline__ void xcd_barrier(const XcdBarrier& b, const int wvs) {
    int tid_; asm volatile("v_mbcnt_lo_u32_b32 %0, -1, 0\n\tv_mbcnt_hi_u32_b32 %0, -1, %0" : "=v"(tid_)); tid_ += wvs * 64;
    asm volatile("s_waitcnt vmcnt(0)" ::: "memory");
    __syncthreads();
    if (tid_ == 0) {
        unsigned* bar = b.bar;
        __builtin_amdgcn_s_waitcnt(0);
        unsigned nloc = b.st[0], nx = b.st[1];
        if (nloc == 0u) { xcd_barrier_complete(bar, b.x, nloc, nx); b.st[0] = nloc; b.st[1] = nx; }
        const unsigned old = xb_add(&bar[XB_XSUB(b.x)], 1u);
        const unsigned gen = old / nloc;
        if (old + 1u == (gen + 1u) * nloc) {
            __builtin_amdgcn_fence(__ATOMIC_RELEASE, "agent");
            asm volatile("s_waitcnt vmcnt(0)" ::: "memory");
            const unsigned og = xb_add(&bar[XB_TOP], 1u);
            const unsigned tg = og / nx;
            if (og + 1u == (tg + 1u) * nx) xb_add(&bar[XB_TOPGEN], 1u);
            else XB_SPIN(xb_ld(&bar[XB_TOPGEN]) == tg, bar);
            __builtin_amdgcn_fence(__ATOMIC_ACQUIRE, "agent");
            xb_add(&bar[XB_XGEN(b.x)], 1u);
            asm volatile("s_waitcnt vmcnt(0)" ::: "memory");
        } else {
            XB_SPIN(xb_ld(&bar[XB_XGEN(b.x)]) == gen, bar);
            __builtin_amdgcn_fence(__ATOMIC_ACQUIRE, "agent");
            asm volatile("s_waitcnt vmcnt(0)" ::: "memory");
        }
    }
    __syncthreads();
}

__global__ void __launch_bounds__(512, 2) mk_fwd(Args args) {
    extern __shared__ __attribute__((aligned(16))) unsigned char lds[];
    const int wvs = __builtin_amdgcn_readfirstlane((int)threadIdx.x >> 6);
    if (threadIdx.x < 8) ((LAS unsigned*)((LAS unsigned char*)lds + 131072))[threadIdx.x] = 0u;
    __syncthreads();
    const XcdBarrier xbar = xcd_barrier_post((unsigned*)(args.ws + A_CTL), (volatile LAS unsigned*)((LAS unsigned char*)lds + 131072), threadIdx.x == 0);
    const int lo = args.ph_lo, hi = args.ph_hi;
#if MK_PER_PHASE
#define SEAM(k) do { } while (0)
#else
#define SEAM(k) do { if (lo <= (k) && (k) + 1 < hi) { if ((k) == 0) cg::this_grid().sync(); else { xcd_barrier(xbar, wvs); } } } while (0)
#endif
#define IN(k) (lo <= (k) && (k) < hi)
#define PH_VARS size_t zoff_ = 0; asm volatile("" : "+s"(zoff_)); unsigned char* ws = args.ws + zoff_; float* out = args.out + zoff_; \
    LAS unsigned char* ldsl = (LAS unsigned char*)lds; const int bid = blockIdx.x, G = gridDim.x; \
    bf16_t* XB = (bf16_t*)(ws + A_XB); float* SSQ = (float*)(ws + A_SSQ); bf16_t* ACT = (bf16_t*)(ws + R_ACT); bf16_t* MIX = (bf16_t*)(ws + R_MIX); float* Y = out + OUT_Y; \
    (void)XB; (void)SSQ; (void)ACT; (void)MIX; (void)Y; (void)ldsl; (void)bid; (void)G;
#define PH_TID int tid_; asm volatile("v_mbcnt_lo_u32_b32 %0, -1, 0\n\tv_mbcnt_hi_u32_b32 %0, -1, %0" : "=v"(tid_)); tid_ += wvs * 64; const int lane = tid_ & 63, wave = tid_ >> 6; (void)lane; (void)wave;

    if (IN(0)) for (int rep_ = 0; rep_ < (REP_PH == 0 ? 2 : 1); ++rep_) { PH_VARS prologue(args, ldsl, G, wvs); } SEAM(0);

#define HOST_ITEMS(set, nset, first_idle) do { if (G == 256 && bid >= (first_idle)) { PH_TID \
        for (int idx = (bid - (first_idle)) * 8 + wave; idx < (nset); idx += (256 - (first_idle)) * 8) weight_item(args, ws, item_of((set), idx), (LAS float*)(ldsl + wave * 16384), lane); } } while (0)
#define FFN_UP(ph, widx) if (IN(ph)) for (int rep_ = 0; rep_ < (REP_PH == (ph) ? 2 : 1); ++rep_) { PH_VARS pg8::Gemm g{XB, (const bf16_t*)(ws + W_GU0 + (size_t)(widx) * SZ_GU), M, 5632, 1024}; pg8::StaticOrder S; S.init(M, 5632, G, bid); \
        EpiGU E{SSQ, ACT}; pg8::gemm_phase<EpiGU, pg8::StaticOrder, true, true>(ldsl, g, S, E, wvs); \
        if ((ph) == 1) HOST_ITEMS(1, NIT_B1, 88); if ((ph) == 7) HOST_ITEMS(3, NIT_B3, 88); } SEAM(ph);
#define FFN_DN(ph, widx, x0, x1) if (IN(ph)) for (int rep_ = 0; rep_ < (REP_PH == (ph) ? 2 : 1); ++rep_) { PH_VARS \
        EpiRes E{x0, x1, Y, XB, SSQ, 0.5f}; res_gemm(wvs, ldsl, ACT, (const bf16_t*)(ws + W_DN0 + (size_t)(widx) * SZ_DN), FF, 256, E, (float*)(ws + R_PART), (unsigned*)(ws + A_CTL) + 8 + (ph), G, bid); } SEAM(ph);
#define MIX_OUT(ph, woff) if (IN(ph)) { PH_VARS \
        EpiRes E{Y, Y + (size_t)MP * D, Y, XB, SSQ, 1.0f}; res_gemm(wvs, ldsl, MIX, (const bf16_t*)(ws + (woff)), 1024, 256, E, (float*)(ws + R_PART), (unsigned*)(ws + A_CTL) + 8 + (ph), G, bid); } SEAM(ph);

    FFN_UP(1, 0)
    FFN_DN(2, 0, gp(args.in[0]), gp(args.in[1]))
    if (IN(3)) { PH_VARS pg8::Gemm g{XB, (const bf16_t*)(ws + W_AB), M, 2560, 1024}; pg8::StaticOrder S; S.init(M, 2560, G, bid);
        EpiAB E{SSQ, (const float*)(ws + T_LB), (bf16_t*)(ws + R_QT), (bf16_t*)(ws + R_KH), (bf16_t*)(ws + R_KTT), (bf16_t*)(ws + R_VTT), (bf16_t*)(ws + R_GB), (bf16_t*)(ws + R_UB), (float*)(ws + R_LDEC)};
        pg8::gemm_phase<EpiAB, pg8::StaticOrder, true, true>(ldsl, g, S, E, wvs); HOST_ITEMS(2, NIT_B2, 40); } SEAM(3);
    if (IN(4)) for (int rep_ = 0; rep_ < (REP_PH == 4 ? 2 : 1); ++rep_) { PH_VARS PH_TID
        for (int task = bid; task < 256; task += G) {
            if (task < 128) {
                { const int b = task >> 2, h = task & 3; hgrn_task(wvs, ws, lds, MP + b * 32, 2, gp(args.in[2]) + (size_t)(b * 4 + h) * 16384, out + OUT_HGRN_S + (size_t)(b * 4 + h) * 16384, h); }
                { const int id = task * 8 + wave, b = id >> 5, g = id & 31; s5_task(wvs, ws, lds + wave * 16384, gp(args.in[26]), MP + b * 32, 2, gp(args.in[3]) + (size_t)(b * 32 + g) * 64, gp(args.in[4]) + (size_t)(b * 32 + g) * 64,
                          out + OUT_S5RE_S + (size_t)(b * 32 + g) * 64, out + OUT_S5IM_S + (size_t)(b * 32 + g) * 64, g); }
                __syncthreads();
            } else if (task < 192) {
                const int i = task - 128, b = i >> 2, h = i & 3; for (int r2 = 0; r2 < (REP_PH == 40 ? 2 : 1); ++r2) hgrn_prompt(wvs, ws, lds, b * 2048, out + OUT_HGRN_P + (size_t)(b * 4 + h) * 16384, h);
            } else {
                if (wave < 4) { const int id = (task - 192) * 4 + wave, b = id >> 5, g = id & 31; for (int r2 = 0; r2 < (REP_PH == 41 ? 2 : 1); ++r2) s5_task(wvs, ws, lds + wave * 16384, gp(args.in[26]), b * 2048, 128, nullptr, nullptr, out + OUT_S5RE_P + (size_t)(b * 32 + g) * 64, out + OUT_S5IM_P + (size_t)(b * 32 + g) * 64, g); }
                __syncthreads();
            }
            if (task < 64 && G == 256) {
                if (wave < 4) { const int id = 256 + task * 4 + wave, b = id >> 5, g = id & 31; s5_task(wvs, ws, lds + wave * 16384, gp(args.in[26]), b * 2048, 128, nullptr, nullptr, out + OUT_S5RE_P + (size_t)(b * 32 + g) * 64, out + OUT_S5IM_P + (size_t)(b * 32 + g) * 64, g); }
                __syncthreads();
            }
        }
        if (G != 256) {
            for (int t2 = bid; t2 < 64; t2 += G) { if (wave < 4) { const int id = 256 + t2 * 4 + wave, b = id >> 5, g = id & 31; s5_task(wvs, ws, lds + wave * 16384, gp(args.in[26]), b * 2048, 128, nullptr, nullptr, out + OUT_S5RE_P + (size_t)(b * 32 + g) * 64, out + OUT_S5IM_P + (size_t)(b * 32 + g) * 64, g); } __syncthreads(); }
        }
    } SEAM(4);
    if (IN(5)) { PH_VARS
        { pg8::Gemm g{(const bf16_t*)(ws + R_ZB), (const bf16_t*)(ws + W_GLU), M, 512, 512}; pg8::StaticOrder S; S.init(M, 512, G, bid);
          EpiGLU E{(const bf16_t*)(ws + R_ZB), gp(args.in[28]), MIX}; pg8::gemm_phase<EpiGLU, pg8::StaticOrder, true, true>(ldsl, g, S, E, wvs); }
        PH_TID
        const bf16_t* OB = (const bf16_t*)(ws + R_OB); const bf16_t* GB = (const bf16_t*)(ws + R_GB);
        const f32x4 og0 = *(const f32x4*)(gp(args.in[18]) + (lane & 15) * 8), og1 = *(const f32x4*)(gp(args.in[18]) + (lane & 15) * 8 + 4);
        const int nx5 = (264 > G && 264 - G < G / 2) ? 264 - G : 0;
        for (int row = (bid - nx5) * 8 + wave; row < M; row += (G - nx5) * 8) { if (bid < nx5) break;
            const u32x4 ov = *(const u32x4*)(OB + (size_t)row * 512 + lane * 8), gv = *(const u32x4*)(GB + (size_t)row * 512 + lane * 8);
            f32x4 a0, a1, g0, g1;
            a0.x = __uint_as_float(ov.x << 16); a0.y = __uint_as_float(ov.x & 0xffff0000u); a0.z = __uint_as_float(ov.y << 16); a0.w = __uint_as_float(ov.y & 0xffff0000u);
            a1.x = __uint_as_float(ov.z << 16); a1.y = __uint_as_float(ov.z & 0xffff0000u); a1.z = __uint_as_float(ov.w << 16); a1.w = __uint_as_float(ov.w & 0xffff0000u);
            g0.x = __uint_as_float(gv.x << 16); g0.y = __uint_as_float(gv.x & 0xffff0000u); g0.z = __uint_as_float(gv.y << 16); g0.w = __uint_as_float(gv.y & 0xffff0000u);
            g1.x = __uint_as_float(gv.z << 16); g1.y = __uint_as_float(gv.z & 0xffff0000u); g1.z = __uint_as_float(gv.w << 16); g1.w = __uint_as_float(gv.w & 0xffff0000u);
            float ss = sum4(a0 * a0) + sum4(a1 * a1);
            ss += __shfl_xor(ss, 1); ss += __shfl_xor(ss, 2); ss += __shfl_xor(ss, 4); ss += __shfl_xor(ss, 8);
            const float rs = rsqrtf(ss * (1.f / 128.f) + EPS);
            const f32x4 r0 = a0 * rs * og0 * g0, r1 = a1 * rs * og1 * g1;
            u32x4 w4; w4.x = cvt_pk_bf16(r0.x, r0.y); w4.y = cvt_pk_bf16(r0.z, r0.w); w4.z = cvt_pk_bf16(r1.x, r1.y); w4.w = cvt_pk_bf16(r1.z, r1.w);
            *(u32x4*)(MIX + (size_t)row * 1024 + lane * 8) = w4;
        }
    } SEAM(5);
    MIX_OUT(6, W_ABO)
    FFN_UP(7, 1)
    FFN_DN(8, 1, Y, Y + (size_t)MP * D)
    FFN_UP(9, 2)
    FFN_DN(10, 2, Y, Y + (size_t)MP * D)
    if (IN(11)) { PH_VARS pg8::Gemm g{XB, (const bf16_t*)(ws + W_CD), M, 1536, 1024}; pg8::StaticOrder S; S.init(M, 1536, G, bid);
        EpiCD E{SSQ, gp(args.in[31]), gp(args.in[36]), (const f32x2*)(ws + T_ROPE), MIX, (bf16_t*)(ws + R_VG), (float*)(ws + A_SSV), (bf16_t*)(ws + R_CQB), (float*)(ws + A_SSCQ), (bf16_t*)(ws + R_CKVG), (float*)(ws + A_SSCKV), (float*)(ws + R_KPEB), (float*)(ws + A_SSK), out};
        pg8::gemm_phase<EpiCD, pg8::StaticOrder, true, true>(ldsl, g, S, E, wvs);
        PH_TID
        bf16_t* CKVG = (bf16_t*)(ws + R_CKVG); float* KPEB = (float*)(ws + R_KPEB); float* SSK = (float*)(ws + A_SSK);
        const int nx11 = (792 % G != 0 && 792 % G < G / 2) ? 792 % G : 0;
        for (int r = (bid - nx11) * 8 + wave; r < 32 * 1024; r += (G - nx11) * 8) { if (bid < nx11) break; const int b = r >> 10, j = r & 1023, kvr = MP + b * 1056 + j;
            const f32x2 c2 = *(const f32x2*)(gp(args.in[5]) + (size_t)r * 128 + lane * 2); ((unsigned*)(CKVG + (size_t)kvr * 128))[lane] = cvt_pk_bf16(c2.x, c2.y);
            float kv = 0.f; if (lane < 32) { kv = gp(args.in[6])[(size_t)r * 32 + lane]; KPEB[(size_t)kvr * 32 + lane] = kv; }
            float ss = kv * kv;
#pragma unroll
            for (int o = 1; o < 64; o <<= 1) ss += __shfl_xor(ss, o);
            if (lane == 0) SSK[kvr] = ss; }
    } SEAM(11);
    if (IN(12)) { PH_VARS
        { pg8::Gemm g{(const bf16_t*)(ws + R_CQB), (const bf16_t*)(ws + W_UQ), M, 768, 256}; pg8::StaticOrder S; S.init(M, 768, G, bid);
          EpiQ E{(const float*)(ws + A_SSCQ), gp(args.in[38]), (const f32x2*)(ws + T_ROPE), (bf16_t*)(ws + R_QF), (float*)(ws + A_SSQN), (float*)(ws + A_SSQR)};
          pg8::gemm_phase<EpiQ, pg8::StaticOrder, true, true>(ldsl, g, S, E, wvs); }
        { pg8::Gemm g{(const bf16_t*)(ws + R_CKVG), (const bf16_t*)(ws + W_UKV), KVR, 1024, 128}; pg8::StaticOrder S; S.init(KVR, 1024, G, bid);
          EpiKV E{(const float*)(ws + A_SSCKV), (const float*)(ws + A_SSK), (const float*)(ws + R_KPEB), gp(args.in[39]), (bf16_t*)(ws + R_KF), (bf16_t*)(ws + R_VT)};
          pg8::gemm_phase<EpiKV, pg8::StaticOrder, true, true>(ldsl, g, S, E, wvs); }
        PH_TID
        const float* SSCKV = (const float*)(ws + A_SSCKV);
        for (int row = bid * 8 + wave; row < M; row += G * 8) { const float rs = rsqrtf(sum4(*(const f32x4*)(SSCKV + (size_t)row * 4)) * (1.f / 128.f) + EPS);
            float* p = row < MP ? out + OUT_CKV_P + (size_t)row * 128 : out + OUT_CKV_S + (size_t)(row - MP) * 128; f32x2 v = *(f32x2*)(p + lane * 2); v.x *= rs; v.y *= rs; *(f32x2*)(p + lane * 2) = v; }
    } SEAM(12);
    if (IN(13)) { PH_VARS PH_TID
        for (int un = bid; un < 1024 + 128; un += G) {
            if (un < 1024) { const int gg = un & 3, ch = (un >> 2) & 15, b = un >> 6; spatial_unit(wvs, args, lds, b * 2048 + ch * 128, 128, gg, ch == 15 ? out + OUT_GV_P + (size_t)b * 128 * 512 : nullptr); }
            else { const int i = un - 1024, gg = i & 3, b = i >> 2; spatial_unit(wvs, args, lds, MP + b * 32, 32, gg, out + OUT_GV_S + (size_t)b * 32 * 512); }
        }
        const int gw = bid * 8 + wave, NGW = G * 8;
        for (int rep_ = 0; rep_ < (REP_PH == 13 ? 2 : 1); ++rep_) {
        if ((G & 7) == 0) { const int x = bid & 7, y = bid >> 3, PW = G >> 3;
            for (int slot = y; slot < 64; slot += PW) { const int combo = x * 16 + (slot >> 2), qbl = slot & 3, b = combo >> 3, head = combo & 7;
                attn_unit2(wvs, ws, lds, b, head, qbl); attn_unit2(wvs, ws, lds, b, head, 7 - qbl); } }
        else { for (int pu = bid; pu < 512; pu += G) { const int qbl = pu & 3, head = (pu >> 2) & 7, b = pu >> 5; attn_unit2(wvs, ws, lds, b, head, qbl); attn_unit2(wvs, ws, lds, b, head, 7 - qbl); } }
        for (int r3 = 0; r3 < (REP_PH == 14 ? 2 : 1); ++r3) for (int t = bid; t < 256; t += G) attn_sample(wvs, ws, lds, t >> 3, t & 7);
        }
    } SEAM(13);
    MIX_OUT(14, W_CDO)
    FFN_UP(15, 3)
    FFN_DN(16, 3, Y, Y + (size_t)MP * D)
}

extern "C" void kernel_launch(void* const* d_in, const int* in_sizes, int n_in, void* d_out, int out_size, void* d_ws, size_t ws_size, hipStream_t stream) {
    static int grid = 0;
    if (grid == 0) {
        if (n_in != 41 || (size_t)out_size != OUT_TOTAL || ws_size < WS_END) { fprintf(stderr, "kernel_launch: unexpected shapes: n_in %d out %d ws %zu (need %zu)\n", n_in, out_size, ws_size, (size_t)WS_END); grid = -1; return; }
        int dev = 0, cus = 0, per_cu = 0;
        hipGetDevice(&dev); hipDeviceGetAttribute(&cus, hipDeviceAttributeMultiprocessorCount, dev);
        hipFuncSetAttribute((const void*)mk_fwd, hipFuncAttributeMaxDynamicSharedMemorySize, LDS_BYTES);
        hipOccupancyMaxActiveBlocksPerMultiprocessor(&per_cu, (const void*)mk_fwd, 512, LDS_BYTES);
        if (per_cu < 1) { fprintf(stderr, "kernel_launch: occupancy query says %d blocks per CU\n", per_cu); per_cu = 1; }
        (void)hipGetLastError();
        grid = cus * 1;
    }
    if (grid < 0) return;
    Args a{};
    for (int i = 0; i < 41; ++i) a.in[i] = (const float*)d_in[i];
    a.out = (float*)d_out; a.ws = (unsigned char*)d_ws;
#if MK_PER_PHASE
    for (int ph = 0; ph < NPH; ++ph) { a.ph_lo = ph; a.ph_hi = ph + 1; hipLaunchKernelGGL(mk_fwd, dim3(grid), dim3(512), LDS_BYTES, stream, a); }
#else
    a.ph_lo = 0; a.ph_hi = NPH;
    hipMemsetAsync((unsigned char*)d_ws + A_CTL, 0, 16384, stream);
    void* kargs[] = {&a};
    hipError_t e = hipLaunchCooperativeKernel((const void*)mk_fwd, dim3(grid), dim3(512), kargs, LDS_BYTES, stream);
    if (e != hipSuccess) fprintf(stderr, "kernel_launch: cooperative launch failed: %s (grid %d)\n", hipGetErrorString(e), grid);
#endif
}
```

```cpp
#include <hip/hip_runtime.h>
#include <hip/hip_cooperative_groups.h>
#include <cstdio>
#include <cstdint>
namespace cg = cooperative_groups;
namespace pg8 {
#define PG8_LAS __attribute__((address_space(3)))
typedef unsigned short bf16_t;
typedef short bf16x8 __attribute__((ext_vector_type(8)));
typedef float f32x4 __attribute__((ext_vector_type(4)));
typedef unsigned u32x4 __attribute__((ext_vector_type(4)));
constexpr int BM = 256, BK = 64, HALF = 128, HTB = HALF * BK * 2  , STAGE_BYTES = 8 * HTB, NXCD = 8, WGM = 8;

__host__ __device__ __forceinline__ int lds_byte(int r, int c) { const int st = (r >> 4) * 2 + (c >> 5), rr = r & 15, cc = c & 31, ob = rr * 64 + cc * 2; return st * 1024 + (ob ^ (((ob >> 9) & 1) << 5)); }
__host__ __device__ __forceinline__ void stage_rc(int b, int& R, int& C) { const int st = b / 1024, sb = b % 1024, swz = sb ^ (((sb >> 9) & 1) << 5); R = (st >> 1) * 16 + swz / 64; C = (st & 1) * 32 + (swz % 64) / 2; }
__host__ __device__ __forceinline__ int perm32(int rho) { const int n = rho >> 4, i = rho & 15; return 8 * (i >> 2) + 4 * n + (i & 3); }

struct Unit { int pm, pn; };
struct Gemm { const bf16_t* A; const bf16_t* Bt; int M, N, K; int Kl = 0; };

struct StaticOrder {
    int nM, nN, nwg, G, c;
    __host__ __device__ void init(int M, int N, int G_, int c_) { nM = M / BM; nN = N / BM; nwg = nM * nN; G = G_; c = c_; }
    __host__ __device__ bool next(int i, Unit& u) const {
        const long L = (long)i * G + c; if (L >= nwg) return false;
        int wgid = (int)L; { const int q = nwg / NXCD, r = nwg % NXCD, xcd = wgid % NXCD, off = wgid / NXCD; wgid = (xcd < r ? xcd * (q + 1) : r * (q + 1) + (xcd - r) * q) + off; }
        const int nig = WGM * nN, gid = wgid / nig, fm = gid * WGM, gsz = (nM - fm) < WGM ? (nM - fm) : WGM;
        u.pm = fm + ((wgid % nig) % gsz); u.pn = (wgid % nig) / gsz; return true;
    }
    __device__ __forceinline__ void a_ready(const Unit&) const {}
    __device__ __forceinline__ void done(const Unit&) const {}
};

typedef __bf16 bf16x2_cv __attribute__((ext_vector_type(2))); typedef float f32x2_cv __attribute__((ext_vector_type(2)));
__device__ __forceinline__ unsigned cvt_pk_bf16(float lo, float hi) { const f32x2_cv v = {lo, hi}; const bf16x2_cv b = __builtin_convertvector(v, bf16x2_cv); return __builtin_bit_cast(unsigned, b); }

template <class Epi, class Sched, bool ALIGN_EPI = false, bool SP2 = false>
__device__ __forceinline__ void gemm_phase(PG8_LAS unsigned char* lds, const Gemm g, const Sched& S, const Epi& E, const int wvs) {
    int tid_; asm volatile("v_mbcnt_lo_u32_b32 %0, -1, 0\n\tv_mbcnt_hi_u32_b32 %0, -1, %0" : "=v"(tid_)); tid_ += wvs * 64;
    const int tid = tid_, wid = __builtin_amdgcn_readfirstlane(tid >> 6), lane = tid & 63, wr = wid >> 2, wc = wid & 3, fr = lane & 15, fq = lane >> 4;
    const int K = g.K, nt = (g.Kl ? g.Kl : K) / BK;
    unsigned voffA[2], voffB[2];
#pragma unroll
    for (int i = 0; i < 2; ++i) { int R, C; stage_rc(tid * 16 + i * 8192, R, C); const int Rb = Epi::PERM ? ((R & ~31) + perm32(R & 31)) : R;
        voffA[i] = (unsigned)(R * K + C) * 2u; voffB[i] = (unsigned)(Rb * K + C) * 2u; }
    const size_t kstep = (size_t)(BK * 2);
    const size_t hstep = (size_t)HALF * K * 2;
    const size_t tstep = 2 * hstep;
    const unsigned ldsw = (unsigned)wid * 1024u;
    const int aoff = lds_byte(wr * 64 + fr, fq * 8), boff = lds_byte(wc * 32 + fr, fq * 8);
#define PG8_SA(b, h) (((b) * 2 + (h)) * HTB)
#define PG8_SB(b, h) ((4 + (b) * 2 + (h)) * HTB)
#define PG8_STAGE(bufoff, gbase, voff) do { _Pragma("unroll") for (int _i = 0; _i < 2; ++_i) \
        __builtin_amdgcn_global_load_lds((const unsigned*)((const char*)(gbase) + (voff)[_i]), (PG8_LAS unsigned*)(lds + (bufoff) + ldsw + _i * 8192), 16, 0, 0); } while (0)
#define PG8_LDA(dst, b, h) do { _Pragma("unroll") for (int m = 0; m < 4; ++m) _Pragma("unroll") for (int k = 0; k < 2; ++k) dst[m][k] = *(const PG8_LAS bf16x8*)(lds + PG8_SA(b, h) + aoff + m * 2048 + k * 1024); } while (0)
#define PG8_LDB(dst, b, h) do { _Pragma("unroll") for (int n = 0; n < 2; ++n) _Pragma("unroll") for (int k = 0; k < 2; ++k) dst[n][k] = *(const PG8_LAS bf16x8*)(lds + PG8_SB(b, h) + boff + n * 2048 + k * 1024); } while (0)
#define PG8_MMA(ai, bj, At, Bt) do { __builtin_amdgcn_s_setprio(1); _Pragma("unroll") for (int m = 0; m < 4; ++m) _Pragma("unroll") for (int n = 0; n < 2; ++n) _Pragma("unroll") for (int k = 0; k < 2; ++k) \
        acc[ai][bj][m][n] = __builtin_amdgcn_mfma_f32_16x16x32_bf16(Bt[n][k], At[m][k], acc[ai][bj][m][n], 0, 0, 0); __builtin_amdgcn_s_setprio(0); } while (0)
#define PG8_WAIT_V(n) asm volatile("s_waitcnt vmcnt(" #n ")" ::: "memory")
#define PG8_WAIT_L(n) asm volatile("s_waitcnt lgkmcnt(" #n ")" ::: "memory")
#define PG8_BAR __builtin_amdgcn_s_barrier()
#define PG8_SCHED __builtin_amdgcn_sched_barrier(0)
    Unit cur, nxt; int ui = 0;
    if (!S.next(0, cur)) return;
    f32x4 acc[2][2][4][2];
#pragma unroll
    for (int a = 0; a < 2; ++a)
#pragma unroll
        for (int b = 0; b < 2; ++b)
#pragma unroll
            for (int m = 0; m < 4; ++m)
#pragma unroll
                for (int n = 0; n < 2; ++n) acc[a][b][m][n] = (f32x4){0.f, 0.f, 0.f, 0.f};
    bf16x8 At[4][2], B0[2][2], B1[2][2];
    const char* cA = (const char*)g.A + (size_t)cur.pm * tstep; const char* cB = (const char*)g.Bt + (size_t)cur.pn * tstep;
    S.a_ready(cur);
    if constexpr (SP2) {
        PG8_STAGE(PG8_SB(0, 0), cB, voffB); PG8_STAGE(PG8_SB(0, 1), cB + hstep, voffB); PG8_STAGE(PG8_SA(0, 0), cA, voffA); PG8_STAGE(PG8_SA(0, 1), cA + hstep, voffA);
        if (wr == 1) PG8_BAR;
        PG8_WAIT_V(2); PG8_BAR;
        PG8_STAGE(PG8_SB(1, 0), cB + kstep, voffB); PG8_STAGE(PG8_SA(1, 0), cA + kstep, voffA); PG8_STAGE(PG8_SB(1, 1), cB + hstep + kstep, voffB);
        PG8_WAIT_V(6); PG8_BAR;
    } else {
        PG8_STAGE(PG8_SB(0, 0), cB, voffB); PG8_STAGE(PG8_SA(0, 0), cA, voffA); PG8_STAGE(PG8_SB(0, 1), cB + hstep, voffB); PG8_STAGE(PG8_SA(0, 1), cA + hstep, voffA);
        if (wr == 1) PG8_BAR;
        PG8_WAIT_V(4); PG8_BAR;
        PG8_STAGE(PG8_SB(1, 0), cB + kstep, voffB); PG8_STAGE(PG8_SA(1, 0), cA + kstep, voffA); PG8_STAGE(PG8_SB(1, 1), cB + hstep + kstep, voffB);
        PG8_WAIT_V(6); PG8_BAR;
    }
    for (;;) {
        const bool has_next = S.next(ui + 1, nxt);
        const char* nA = has_next ? (const char*)g.A + (size_t)nxt.pm * tstep : cA; const char* nB = has_next ? (const char*)g.Bt + (size_t)nxt.pn * tstep : cB;
        for (int t = 0; t < nt; t += 2) {
            const bool last = (t == nt - 2);
            const char* a1 = cA + (size_t)(t + 1) * kstep;
            const char* a2 = last ? nA : cA + (size_t)(t + 2) * kstep; const char* b2 = last ? nB : cB + (size_t)(t + 2) * kstep;
            const char* a3 = a2 + kstep; const char* b3 = b2 + kstep;
            if (last && has_next) S.a_ready(nxt);
            if constexpr (SP2) {
            PG8_LDB(B0, 0, 0); PG8_LDB(B1, 0, 1); PG8_SCHED; PG8_LDA(At, 0, 0); PG8_STAGE(PG8_SA(1, 1), a1 + hstep, voffA);
            PG8_WAIT_V(8); PG8_WAIT_L(0); PG8_BAR; PG8_MMA(0, 0, At, B0); PG8_MMA(0, 1, At, B1); PG8_BAR; PG8_SCHED;
            PG8_LDA(At, 0, 1); PG8_STAGE(PG8_SB(0, 0), b2, voffB); PG8_STAGE(PG8_SB(0, 1), b2 + hstep, voffB); PG8_STAGE(PG8_SA(0, 0), a2, voffA);
            PG8_WAIT_V(8); PG8_WAIT_L(0); PG8_BAR; PG8_MMA(1, 0, At, B0); PG8_MMA(1, 1, At, B1); PG8_BAR; PG8_SCHED;
            PG8_LDB(B0, 1, 0); PG8_LDB(B1, 1, 1); PG8_SCHED; PG8_LDA(At, 1, 0); PG8_STAGE(PG8_SA(0, 1), a2 + hstep, voffA);
            PG8_WAIT_V(8); PG8_WAIT_L(0); PG8_BAR; PG8_MMA(0, 0, At, B0); PG8_MMA(0, 1, At, B1); PG8_BAR; PG8_SCHED;
            PG8_LDA(At, 1, 1); PG8_STAGE(PG8_SB(1, 0), b3, voffB); PG8_STAGE(PG8_SB(1, 1), b3 + hstep, voffB); PG8_STAGE(PG8_SA(1, 0), a3, voffA);
            PG8_WAIT_V(8); PG8_WAIT_L(0); PG8_BAR; PG8_MMA(1, 0, At, B0); PG8_MMA(1, 1, At, B1); PG8_BAR; PG8_SCHED;
            } else {
            PG8_LDB(B0, 0, 0); PG8_SCHED; PG8_LDA(At, 0, 0); PG8_STAGE(PG8_SA(1, 1), a1 + hstep, voffA);
            PG8_WAIT_L(8); PG8_BAR; PG8_WAIT_L(0); PG8_MMA(0, 0, At, B0); PG8_BAR; PG8_SCHED;
            PG8_LDB(B1, 0, 1); PG8_STAGE(PG8_SB(0, 0), b2, voffB);
            PG8_BAR; PG8_WAIT_L(0); PG8_MMA(0, 1, At, B1); PG8_BAR;
            PG8_LDA(At, 0, 1); PG8_STAGE(PG8_SA(0, 0), a2, voffA);
            PG8_BAR; PG8_WAIT_L(0); PG8_MMA(1, 0, At, B0); PG8_BAR; PG8_SCHED;
            PG8_STAGE(PG8_SB(0, 1), b2 + hstep, voffB);
            PG8_WAIT_V(6); PG8_BAR; PG8_MMA(1, 1, At, B1); PG8_BAR;
            PG8_LDB(B0, 1, 0); PG8_SCHED; PG8_LDA(At, 1, 0); PG8_STAGE(PG8_SA(0, 1), a2 + hstep, voffA);
            PG8_WAIT_L(8); PG8_BAR; PG8_WAIT_L(0); PG8_MMA(0, 0, At, B0); PG8_BAR; PG8_SCHED;
            PG8_LDB(B1, 1, 1); PG8_STAGE(PG8_SB(1, 0), b3, voffB);
            PG8_BAR; PG8_WAIT_L(0); PG8_MMA(0, 1, At, B1); PG8_BAR;
            PG8_LDA(At, 1, 1); PG8_STAGE(PG8_SA(1, 0), a3, voffA);
            PG8_BAR; PG8_WAIT_L(0); PG8_MMA(1, 0, At, B0); PG8_BAR; PG8_SCHED;
            PG8_STAGE(PG8_SB(1, 1), b3 + hstep, voffB);
            PG8_WAIT_V(6); PG8_BAR; PG8_MMA(1, 1, At, B1); PG8_BAR;
            }
        }
        if constexpr (ALIGN_EPI) { if (wr == 0) PG8_BAR; }
        if constexpr (!Epi::AFTER_DRAIN) { E(acc, cur, wr, wc, fr, fq); S.done(cur); }
        if (!has_next) break;
#pragma unroll
        for (int a = 0; a < 2; ++a)
#pragma unroll
            for (int b = 0; b < 2; ++b)
#pragma unroll
                for (int m = 0; m < 4; ++m)
#pragma unroll
                    for (int n = 0; n < 2; ++n) acc[a][b][m][n] = (f32x4){0.f, 0.f, 0.f, 0.f};
        cur = nxt; cA = nA; cB = nB; ++ui;
        if constexpr (ALIGN_EPI) { if (wr == 1) PG8_BAR; }
    }
    PG8_WAIT_V(0);
    if constexpr (!ALIGN_EPI) { if (wr == 0) PG8_BAR; }
    PG8_BAR;
    if constexpr (Epi::AFTER_DRAIN) { E.fused(acc, cur, wr, wc, fr, fq, lds, wid, lane); S.done(cur); }
#undef PG8_SA
#undef PG8_SB
#undef PG8_STAGE
#undef PG8_LDA
#undef PG8_LDB
#undef PG8_MMA
#undef PG8_WAIT_V
#undef PG8_WAIT_L
#undef PG8_BAR
#undef PG8_SCHED
}
}

#ifndef REP_PH
#define REP_PH -1
#endif
#ifndef MK_PER_PHASE
#define MK_PER_PHASE 0
#endif
#define LAS __attribute__((address_space(3)))
using pg8::bf16_t; using pg8::bf16x8; using pg8::f32x4; using pg8::Unit; using pg8::cvt_pk_bf16;
typedef unsigned u32x2 __attribute__((ext_vector_type(2)));
typedef unsigned u32x4 __attribute__((ext_vector_type(4)));
typedef float f32x2 __attribute__((ext_vector_type(2)));

constexpr int MP = 32768, MS = 1024, M = MP + MS, D = 1024, FF = 2816;
constexpr int KVR = 32768 + 32 * 1056;
constexpr float EPS = 1e-6f;
constexpr int NPH = 17;

constexpr size_t OUT_Y = 0;
constexpr size_t OUT_HGRN_P = 34603008, OUT_HGRN_S = OUT_HGRN_P + 1048576;
constexpr size_t OUT_S5RE_P = OUT_HGRN_S + 2097152, OUT_S5IM_P = OUT_S5RE_P + 32768;
constexpr size_t OUT_S5RE_S = OUT_S5IM_P + 32768, OUT_S5IM_S = OUT_S5RE_S + 65536;
constexpr size_t OUT_GV_P = OUT_S5IM_S + 65536, OUT_GV_S = OUT_GV_P + 1048576;
constexpr size_t OUT_CKV_P = OUT_GV_S + 524288, OUT_KPE_P = OUT_CKV_P + 4194304;
constexpr size_t OUT_CKV_S = OUT_KPE_P + 1048576, OUT_KPE_S = OUT_CKV_S + 131072;
constexpr size_t OUT_TOTAL = OUT_KPE_S + 32768;

constexpr size_t al256(size_t x) { return (x + 255) & ~(size_t)255; }
constexpr size_t SZ_GU = (size_t)5632 * 1024 * 2, SZ_DN = (size_t)1024 * 2816 * 2;
constexpr size_t W_GU0 = 0;
constexpr size_t W_DN0 = W_GU0 + 4 * SZ_GU;
constexpr size_t W_AB = W_DN0 + 4 * SZ_DN;
constexpr size_t W_ABO = W_AB + (size_t)2560 * 1024 * 2;
constexpr size_t W_GLU = W_ABO + (size_t)1024 * 1024 * 2;
constexpr size_t W_CD = W_GLU + (size_t)512 * 512 * 2;
constexpr size_t W_CDO = W_CD + (size_t)1536 * 1024 * 2;
constexpr size_t W_UQ = W_CDO + (size_t)1024 * 1024 * 2;
constexpr size_t W_UKV = W_UQ + (size_t)768 * 256 * 2;
constexpr size_t T_LAMBAR = W_UKV + (size_t)1024 * 128 * 2;
constexpr size_t T_BBT = T_LAMBAR + 2048 * 8;
constexpr size_t T_CCT = T_BBT + 65536 * 2;
constexpr size_t T_ROPE = T_CCT + 65536 * 2;
constexpr size_t T_LB = T_ROPE + 32768 * 8;
constexpr size_t T_WS = T_LB + 2048;
constexpr size_t A_XB = T_WS + 65536 * 2;
constexpr size_t A_SSQ = A_XB + (size_t)M * 1024 * 2;
constexpr size_t A_SSV = A_SSQ + (size_t)M * 16 * 4;
constexpr size_t A_SSCQ = A_SSV + (size_t)M * 8 * 4;
constexpr size_t A_SSCKV = A_SSCQ + (size_t)M * 4 * 4;
constexpr size_t A_SSQN = A_SSCKV + (size_t)M * 4 * 4;
constexpr size_t A_SSQR = A_SSQN + (size_t)M * 8 * 4;
constexpr size_t A_SSK = A_SSQR + (size_t)M * 8 * 4;
constexpr size_t A_CTL = al256(A_SSK + (size_t)KVR * 4);
constexpr size_t R0 = A_CTL + 16384;
constexpr size_t SZ_H = (size_t)M * 512 * 2;
constexpr size_t R_ACT = R0;
constexpr size_t R_MIX = R0;
constexpr size_t R_QT = R_MIX + 2 * SZ_H, R_KH = R_QT + SZ_H, R_KTT = R_KH + SZ_H, R_VTT = R_KTT + SZ_H;
constexpr size_t R_GB = R_VTT + SZ_H, R_UB = R_GB + SZ_H, R_OB = R_UB + SZ_H, R_ZB = R_OB + SZ_H;
constexpr size_t R_LDEC = R_ZB + SZ_H;
constexpr size_t R_END0 = R_LDEC + (size_t)(M / 16) * 512 * 4;
constexpr size_t R_VG = R_MIX + 2 * SZ_H;
constexpr size_t R_CQB = R_VG + SZ_H;
constexpr size_t R_CKVG = R_CQB + (size_t)M * 256 * 2;
constexpr size_t R_KPEB = R_CKVG + (size_t)KVR * 128 * 2;
constexpr size_t R_QF = R_KPEB + (size_t)KVR * 32 * 4;
constexpr size_t R_KF = R_QF + (size_t)M * 768 * 2;
constexpr size_t R_VT = R_KF + (size_t)KVR * 768 * 2;
constexpr size_t R_END1 = R_VT + (size_t)KVR * 512 * 2;
constexpr size_t R_PART = al256(R_ACT + (size_t)M * FF * 2);
constexpr size_t R_ENDA = R_PART + (size_t)176 * 65536 * 4;
constexpr size_t WS_END = (R_END1 > R_END0 ? (R_END1 > R_ENDA ? R_END1 : R_ENDA) : (R_END0 > R_ENDA ? R_END0 : R_ENDA));
static_assert(WS_END <= (size_t)536870912, "workspace map exceeds 512 MiB");

constexpr int LDS_BYTES = 147456;

template <class T> __device__ __forceinline__ T* gp(T* p) { return p; }
__device__ __forceinline__ float sum4(f32x4 a) { return (a.x + a.y) + (a.z + a.w); }
__device__ __forceinline__ float bf2f(unsigned short h) { return __uint_as_float((unsigned)h << 16); }
__device__ __forceinline__ void st_bf4(bf16_t* p, f32x4 v) { u32x2 w; w.x = cvt_pk_bf16(v.x, v.y); w.y = cvt_pk_bf16(v.z, v.w); *(u32x2*)p = w; }
__device__ __forceinline__ unsigned short bf1(float v) { return (unsigned short)(cvt_pk_bf16(v, 0.f) & 0xffffu); }
__device__ __forceinline__ float sigmoidf_(float x) { return __builtin_amdgcn_rcpf(1.f + __expf(-x)); }
__device__ __forceinline__ float gelu_tanh(float x) { const float y = 1.5957691216057308f * (x + 0.044715f * x * x * x); return x * __builtin_amdgcn_rcpf(1.f + __expf(-y)); }
__device__ __forceinline__ float rstd16(const float* ssq, int row) { const f32x4* p = (const f32x4*)(ssq + (size_t)row * 16); return rsqrtf((sum4(p[0]) + sum4(p[1]) + sum4(p[2]) + sum4(p[3])) * (1.f / 1024.f) + EPS); }
__device__ __forceinline__ int kvrow_of(int row) { return row < MP ? row : MP + ((row - MP) >> 5) * 1056 + 1024 + ((row - MP) & 31); }
__device__ __forceinline__ int pos_of(int row) { return row < MP ? (row & 2047) : 1024 + ((row - MP) & 31); }
__device__ __forceinline__ bf16x8 mk8(u32x2 a, u32x2 b) { u32x4 w; w.x = a.x; w.y = a.y; w.z = b.x; w.w = b.y; return __builtin_bit_cast(bf16x8, w); }
__device__ __forceinline__ f32x4 mfma16(bf16x8 a, bf16x8 b, f32x4 c) { return __builtin_amdgcn_mfma_f32_16x16x32_bf16(a, b, c, 0, 0, 0); }
#define LDSWAIT() asm volatile("s_waitcnt lgkmcnt(0)" ::: "memory")

#define EPI_ROWS_BEGIN _Pragma("unroll") for (int ai = 0; ai < 2; ++ai) _Pragma("unroll") for (int m = 0; m < 4; ++m) { const int row = u.pm * 256 + ai * 128 + wr * 64 + m * 16 + fr;
#define EPI_ROWS_END }

struct EpiGU {
    static constexpr bool PERM = false, AFTER_DRAIN = false;
    const float* ssq; bf16_t* act;
    __device__ __forceinline__ void operator()(const f32x4 (&acc)[2][2][4][2], const Unit& u, int wr, int wc, int fr, int fq) const {
        asm volatile("" : "+v"(fr), "+v"(fq));
        EPI_ROWS_BEGIN
            const float rs = rstd16(ssq, row);
#pragma unroll
            for (int n = 0; n < 2; ++n) { const f32x4 g = acc[ai][0][m][n] * rs, up = acc[ai][1][m][n] * rs; f32x4 a;
                a.x = g.x * sigmoidf_(g.x) * up.x; a.y = g.y * sigmoidf_(g.y) * up.y; a.z = g.z * sigmoidf_(g.z) * up.z; a.w = g.w * sigmoidf_(g.w) * up.w;
                st_bf4(act + (size_t)row * FF + u.pn * 128 + wc * 32 + n * 16 + fq * 4, a); }
        EPI_ROWS_END
    }
};
struct EpiRes {
    static constexpr bool PERM = false, AFTER_DRAIN = false;
    const float* xin0; const float* xin1; float* xout; bf16_t* xb; float* ssq; float scale;
    __device__ __forceinline__ void do_row(int row, int pn, int wc, int fq, const f32x4& a00, const f32x4& a01, const f32x4& a10, const f32x4& a11) const {
        const float* src = row < MP ? xin0 + (size_t)row * D : xin1 + (size_t)(row - MP) * D; float ss = 0.f;
#pragma unroll
        for (int bj = 0; bj < 2; ++bj)
#pragma unroll
            for (int n = 0; n < 2; ++n) { const int col = pn * 256 + bj * 128 + wc * 32 + n * 16 + fq * 4;
                const f32x4 o = *(const f32x4*)(src + col) + (bj ? (n ? a11 : a10) : (n ? a01 : a00)) * scale;
                *(f32x4*)(xout + (size_t)row * D + col) = o; st_bf4(xb + (size_t)row * D + col, o); ss += sum4(o * o); }
        ss += __shfl_xor(ss, 16); ss += __shfl_xor(ss, 32);
        if (fq == 0) ssq[(size_t)row * 16 + pn * 4 + wc] = ss;
    }
    __device__ __forceinline__ void operator()(const f32x4 (&acc)[2][2][4][2], const Unit& u, int wr, int wc, int fr, int fq) const {
        asm volatile("" : "+v"(fr), "+v"(fq));
        EPI_ROWS_BEGIN
            do_row(row, u.pn, wc, fq, acc[ai][0][m][0], acc[ai][0][m][1], acc[ai][1][m][0], acc[ai][1][m][1]);
        EPI_ROWS_END
    }
};
struct EpiAB {
    static constexpr bool PERM = false, AFTER_DRAIN = false;
    const float* ssq; const float* lb; bf16_t* QT; bf16_t* KH; bf16_t* KTT; bf16_t* VTT; bf16_t* GB; bf16_t* UB; float* LDEC;
    __device__ __forceinline__ void operator()(const f32x4 (&acc)[2][2][4][2], const Unit& u, int wr, int wc, int fr, int fq) const {
        asm volatile("" : "+v"(fr), "+v"(fq));
        if (u.pn < 4) {
            const int h = u.pn;
            EPI_ROWS_BEGIN
                const float rs = rstd16(ssq, row); const int blk = row >> 4;
#pragma unroll
                for (int n = 0; n < 2; ++n) { const int cl = h * 128 + wc * 32 + n * 16 + fq * 4; const f32x4 lbv = *(const f32x4*)(lb + cl);
                    f32x4 qt, kh, dec; float kt[4];
#pragma unroll
                    for (int j = 0; j < 4; ++j) { const float q = acc[ai][0][m][n][j] * rs, fz = acc[ai][1][m][n][j] * rs;
                        const float f = lbv[j] + (1.f - lbv[j]) * sigmoidf_(fz); float b = __logf(f);
#pragma unroll
                        for (int d = 1; d < 16; d <<= 1) { const float t = __shfl_up(b, d, 16); if (fr >= d) b += t; }
                        const float bend = __shfl(b, 15, 16); const float kk = 1.f - f;
                        qt[j] = q * __expf(b); kh[j] = kk * __expf(-b); kt[j] = kk * __expf(bend - b); dec[j] = __expf(bend); }
                    st_bf4(QT + (size_t)row * 512 + cl, qt); st_bf4(KH + (size_t)row * 512 + cl, kh);
#pragma unroll
                    for (int j = 0; j < 4; ++j) KTT[(size_t)blk * 8192 + (cl + j) * 16 + fr] = bf1(kt[j]);
                    if (fr == 15) *(f32x4*)(LDEC + (size_t)blk * 512 + cl) = dec; }
            EPI_ROWS_END
        } else if (u.pn < 6) {
            EPI_ROWS_BEGIN
                const float rs = rstd16(ssq, row); const int blk = row >> 4;
#pragma unroll
                for (int bj = 0; bj < 2; ++bj)
#pragma unroll
                    for (int n = 0; n < 2; ++n) { const int cl = (u.pn - 4) * 256 + bj * 128 + wc * 32 + n * 16 + fq * 4;
#pragma unroll
                        for (int j = 0; j < 4; ++j) VTT[(size_t)blk * 8192 + (cl + j) * 16 + fr] = bf1(acc[ai][bj][m][n][j] * rs); }
            EPI_ROWS_END
        } else if (u.pn < 8) {
            EPI_ROWS_BEGIN
                const float rs = rstd16(ssq, row);
#pragma unroll
                for (int bj = 0; bj < 2; ++bj)
#pragma unroll
                    for (int n = 0; n < 2; ++n) { const int cl = (u.pn - 6) * 256 + bj * 128 + wc * 32 + n * 16 + fq * 4; const f32x4 v = acc[ai][bj][m][n] * rs; f32x4 s;
                        s.x = sigmoidf_(v.x); s.y = sigmoidf_(v.y); s.z = sigmoidf_(v.z); s.w = sigmoidf_(v.w); st_bf4(GB + (size_t)row * 512 + cl, s); }
            EPI_ROWS_END
        } else {
            EPI_ROWS_BEGIN
                const float rs = rstd16(ssq, row);
#pragma unroll
                for (int bj = 0; bj < 2; ++bj)
#pragma unroll
                    for (int n = 0; n < 2; ++n) { const int cl = (u.pn - 8) * 256 + bj * 128 + wc * 32 + n * 16 + fq * 4; st_bf4(UB + (size_t)row * 512 + cl, acc[ai][bj][m][n] * rs); }
            EPI_ROWS_END
        }
    }
};
struct EpiGLU {
    static constexpr bool PERM = false, AFTER_DRAIN = false;
    const bf16_t* ZB; const float* bglu; bf16_t* MIX;
    __device__ __forceinline__ void operator()(const f32x4 (&acc)[2][2][4][2], const Unit& u, int wr, int wc, int fr, int fq) const {
        asm volatile("" : "+v"(fr), "+v"(fq));
        EPI_ROWS_BEGIN
#pragma unroll
            for (int bj = 0; bj < 2; ++bj)
#pragma unroll
                for (int n = 0; n < 2; ++n) { const int col = u.pn * 256 + bj * 128 + wc * 32 + n * 16 + fq * 4;
                    const u32x2 zz = *(const u32x2*)(ZB + (size_t)row * 512 + col); const f32x4 bv = *(const f32x4*)(bglu + col); const f32x4 a = acc[ai][bj][m][n] + bv; f32x4 o;
                    o.x = __uint_as_float(zz.x << 16) * sigmoidf_(a.x); o.y = __uint_as_float(zz.x & 0xffff0000u) * sigmoidf_(a.y);
                    o.z = __uint_as_float(zz.y << 16) * sigmoidf_(a.z); o.w = __uint_as_float(zz.y & 0xffff0000u) * sigmoidf_(a.w);
                    st_bf4(MIX + (size_t)row * 1024 + 512 + col, o); }
        EPI_ROWS_END
    }
};
struct EpiCD {
    static constexpr bool PERM = false, AFTER_DRAIN = false;
    const float* ssq; const float* vnorm; const float* kvnorm; const f32x2* rope; bf16_t* MIX; bf16_t* VG; float* SSV; bf16_t* CQB; float* SSCQ; bf16_t* CKVG; float* SSCKV; float* KPEB; float* SSK; float* out;
    __device__ __forceinline__ void operator()(const f32x4 (&acc)[2][2][4][2], const Unit& u, int wr, int wc, int fr, int fq) const {
        asm volatile("" : "+v"(fr), "+v"(fq));
        if (u.pn < 2) {
            EPI_ROWS_BEGIN
                const float rs = rstd16(ssq, row);
#pragma unroll
                for (int bj = 0; bj < 2; ++bj)
#pragma unroll
                    for (int n = 0; n < 2; ++n) { const int cl = u.pn * 256 + bj * 128 + wc * 32 + n * 16 + fq * 4; const f32x4 v = acc[ai][bj][m][n] * rs; f32x4 g;
                        g.x = gelu_tanh(v.x); g.y = gelu_tanh(v.y); g.z = gelu_tanh(v.z); g.w = gelu_tanh(v.w); st_bf4(MIX + (size_t)row * 1024 + cl, g); }
            EPI_ROWS_END
        } else if (u.pn < 4) {
            EPI_ROWS_BEGIN
                const float rs = rstd16(ssq, row); float ss = 0.f;
#pragma unroll
                for (int bj = 0; bj < 2; ++bj)
#pragma unroll
                    for (int n = 0; n < 2; ++n) { const int cl = (u.pn - 2) * 256 + bj * 128 + wc * 32 + n * 16 + fq * 4; const f32x4 v = acc[ai][bj][m][n] * rs; f32x4 g;
                        g.x = gelu_tanh(v.x); g.y = gelu_tanh(v.y); g.z = gelu_tanh(v.z); g.w = gelu_tanh(v.w); ss += sum4(g * g);
                        st_bf4(VG + (size_t)row * 512 + cl, g * *(const f32x4*)(vnorm + cl)); }
                ss += __shfl_xor(ss, 16); ss += __shfl_xor(ss, 32);
                if (fq == 0) SSV[(size_t)row * 8 + (u.pn - 2) * 4 + wc] = ss;
            EPI_ROWS_END
        } else if (u.pn == 4) {
            EPI_ROWS_BEGIN
                const float rs = rstd16(ssq, row); float ss = 0.f;
#pragma unroll
                for (int bj = 0; bj < 2; ++bj)
#pragma unroll
                    for (int n = 0; n < 2; ++n) { const int cl = bj * 128 + wc * 32 + n * 16 + fq * 4; const f32x4 v = acc[ai][bj][m][n] * rs; ss += sum4(v * v); st_bf4(CQB + (size_t)row * 256 + cl, v); }
                ss += __shfl_xor(ss, 16); ss += __shfl_xor(ss, 32);
                if (fq == 0) SSCQ[(size_t)row * 4 + wc] = ss;
            EPI_ROWS_END
        } else {
            EPI_ROWS_BEGIN
                const float rs = rstd16(ssq, row); const int kvr = kvrow_of(row); float ss = 0.f;
                float* ock = row < MP ? out + OUT_CKV_P + (size_t)row * 128 : out + OUT_CKV_S + (size_t)(row - MP) * 128;
#pragma unroll
                for (int n = 0; n < 2; ++n) { const int cl = wc * 32 + n * 16 + fq * 4; const f32x4 v = acc[ai][0][m][n] * rs; ss += sum4(v * v);
                    const f32x4 g = v * *(const f32x4*)(kvnorm + cl); st_bf4(CKVG + (size_t)kvr * 128 + cl, g); *(f32x4*)(ock + cl) = g; }
                ss += __shfl_xor(ss, 16); ss += __shfl_xor(ss, 32);
                if (fq == 0) SSCKV[(size_t)row * 4 + wc] = ss;
                if (wc == 0) {
                    const int pos = pos_of(row); float* okp = row < MP ? out + OUT_KPE_P + (size_t)row * 32 : out + OUT_KPE_S + (size_t)(row - MP) * 32;
                    const f32x4 x1 = acc[ai][1][m][0] * rs, x2 = acc[ai][1][m][1] * rs; f32x4 o1, o2; float s2 = 0.f;
#pragma unroll
                    for (int j = 0; j < 4; ++j) { const f32x2 cs = rope[pos * 16 + fq * 4 + j]; o1[j] = x1[j] * cs.x - x2[j] * cs.y; o2[j] = x1[j] * cs.y + x2[j] * cs.x; }
                    s2 = sum4(o1 * o1) + sum4(o2 * o2); s2 += __shfl_xor(s2, 16); s2 += __shfl_xor(s2, 32);
                    *(f32x4*)(okp + fq * 4) = o1; *(f32x4*)(okp + 16 + fq * 4) = o2;
                    *(f32x4*)(KPEB + (size_t)kvr * 32 + fq * 4) = o1; *(f32x4*)(KPEB + (size_t)kvr * 32 + 16 + fq * 4) = o2;
                    if (fq == 0) SSK[kvr] = s2;
                }
            EPI_ROWS_END
        }
    }
};
struct EpiQ {
    static constexpr bool PERM = false, AFTER_DRAIN = false;
    const float* SSCQ; const float* qgain; const f32x2* rope; bf16_t* QF; float* SSQN; float* SSQR;
    __device__ __forceinline__ void operator()(const f32x4 (&acc)[2][2][4][2], const Unit& u, int wr, int wc, int fr, int fq) const {
        asm volatile("" : "+v"(fr), "+v"(fq));
        if (u.pn < 2) {
            const int head = u.pn * 4 + wc;
            EPI_ROWS_BEGIN
                const float rs = rsqrtf(sum4(*(const f32x4*)(SSCQ + (size_t)row * 4)) * (1.f / 256.f) + EPS); float ss = 0.f;
#pragma unroll
                for (int bj = 0; bj < 2; ++bj)
#pragma unroll
                    for (int n = 0; n < 2; ++n) { const int d = bj * 32 + n * 16 + fq * 4; const f32x4 v = acc[ai][bj][m][n] * rs; ss += sum4(v * v);
                        st_bf4(QF + (size_t)row * 768 + head * 96 + d, v * *(const f32x4*)(qgain + d)); }
                ss += __shfl_xor(ss, 16); ss += __shfl_xor(ss, 32);
                if (fq == 0) SSQN[(size_t)row * 8 + head] = ss;
            EPI_ROWS_END
        } else {
            EPI_ROWS_BEGIN
                const float rs = rsqrtf(sum4(*(const f32x4*)(SSCQ + (size_t)row * 4)) * (1.f / 256.f) + EPS); const int pos = pos_of(row);
#pragma unroll
                for (int bj = 0; bj < 2; ++bj) { const int head = 2 * wc + bj; const f32x4 x1 = acc[ai][bj][m][0] * rs, x2 = acc[ai][bj][m][1] * rs; f32x4 o1, o2;
#pragma unroll
                    for (int j = 0; j < 4; ++j) { const f32x2 cs = rope[pos * 16 + fq * 4 + j]; o1[j] = x1[j] * cs.x - x2[j] * cs.y; o2[j] = x1[j] * cs.y + x2[j] * cs.x; }
                    float ss = sum4(x1 * x1) + sum4(x2 * x2); ss += __shfl_xor(ss, 16); ss += __shfl_xor(ss, 32);
                    st_bf4(QF + (size_t)row * 768 + head * 96 + 64 + fq * 4, o1 * *(const f32x4*)(qgain + 64 + fq * 4));
                    st_bf4(QF + (size_t)row * 768 + head * 96 + 80 + fq * 4, o2 * *(const f32x4*)(qgain + 80 + fq * 4));
                    if (fq == 0) SSQR[(size_t)row * 8 + head] = ss; }
            EPI_ROWS_END
        }
    }
};
struct EpiKV {
    static constexpr bool PERM = false, AFTER_DRAIN = false;
    const float* SSCKV; const float* SSK; const float* KPEB; const float* kgain; bf16_t* KF; bf16_t* VT;
    __device__ __forceinline__ float rstd_kv(int kvr) const {
        int row;
        if (kvr < MP) row = kvr; else { const int rel = kvr - MP, b = rel / 1056, j = rel - b * 1056; if (j < 1024) return 1.f; row = MP + b * 32 + (j - 1024); }
        return rsqrtf(sum4(*(const f32x4*)(SSCKV + (size_t)row * 4)) * (1.f / 128.f) + EPS);
    }
    __device__ __forceinline__ void operator()(const f32x4 (&acc)[2][2][4][2], const Unit& u, int wr, int wc, int fr, int fq) const {
        asm volatile("" : "+v"(fr), "+v"(fq));
        if (u.pn < 2) {
            const int head = u.pn * 4 + wc;
            EPI_ROWS_BEGIN
                const float rs = rstd_kv(row); float ss = 0.f;
#pragma unroll
                for (int bj = 0; bj < 2; ++bj)
#pragma unroll
                    for (int n = 0; n < 2; ++n) { const f32x4 v = acc[ai][bj][m][n] * rs; ss += sum4(v * v); }
                ss += __shfl_xor(ss, 16); ss += __shfl_xor(ss, 32);
                const float rk = rsqrtf((ss + SSK[row]) * (1.f / 96.f) + EPS);
#pragma unroll
                for (int bj = 0; bj < 2; ++bj)
#pragma unroll
                    for (int n = 0; n < 2; ++n) { const int d = bj * 32 + n * 16 + fq * 4; st_bf4(KF + (size_t)row * 768 + head * 96 + d, acc[ai][bj][m][n] * (rs * rk) * *(const f32x4*)(kgain + d)); }
                const f32x4 p0 = *(const f32x4*)(KPEB + (size_t)row * 32 + fq * 8), p1 = *(const f32x4*)(KPEB + (size_t)row * 32 + fq * 8 + 4);
                st_bf4(KF + (size_t)row * 768 + head * 96 + 64 + fq * 8, p0 * rk * *(const f32x4*)(kgain + 64 + fq * 8));
                st_bf4(KF + (size_t)row * 768 + head * 96 + 68 + fq * 8, p1 * rk * *(const f32x4*)(kgain + 68 + fq * 8));
            EPI_ROWS_END
        } else {
            EPI_ROWS_BEGIN
                const float rs = rstd_kv(row); int seq0, key, L;
                if (row < MP) { seq0 = row & ~2047; key = row & 2047; L = 2048; } else { const int rel = row - MP, b = rel / 1056; seq0 = MP + b * 1056; key = rel - b * 1056; L = 1056; }
                bf16_t* base = VT + (size_t)seq0 * 512 + key;
#pragma unroll
                for (int bj = 0; bj < 2; ++bj)
#pragma unroll
                    for (int n = 0; n < 2; ++n) { const int c = (u.pn - 2) * 256 + bj * 128 + wc * 32 + n * 16 + fq * 4;
#pragma unroll
                        for (int j = 0; j < 4; ++j) base[(size_t)(c + j) * L] = bf1(acc[ai][bj][m][n][j] * rs); }
            EPI_ROWS_END
        }
    }
};

struct Args { const float* in[41]; float* out; unsigned char* ws; int ph_lo, ph_hi; };

__device__ __forceinline__ void tr_item(const float* W, int ldw, int col0, const float* gain, bf16_t* WT, int K, int drow0, int k0, LAS float* scr, int lane, bool zero) {
    const int c = lane & 7;
    if (zero) {
#pragma unroll
        for (int j = 0; j < 4; ++j) { const int n = (lane >> 3) + 8 * j; *(u32x4*)(WT + (size_t)(drow0 + n) * K + k0 + 8 * c) = (u32x4){0u, 0u, 0u, 0u}; }
        return;
    }
    float tv[32];
#pragma unroll
    for (int i = 0; i < 32; ++i) { const int kk = 2 * i + (lane >> 5); tv[i] = W[(size_t)(k0 + kk) * ldw + col0 + (lane & 31)]; }
    if (gain) {
#pragma unroll
        for (int i = 0; i < 32; ++i) tv[i] *= gain[k0 + 2 * i + (lane >> 5)]; }
#pragma unroll
    for (int i = 0; i < 32; ++i) scr[(2 * i + (lane >> 5)) * 33 + (lane & 31)] = tv[i];
    LDSWAIT();
#pragma unroll
    for (int j = 0; j < 4; ++j) { const int n = (lane >> 3) + 8 * j; const LAS float* s = scr + (8 * c) * 33 + n;
        u32x4 o; o.x = cvt_pk_bf16(s[0 * 33], s[1 * 33]); o.y = cvt_pk_bf16(s[2 * 33], s[3 * 33]); o.z = cvt_pk_bf16(s[4 * 33], s[5 * 33]); o.w = cvt_pk_bf16(s[6 * 33], s[7 * 33]);
        *(u32x4*)(WT + (size_t)(drow0 + n) * K + k0 + 8 * c) = o; }
    LDSWAIT();
}
__device__ __forceinline__ void sincos_d(double a, double& s, double& c) {
    const double q = rint(a * 0.6366197723675814); double r = fma(-q, 1.5707963267948966, a); r = fma(-q, 6.123233995736766e-17, r);
    const double r2 = r * r;
    const double sr = r * (1.0 + r2 * (-1.0 / 6 + r2 * (1.0 / 120 + r2 * (-1.0 / 5040 + r2 * (1.0 / 362880 + r2 * (-1.0 / 39916800 + r2 * (1.0 / 6227020800.0 + r2 * (-1.0 / 1307674368000.0))))))));
    const double cr = 1.0 + r2 * (-0.5 + r2 * (1.0 / 24 + r2 * (-1.0 / 720 + r2 * (1.0 / 40320 + r2 * (-1.0 / 3628800 + r2 * (1.0 / 479001600 + r2 * (-1.0 / 87178291200.0 + r2 * (1.0 / 20922789888000.0))))))));
    const int n = ((int)q) & 3;
    s = (n == 0) ? sr : (n == 1) ? cr : (n == 2) ? -sr : -cr;
    c = (n == 0) ? cr : (n == 1) ? -sr : (n == 2) ? -cr : sr;
}
__device__ __forceinline__ double exp_d(double x) {
    const double y = x * 0.0625; double t = 1.0 + y * (1.0 + y * (0.5 + y * (1.0 / 6 + y * (1.0 / 24 + y * (1.0 / 120 + y * (1.0 / 720 + y * (1.0 / 5040 + y * (1.0 / 40320 + y * (1.0 / 362880 + y * (1.0 / 3628800 + y * (1.0 / 39916800 + y * (1.0 / 479001600 + y * (1.0 / 6227020800.0)))))))))))));
    t *= t; t *= t; t *= t; t *= t; return t;
}

constexpr int I_GU = 16 * 176, I_DN = 44 * 32, I_AB = 16 * 80, I_ABO = 16 * 32, I_GLU = 8 * 16, I_CD = 16 * 48, I_CDO = 16 * 32, I_UQ = 4 * 24, I_UKV = 2 * 32;
constexpr int NIT = 4 * I_GU + 4 * I_DN + I_AB + I_ABO + I_GLU + I_CD + I_CDO + I_UQ + I_UKV;
constexpr int I_L0 = I_AB + I_ABO + I_GLU, I_L1 = I_CD + I_CDO + I_UQ + I_UKV, IT_MISC = 4 * I_GU + 4 * I_DN;
constexpr int NIT_A = I_GU + I_DN + I_L0, NIT_B1 = I_GU + I_DN, NIT_B2 = I_GU + I_DN + I_L1, NIT_B3 = I_GU + I_DN;
__device__ __forceinline__ int item_of(int set, int idx) {
    if (idx < I_GU) return set * I_GU + idx; idx -= I_GU;
    if (idx < I_DN) return 4 * I_GU + set * I_DN + idx; idx -= I_DN;
    return set == 0 ? IT_MISC + idx : IT_MISC + I_L0 + idx;
}
__device__ __forceinline__ void weight_item(const Args& a, unsigned char* ws, int it, LAS float* scr, int lane) {
        int r = it;
        if (r < 4 * I_GU) { const int w = r / I_GU; r -= w * I_GU; const int l = w >> 1, f2 = w & 1; const int kb = r / 176, nbk = r % 176, pn = nbk >> 3, t32 = nbk & 7, bj = t32 >> 2;
            const float* Wg = gp(a.in[f2 ? 13 : 8]) + (size_t)l * 1024 * FF; const float* Wu = gp(a.in[f2 ? 14 : 9]) + (size_t)l * 1024 * FF; const float* gn = gp(a.in[f2 ? 12 : 7]) + l * 1024;
            tr_item(bj ? Wu : Wg, FF, pn * 128 + (t32 & 3) * 32, gn, (bf16_t*)(ws + W_GU0 + w * SZ_GU), 1024, nbk * 32, kb * 64, scr, lane, false); return; }
        r -= 4 * I_GU;
        if (r < 4 * I_DN) { const int w = r / I_DN; r -= w * I_DN; const int l = w >> 1, f2 = w & 1; const int kb = r / 32, nbk = r % 32;
            tr_item(gp(a.in[f2 ? 15 : 10]) + (size_t)l * FF * 1024, 1024, nbk * 32, nullptr, (bf16_t*)(ws + W_DN0 + w * SZ_DN), FF, nbk * 32, kb * 64, scr, lane, false); return; }
        r -= 4 * I_DN;
        if (r < I_AB) { const int kb = r / 80, nbk = r % 80, pn = nbk >> 3; int col0 = nbk * 32; if (pn < 4) { const int bj = (nbk & 7) >> 2; col0 = bj * 512 + pn * 128 + (nbk & 3) * 32; }
            tr_item(gp(a.in[16]), 2560, col0, gp(a.in[11]), (bf16_t*)(ws + W_AB), 1024, nbk * 32, kb * 64, scr, lane, false); return; }
        r -= I_AB;
        if (r < I_ABO) { const int kb = r / 32, nbk = r % 32; tr_item(gp(a.in[29]), 1024, nbk * 32, nullptr, (bf16_t*)(ws + W_ABO), 1024, nbk * 32, kb * 64, scr, lane, false); return; }
        r -= I_ABO;
        if (r < I_GLU) { const int kb = r / 16, nbk = r % 16; tr_item(gp(a.in[27]), 512, nbk * 32, nullptr, (bf16_t*)(ws + W_GLU), 512, nbk * 32, kb * 64, scr, lane, false); return; }
        r -= I_GLU;
        if (r < I_CD) { const int kb = r / 48, nbk = r % 48; tr_item(gp(a.in[30]), 1440, nbk * 32, gp(a.in[11]) + 1024, (bf16_t*)(ws + W_CD), 1024, nbk * 32, kb * 64, scr, lane, nbk >= 45); return; }
        r -= I_CD;
        if (r < I_CDO) { const int kb = r / 32, nbk = r % 32; tr_item(gp(a.in[40]), 1024, nbk * 32, nullptr, (bf16_t*)(ws + W_CDO), 1024, nbk * 32, kb * 64, scr, lane, false); return; }
        r -= I_CDO;
        if (r < I_UQ) { const int kb = r / 24, nbk = r % 24, pn = nbk >> 3, t32 = nbk & 7, bj = t32 >> 2, wc = t32 & 3; const int col0 = pn < 2 ? (pn * 4 + wc) * 96 + 32 * bj : (2 * wc + bj) * 96 + 64;
            tr_item(gp(a.in[35]), 768, col0, gp(a.in[34]), (bf16_t*)(ws + W_UQ), 256, nbk * 32, kb * 64, scr, lane, false); return; }
        r -= I_UQ;
        { const int kb = r / 32, nbk = r % 32, pn = nbk >> 3, t32 = nbk & 7, bj = t32 >> 2, wc = t32 & 3; int col0;
            if (pn < 2) col0 = (pn * 4 + wc) * 128 + 32 * bj; else { const int tc0 = t32 * 32; col0 = ((pn - 2) * 4 + (tc0 >> 6)) * 128 + 64 + (tc0 & 63); }
            tr_item(gp(a.in[37]), 1024, col0, nullptr, (bf16_t*)(ws + W_UKV), 128, nbk * 32, kb * 64, scr, lane, false); }
}

__device__ __forceinline__ void prologue(const Args& a, LAS unsigned char* lds, int G, const int wvs) {
    int tid_; asm volatile("v_mbcnt_lo_u32_b32 %0, -1, 0\n\tv_mbcnt_hi_u32_b32 %0, -1, %0" : "=v"(tid_)); tid_ += wvs * 64;
    const int tid = tid_, lane = tid & 63, wave = tid >> 6, bid = blockIdx.x;
    unsigned char* ws = gp(a.ws);
    LAS float* scr = (LAS float*)(lds + wave * 16384);
    const int gw = bid * 8 + wave, NGW = G * 8;
    if (G == 256) { for (int idx = gw; idx < NIT_A; idx += NGW) weight_item(a, ws, item_of(0, idx), scr, lane); }
    else { for (int it = gw; it < NIT; it += NGW) weight_item(a, ws, it, scr, lane); }
    { bf16_t* XB = (bf16_t*)(ws + A_XB); float* SSQ = (float*)(ws + A_SSQ);
      for (int row0 = gw * 2; row0 < M; row0 += NGW * 2) {
          const float* s0 = row0 < MP ? gp(a.in[0]) + (size_t)row0 * D : gp(a.in[1]) + (size_t)(row0 - MP) * D; const float* s1 = s0 + D;
          f32x4 v0[4], v1[4]; float ss0 = 0.f, ss1 = 0.f;
#pragma unroll
          for (int j = 0; j < 4; ++j) { v0[j] = ((const f32x4*)s0)[lane + 64 * j]; v1[j] = ((const f32x4*)s1)[lane + 64 * j]; }
#pragma unroll
          for (int j = 0; j < 4; ++j) { ss0 += sum4(v0[j] * v0[j]); ss1 += sum4(v1[j] * v1[j]); st_bf4(XB + (size_t)row0 * D + (lane + 64 * j) * 4, v0[j]); st_bf4(XB + (size_t)(row0 + 1) * D + (lane + 64 * j) * 4, v1[j]); }
#pragma unroll
          for (int o = 1; o < 64; o <<= 1) { ss0 += __shfl_xor(ss0, o); ss1 += __shfl_xor(ss1, o); }
          if (lane < 4) ((f32x4*)(SSQ + (size_t)row0 * 16))[lane] = (f32x4){lane == 0 ? ss0 : 0.f, 0.f, 0.f, 0.f};
          else if (lane < 8) ((f32x4*)(SSQ + (size_t)(row0 + 1) * 16))[lane - 4] = (f32x4){lane == 4 ? ss1 : 0.f, 0.f, 0.f, 0.f};
      } }
    const int gid = bid * 512 + tid, NT = G * 512;
    for (int i = gid; i < 65536; i += NT) {
        const int g = i >> 11, c = (i >> 4) & 127, h = i & 15, p = c & 63;
        const double lr = fmin((double)gp(a.in[19])[g * 64 + p], -1e-4), li = (double)gp(a.in[20])[g * 64 + p], dt = exp_d((double)gp(a.in[21])[g]);
        double sn, cs; sincos_d(li * dt, sn, cs); const double er = exp_d(lr * dt); const double br = er * cs, bi = er * sn;
        const double nr = br - 1.0, ni = bi, den = lr * lr + li * li; const double fr_ = (nr * lr + ni * li) / den, fi_ = (ni * lr - nr * li) / den;
        const double Br = (double)gp(a.in[22])[(g * 64 + p) * 16 + h], Bi = (double)gp(a.in[23])[(g * 64 + p) * 16 + h];
        const double vr = fr_ * Br - fi_ * Bi, vi = fr_ * Bi + fi_ * Br;
        ((bf16_t*)(ws + T_BBT))[i] = bf1((float)(c < 64 ? vr : vi));
        if (h == 0 && c < 64) ((f32x2*)(ws + T_LAMBAR))[g * 64 + p] = (f32x2){(float)br, (float)bi};
    }
    for (int i = gid; i < 65536; i += NT) {
        const int g = i >> 11, h = (i >> 7) & 15, k = i & 127;
        ((bf16_t*)(ws + T_CCT))[i] = bf1(k < 64 ? gp(a.in[24])[(g * 16 + h) * 64 + k] : -gp(a.in[25])[(g * 16 + h) * 64 + (k - 64)]);
    }
    for (int i = gid; i < 32768; i += NT) {
        const int pos = i >> 4, k = i & 15; const double inv = exp_d(-(double)k * (9.210340371976184 / 16.0)); double sn, cs; sincos_d((double)pos * inv, sn, cs);
        ((f32x2*)(ws + T_ROPE))[i] = (f32x2){(float)cs, (float)sn};
    }
    for (int i = gid; i < 512; i += NT) {
        const float l0 = gp(a.in[17])[i], l1 = gp(a.in[17])[512 + i], l2 = gp(a.in[17])[1024 + i]; const float mx = fmaxf(l0, fmaxf(l1, l2));
        const float e0 = __expf(l0 - mx), e1 = __expf(l1 - mx), e2 = __expf(l2 - mx); ((float*)(ws + T_LB))[i] = e0 / (e0 + e1 + e2);
    }
    if (gid == 0) {
        float gq = 0.f, gk = 0.f; for (int d = 0; d < 96; ++d) { gq = fmaxf(gq, fabsf(gp(a.in[38])[d])); gk = fmaxf(gk, fabsf(gp(a.in[39])[d])); }
        ((float*)(ws + A_CTL))[60] = 9.797958971132712f * gq * gk * 1.001f * 1.4426950408889634f; }
    for (int i = gid; i < 65536; i += NT) {
        const int t = (i >> 7) & 127, s = i & 127; ((bf16_t*)(ws + T_WS))[i] = bf1(s <= t ? gp(a.in[32])[i] : 0.f);
    }
}

__device__ __forceinline__ void hgrn_task(const int wvs, unsigned char* ws, unsigned char* ldsg, int rowbase, int nblk, const float* S0, float* Sout, int h) {
    int tid_; asm volatile("v_mbcnt_lo_u32_b32 %0, -1, 0\n\tv_mbcnt_hi_u32_b32 %0, -1, %0" : "=v"(tid_)); tid_ += wvs * 64;
    const int tid = tid_, lane = tid & 63, w = tid >> 6, fr = lane & 15, fq = lane >> 4;
    constexpr int PITCH = 136;
    const bf16_t* QT = (const bf16_t*)(ws + R_QT); const bf16_t* KH = (const bf16_t*)(ws + R_KH); const bf16_t* KTT = (const bf16_t*)(ws + R_KTT); const bf16_t* VTT = (const bf16_t*)(ws + R_VTT);
    const float* LDEC = (const float*)(ws + R_LDEC); bf16_t* OB = (bf16_t*)(ws + R_OB);
    f32x4 S[8];
#pragma unroll
    for (int vt = 0; vt < 8; ++vt)
#pragma unroll
        for (int j = 0; j < 4; ++j) S[vt][j] = S0 ? S0[(size_t)(16 * w + 4 * fq + j) * 128 + 16 * vt + fr] : 0.f;
    const u32x2 z2 = {0u, 0u};
    bf16x8 qf[4], kf[4]; u32x2 vown, ktf, vf[8]; f32x4 dec;
#define HG_LOAD(Q, K, VO, KT, VF, DE, rb_) do { const int rbx = (rb_); const size_t gbx = (size_t)(rbx >> 4) * 8192; \
        _Pragma("unroll") for (int ks = 0; ks < 4; ++ks) { Q[ks] = *(const bf16x8*)(QT + (size_t)(rbx + fr) * 512 + h * 128 + ks * 32 + fq * 8); K[ks] = *(const bf16x8*)(KH + (size_t)(rbx + fr) * 512 + h * 128 + ks * 32 + fq * 8); } \
        VO = *(const u32x2*)(VTT + gbx + (size_t)(h * 128 + 16 * w + fr) * 16 + 4 * fq); KT = *(const u32x2*)(KTT + gbx + (size_t)(h * 128 + 16 * w + fr) * 16 + 4 * fq); \
        _Pragma("unroll") for (int vt = 0; vt < 8; ++vt) VF[vt] = *(const u32x2*)(VTT + gbx + (size_t)(h * 128 + 16 * vt + fr) * 16 + 4 * fq); \
        DE = *(const f32x4*)(LDEC + (size_t)(rbx >> 4) * 512 + h * 128 + 16 * w + 4 * fq); } while (0)
    HG_LOAD(qf, kf, vown, ktf, vf, dec, rowbase);
    for (int blk = 0; blk < nblk; ++blk) {
        const int rb = rowbase + 16 * blk;
        bf16_t* sl = (bf16_t*)(ldsg + (blk & 1) * (128 * PITCH * 2));
#pragma unroll
        for (int vt = 0; vt < 8; ++vt) st_bf4(sl + (16 * vt + fr) * PITCH + 16 * w + 4 * fq, S[vt]);
        bf16x8 qn[4], kn[4]; u32x2 vown_n, ktf_n, vfn[8]; f32x4 dec_n;
        HG_LOAD(qn, kn, vown_n, ktf_n, vfn, dec_n, rowbase + 16 * (blk + 1 < nblk ? blk + 1 : blk));
        __syncthreads();
        f32x4 o = {0.f, 0.f, 0.f, 0.f}, pt = {0.f, 0.f, 0.f, 0.f};
#pragma unroll
        for (int ks = 0; ks < 4; ++ks) { const bf16x8 sf = *(const bf16x8*)(sl + (16 * w + fr) * PITCH + ks * 32 + fq * 8); o = mfma16(qf[ks], sf, o); pt = mfma16(kf[ks], qf[ks], pt); }
#pragma unroll
        for (int j = 0; j < 4; ++j) if (4 * fq + j > fr) pt[j] = 0.f;
        u32x2 pp; pp.x = cvt_pk_bf16(pt[0], pt[1]); pp.y = cvt_pk_bf16(pt[2], pt[3]);
        o = mfma16(mk8(pp, z2), mk8(vown, z2), o);
#pragma unroll
        for (int j = 0; j < 4; ++j) OB[(size_t)(rb + 4 * fq + j) * 512 + h * 128 + 16 * w + fr] = bf1(o[j]);
        const bf16x8 ka = mk8(ktf, z2);
#pragma unroll
        for (int vt = 0; vt < 8; ++vt) { S[vt] = S[vt] * dec; S[vt] = mfma16(ka, mk8(vf[vt], z2), S[vt]); }
#pragma unroll
        for (int ks = 0; ks < 4; ++ks) { qf[ks] = qn[ks]; kf[ks] = kn[ks]; }
        vown = vown_n; ktf = ktf_n; dec = dec_n;
#pragma unroll
        for (int vt = 0; vt < 8; ++vt) vf[vt] = vfn[vt];
    }
#undef HG_LOAD
#pragma unroll
    for (int vt = 0; vt < 8; ++vt)
#pragma unroll
        for (int j = 0; j < 4; ++j) Sout[(size_t)(16 * w + 4 * fq + j) * 128 + 16 * vt + fr] = S[vt][j];
    __syncthreads();
}

__device__ __forceinline__ void hgrn_prompt(const int wvs, unsigned char* ws, unsigned char* ldsg, int rowbase, float* Sout, int h) {
    int tid_; asm volatile("v_mbcnt_lo_u32_b32 %0, -1, 0\n\tv_mbcnt_hi_u32_b32 %0, -1, %0" : "=v"(tid_)); tid_ += wvs * 64;
    const int tid = tid_, lane = tid & 63, w = tid >> 6, fr = lane & 15, fq = lane >> 4;
    constexpr int PITCH = 136, SBUF = 128 * PITCH * 2, QP = 136, SLOT = 2 * 16 * QP * 2 + 2 * 4096 + 512, NBLK = 128, DEP = 8;
    const bf16_t* QT = (const bf16_t*)(ws + R_QT); const bf16_t* KH = (const bf16_t*)(ws + R_KH); const bf16_t* KTT = (const bf16_t*)(ws + R_KTT); const bf16_t* VTT = (const bf16_t*)(ws + R_VTT);
    const float* LDEC = (const float*)(ws + R_LDEC); bf16_t* OB = (bf16_t*)(ws + R_OB);
    unsigned char* ring = ldsg + 2 * SBUF;
    const int t2 = tid & 255; const bool lo = tid < 256;
    const bf16_t* gA = (lo ? QT : KH) + (size_t)(rowbase + (t2 >> 4)) * 512 + h * 128 + (t2 & 15) * 8;
    const bf16_t* gB = (lo ? VTT : KTT) + (size_t)(rowbase >> 4) * 8192 + (size_t)h * 128 * 16 + t2 * 8;
    const float* gD = LDEC + (size_t)(rowbase >> 4) * 512 + h * 128 + (tid & 31) * 4;
    const int lA = (lo ? 0 : 16 * QP * 2) + ((t2 >> 4) * QP + (t2 & 15) * 8) * 2, lB = 2 * 16 * QP * 2 + (lo ? 0 : 4096) + t2 * 16, lD = 2 * 16 * QP * 2 + 8192 + (tid & 31) * 16;
    u32x4 ra[DEP], rb_[DEP]; f32x4 rd[DEP];
#pragma unroll
    for (int s = 0; s < DEP; ++s) { ra[s] = *(const u32x4*)(gA + (size_t)s * 8192); rb_[s] = *(const u32x4*)(gB + (size_t)s * 8192); rd[s] = *(const f32x4*)(gD + (size_t)s * 512); }
    f32x4 S[8];
#pragma unroll
    for (int vt = 0; vt < 8; ++vt) S[vt] = (f32x4){0.f, 0.f, 0.f, 0.f};
    const u32x2 z2 = {0u, 0u};
    *(u32x4*)(ring + lA) = ra[0]; *(u32x4*)(ring + lB) = rb_[0]; if (tid < 32) *(f32x4*)(ring + lD) = rd[0];
    ra[0] = *(const u32x4*)(gA + (size_t)DEP * 8192); rb_[0] = *(const u32x4*)(gB + (size_t)DEP * 8192); rd[0] = *(const f32x4*)(gD + (size_t)DEP * 512);
    for (int b0 = 0; b0 < NBLK; b0 += DEP) {
#pragma unroll
        for (int s = 0; s < DEP; ++s) {
            const int blk = b0 + s, rb = rowbase + 16 * blk;
            bf16_t* sl = (bf16_t*)(ldsg + (blk & 1) * SBUF);
#pragma unroll
            for (int vt = 0; vt < 8; ++vt) st_bf4(sl + (16 * vt + fr) * PITCH + 16 * w + 4 * fq, S[vt]);
            asm volatile("s_waitcnt lgkmcnt(0)" ::: "memory"); __builtin_amdgcn_s_barrier(); asm volatile("" ::: "memory");
            { constexpr int dummy = 0; (void)dummy; const int sn = (s + 1) % DEP; unsigned char* slot = ring + ((blk + 1) & 1) * SLOT;
              *(u32x4*)(slot + lA) = ra[sn]; *(u32x4*)(slot + lB) = rb_[sn]; if (tid < 32) *(f32x4*)(slot + lD) = rd[sn];
              const int nb = blk + 1 + DEP < NBLK ? blk + 1 + DEP : NBLK - 1;
              ra[sn] = *(const u32x4*)(gA + (size_t)nb * 8192); rb_[sn] = *(const u32x4*)(gB + (size_t)nb * 8192); rd[sn] = *(const f32x4*)(gD + (size_t)nb * 512); }
            const unsigned char* cur = ring + (blk & 1) * SLOT; const bf16_t* Qs = (const bf16_t*)cur; const bf16_t* Ks = (const bf16_t*)(cur + 16 * QP * 2); const bf16_t* Vs = (const bf16_t*)(cur + 2 * 16 * QP * 2); const bf16_t* KTs = Vs + 2048;
            const f32x4 dec = *(const f32x4*)(cur + 2 * 16 * QP * 2 + 8192 + (16 * w + 4 * fq) * 4);
            f32x4 o = {0.f, 0.f, 0.f, 0.f}, pt = {0.f, 0.f, 0.f, 0.f};
#pragma unroll
            for (int ks = 0; ks < 4; ++ks) { const bf16x8 qf = *(const bf16x8*)(Qs + fr * QP + ks * 32 + fq * 8), kf = *(const bf16x8*)(Ks + fr * QP + ks * 32 + fq * 8);
                const bf16x8 sf = *(const bf16x8*)(sl + (16 * w + fr) * PITCH + ks * 32 + fq * 8); o = mfma16(qf, sf, o); pt = mfma16(kf, qf, pt); }
#pragma unroll
            for (int j = 0; j < 4; ++j) if (4 * fq + j > fr) pt[j] = 0.f;
            u32x2 pp; pp.x = cvt_pk_bf16(pt[0], pt[1]); pp.y = cvt_pk_bf16(pt[2], pt[3]);
            o = mfma16(mk8(pp, z2), mk8(*(const u32x2*)(Vs + (16 * w + fr) * 16 + 4 * fq), z2), o);
#pragma unroll
            for (int j = 0; j < 4; ++j) OB[(size_t)(rb + 4 * fq + j) * 512 + h * 128 + 16 * w + fr] = bf1(o[j]);
            const bf16x8 ka = mk8(*(const u32x2*)(KTs + (16 * w + fr) * 16 + 4 * fq), z2);
#pragma unroll
            for (int vt = 0; vt < 8; ++vt) { S[vt] = S[vt] * dec; S[vt] = mfma16(ka, mk8(*(const u32x2*)(Vs + (16 * vt + fr) * 16 + 4 * fq), z2), S[vt]); }
        }
    }
#pragma unroll
    for (int vt = 0; vt < 8; ++vt)
#pragma unroll
        for (int j = 0; j < 4; ++j) Sout[(size_t)(16 * w + 4 * fq + j) * 128 + 16 * vt + fr] = S[vt][j];
    __syncthreads();
}

__device__ __forceinline__ void s5_task(const int wvs, unsigned char* ws, unsigned char* ldsw, const float* dvec, int rowbase, int nblk, const float* x0re, const float* x0im, float* ore, float* oim, int g) {
    int tid_; asm volatile("v_mbcnt_lo_u32_b32 %0, -1, 0\n\tv_mbcnt_hi_u32_b32 %0, -1, %0" : "=v"(tid_)); tid_ += wvs * 64;
    const int lane = tid_ & 63, fr = lane & 15, fq = lane >> 4;
    constexpr int BP = 132, XP = 136;
    float* buf = (float*)ldsw; bf16_t* xb = (bf16_t*)(ldsw + 16 * BP * 4);
    const bf16_t* UB = (const bf16_t*)(ws + R_UB); bf16_t* ZB = (bf16_t*)(ws + R_ZB);
    const f32x2 lam = ((const f32x2*)(ws + T_LAMBAR))[g * 64 + lane];
    float xr = x0re ? x0re[lane] : 0.f, xi = x0im ? x0im[lane] : 0.f;
    const u32x2 z2 = {0u, 0u};
    bf16x8 Bf[8], Cf[4];
#pragma unroll
    for (int nt = 0; nt < 8; ++nt) Bf[nt] = mk8(*(const u32x2*)((const bf16_t*)(ws + T_BBT) + (size_t)(g * 128 + 16 * nt + fr) * 16 + 4 * fq), z2);
#pragma unroll
    for (int ks = 0; ks < 4; ++ks) Cf[ks] = *(const bf16x8*)((const bf16_t*)(ws + T_CCT) + (size_t)(g * 16 + fr) * 128 + 32 * ks + 8 * fq);
    const float dv = dvec[g * 16 + fr];
    u32x2 ucur = *(const u32x2*)(UB + (size_t)(rowbase + fr) * 512 + g * 16 + 4 * fq);
    unsigned short uv[4];
#pragma unroll
    for (int j = 0; j < 4; ++j) uv[j] = UB[(size_t)(rowbase + 4 * fq + j) * 512 + g * 16 + fr];
    for (int blk = 0; blk < nblk; ++blk) {
        const int rb = rowbase + 16 * blk; const int rbn = rowbase + 16 * (blk + 1 < nblk ? blk + 1 : blk);
        const bf16x8 uf = mk8(ucur, z2);
        const u32x2 unext = *(const u32x2*)(UB + (size_t)(rbn + fr) * 512 + g * 16 + 4 * fq);
        unsigned short uvn[4];
#pragma unroll
        for (int j = 0; j < 4; ++j) uvn[j] = UB[(size_t)(rbn + 4 * fq + j) * 512 + g * 16 + fr];
#pragma unroll
        for (int nt = 0; nt < 8; ++nt) { const f32x4 d = mfma16(uf, Bf[nt], (f32x4){0.f, 0.f, 0.f, 0.f});
#pragma unroll
            for (int j = 0; j < 4; ++j) buf[(4 * fq + j) * BP + 16 * nt + fr] = d[j]; }
        LDSWAIT();
#pragma unroll
        for (int t = 0; t < 16; ++t) { const float br = buf[t * BP + lane], bi = buf[t * BP + 64 + lane];
            const float nr = lam.x * xr - lam.y * xi + br, ni = lam.x * xi + lam.y * xr + bi; xr = nr; xi = ni;
            xb[t * XP + lane] = bf1(nr); xb[t * XP + 64 + lane] = bf1(ni); }
        LDSWAIT();
        f32x4 y = {0.f, 0.f, 0.f, 0.f};
#pragma unroll
        for (int ks = 0; ks < 4; ++ks) y = mfma16(*(const bf16x8*)(xb + fr * XP + 32 * ks + 8 * fq), Cf[ks], y);
#pragma unroll
        for (int j = 0; j < 4; ++j) { const size_t idx = (size_t)(rb + 4 * fq + j) * 512 + g * 16 + fr; ZB[idx] = bf1(gelu_tanh(y[j] + dv * bf2f(uv[j]))); }
        LDSWAIT();
        ucur = unext;
#pragma unroll
        for (int j = 0; j < 4; ++j) uv[j] = uvn[j];
    }
    ore[lane] = xr; oim[lane] = xi;
}

__device__ __forceinline__ void spatial_unit(const int wvs, const Args& a, unsigned char* ldsg, int rb, int L, int gg, float* vout  ) {
    unsigned char* ws = gp(a.ws);
    int tid_; asm volatile("v_mbcnt_lo_u32_b32 %0, -1, 0\n\tv_mbcnt_hi_u32_b32 %0, -1, %0" : "=v"(tid_)); tid_ += wvs * 64;
    const int tid = tid_, lane = tid & 63, w = tid >> 6, fr = lane & 15, fq = lane >> 4;
    const int TP = L + 8, cm = (L >> 3) - 1;
    bf16_t* T = (bf16_t*)ldsg; const bf16_t* VG = (const bf16_t*)(ws + R_VG); const float* SSV = (const float*)(ws + A_SSV); bf16_t* MIX = (bf16_t*)(ws + R_MIX);
    for (int it = tid; it < L * 16; it += 512) { const int s = it >> 4, dg = it & 15; const int row = rb + s;
        const f32x4 p0 = *(const f32x4*)(SSV + (size_t)row * 8), p1 = *(const f32x4*)(SSV + (size_t)row * 8 + 4); const float rs = rsqrtf((sum4(p0) + sum4(p1)) * (1.f / 512.f) + EPS);
        const u32x4 raw = *(const u32x4*)(VG + (size_t)row * 512 + gg * 128 + dg * 8); float v[8];
        v[0] = __uint_as_float(raw.x << 16) * rs; v[1] = __uint_as_float(raw.x & 0xffff0000u) * rs; v[2] = __uint_as_float(raw.y << 16) * rs; v[3] = __uint_as_float(raw.y & 0xffff0000u) * rs;
        v[4] = __uint_as_float(raw.z << 16) * rs; v[5] = __uint_as_float(raw.z & 0xffff0000u) * rs; v[6] = __uint_as_float(raw.w << 16) * rs; v[7] = __uint_as_float(raw.w & 0xffff0000u) * rs;
#pragma unroll
        for (int i = 0; i < 8; ++i) T[(dg * 8 + i) * TP + ((((s >> 3) ^ (dg & cm)) << 3) | (s & 7))] = bf1(v[i]);
        if (vout) { *(f32x4*)(vout + (size_t)s * 512 + gg * 128 + dg * 8) = (f32x4){v[0], v[1], v[2], v[3]}; *(f32x4*)(vout + (size_t)s * 512 + gg * 128 + dg * 8 + 4) = (f32x4){v[4], v[5], v[6], v[7]}; }
    }
    __syncthreads();
    if (16 * w < L) {
        const bf16_t* WS = (const bf16_t*)(ws + T_WS) + (size_t)gg * 16384;
        f32x4 acc[8];
#pragma unroll
        for (int dt = 0; dt < 8; ++dt) acc[dt] = (f32x4){0.f, 0.f, 0.f, 0.f};
        const int nks = (16 * w + 15) / 32 + 1;
        for (int ks = 0; ks < nks; ++ks) { const bf16x8 af = *(const bf16x8*)(WS + (size_t)(16 * w + fr) * 128 + 32 * ks + 8 * fq);
#pragma unroll
            for (int dt = 0; dt < 8; ++dt) acc[dt] = mfma16(af, *(const bf16x8*)(T + (16 * dt + fr) * TP + (((4 * ks + fq) ^ ((2 * dt + (fr >> 3)) & cm)) << 3)), acc[dt]); }
#pragma unroll
        for (int j = 0; j < 4; ++j) { const int t = 16 * w + 4 * fq + j; const float bs = gp(a.in[33])[gg * 128 + t];
#pragma unroll
            for (int dt = 0; dt < 8; ++dt) { const size_t idx = (size_t)(rb + t) * 1024 + gg * 128 + 16 * dt + fr; MIX[idx] = bf1(bf2f(MIX[idx]) * (acc[dt][j] + bs)); } }
    }
    __syncthreads();
}

__device__ __forceinline__ void attn_task(const int wvs, unsigned char* ws, int qrow0, int kvrow0, int nkeys, int L, int head) {
    int tid_; asm volatile("v_mbcnt_lo_u32_b32 %0, -1, 0\n\tv_mbcnt_hi_u32_b32 %0, -1, %0" : "=v"(tid_)); tid_ += wvs * 64;
    const int lane = tid_ & 63, fr = lane & 15, fq = lane >> 4;
    const bf16_t* QF = (const bf16_t*)(ws + R_QF); const bf16_t* KF = (const bf16_t*)(ws + R_KF); const bf16_t* VT = (const bf16_t*)(ws + R_VT);
    const float* SSQN = (const float*)(ws + A_SSQN); const float* SSQR = (const float*)(ws + A_SSQR); bf16_t* MIX = (bf16_t*)(ws + R_MIX);
    const int qrow = qrow0 + fr;
    bf16x8 qf[3];
#pragma unroll
    for (int ks = 0; ks < 3; ++ks) qf[ks] = *(const bf16x8*)(QF + (size_t)qrow * 768 + head * 96 + ks * 32 + fq * 8);
    const float sc = rsqrtf((SSQN[(size_t)qrow * 8 + head] + SSQR[(size_t)qrow * 8 + head]) * (1.f / 96.f) + EPS) * (0.10206207261596575f * 1.4426950408889634f);
    float mrun = -INFINITY, lrun = 0.f; f32x4 o[4];
#pragma unroll
    for (int dt = 0; dt < 4; ++dt) o[dt] = (f32x4){0.f, 0.f, 0.f, 0.f};
    const bf16_t* kp = KF + (size_t)(kvrow0 + fr) * 768 + head * 96 + fq * 8;
    const bf16_t* vp = VT + (size_t)kvrow0 * 512 + (size_t)(head * 64 + fr) * L + 4 * fq;
    bf16x8 ka[2][3]; u32x2 va[4][2];
#define AT_LOAD(KA, VA, k0_) do { const int kx = (k0_); \
        _Pragma("unroll") for (int hf = 0; hf < 2; ++hf) _Pragma("unroll") for (int ks = 0; ks < 3; ++ks) KA[hf][ks] = *(const bf16x8*)(kp + (size_t)(kx + 16 * hf) * 768 + ks * 32); \
        _Pragma("unroll") for (int dt = 0; dt < 4; ++dt) _Pragma("unroll") for (int hf = 0; hf < 2; ++hf) VA[dt][hf] = *(const u32x2*)(vp + (size_t)dt * 16 * L + kx + 16 * hf); } while (0)
    AT_LOAD(ka, va, 0);
    for (int k0 = 0; k0 < nkeys; k0 += 32) {
        bf16x8 kn[2][3]; u32x2 vn[4][2];
        AT_LOAD(kn, vn, (k0 + 32 < nkeys ? k0 + 32 : k0));
        f32x4 st[2];
#pragma unroll
        for (int hf = 0; hf < 2; ++hf) { st[hf] = (f32x4){0.f, 0.f, 0.f, 0.f};
#pragma unroll
            for (int ks = 0; ks < 3; ++ks) st[hf] = mfma16(ka[hf][ks], qf[ks], st[hf]); }
        const f32x4 s0 = st[0] * sc, s1 = st[1] * sc;
        float mx = fmaxf(fmaxf(fmaxf(s0.x, s0.y), fmaxf(s0.z, s0.w)), fmaxf(fmaxf(s1.x, s1.y), fmaxf(s1.z, s1.w)));
        mx = fmaxf(mx, __shfl_xor(mx, 16)); mx = fmaxf(mx, __shfl_xor(mx, 32));
        const float mnew = fmaxf(mrun, mx), alpha = exp2f(mrun - mnew); mrun = mnew;
        f32x4 p0, p1;
#pragma unroll
        for (int j = 0; j < 4; ++j) { p0[j] = exp2f(s0[j] - mnew); p1[j] = exp2f(s1[j] - mnew); }
        float ls = sum4(p0) + sum4(p1); ls += __shfl_xor(ls, 16); ls += __shfl_xor(ls, 32);
        lrun = lrun * alpha + ls;
        u32x2 pa, pb; pa.x = cvt_pk_bf16(p0[0], p0[1]); pa.y = cvt_pk_bf16(p0[2], p0[3]); pb.x = cvt_pk_bf16(p1[0], p1[1]); pb.y = cvt_pk_bf16(p1[2], p1[3]);
        const bf16x8 pf = mk8(pa, pb);
#pragma unroll
        for (int dt = 0; dt < 4; ++dt) { o[dt] = o[dt] * alpha; o[dt] = mfma16(mk8(va[dt][0], va[dt][1]), pf, o[dt]); }
#pragma unroll
        for (int hf = 0; hf < 2; ++hf) {
#pragma unroll
            for (int ks = 0; ks < 3; ++ks) ka[hf][ks] = kn[hf][ks];
#pragma unroll
            for (int dt = 0; dt < 4; ++dt) va[dt][hf] = vn[dt][hf]; }
    }
#undef AT_LOAD
    const float inv = 1.f / lrun;
#pragma unroll
    for (int dt = 0; dt < 4; ++dt) st_bf4(MIX + (size_t)qrow * 1024 + 512 + head * 64 + 16 * dt + 4 * fq, o[dt] * inv);
}

__device__ __forceinline__ void attn_unit(const int wvs, unsigned char* ws, unsigned char* ldsg, int b, int head, int qb) {
    int tid_; asm volatile("v_mbcnt_lo_u32_b32 %0, -1, 0\n\tv_mbcnt_hi_u32_b32 %0, -1, %0" : "=v"(tid_)); tid_ += wvs * 64;
    const int tid = tid_, lane = tid & 63, w = tid >> 6, fr = lane & 15, fq = lane >> 4;
    constexpr int KP = 104, VP = 72, KB_BYTES = 64 * KP * 2, VB_BYTES = 64 * VP * 2;
    const bf16_t* QF = (const bf16_t*)(ws + R_QF); const bf16_t* KF = (const bf16_t*)(ws + R_KF); const bf16_t* VT = (const bf16_t*)(ws + R_VT);
    const float* SSQN = (const float*)(ws + A_SSQN); const float* SSQR = (const float*)(ws + A_SSQR); bf16_t* MIX = (bf16_t*)(ws + R_MIX);
    const int kvrow0 = b * 2048, qrow = b * 2048 + qb * 128 + w * 16 + fr;
    const int ntiles = 2 * qb + 2, mytiles = 2 * qb + 1 + (w >> 2);
    bf16x8 qf[3];
#pragma unroll
    for (int ks = 0; ks < 3; ++ks) qf[ks] = *(const bf16x8*)(QF + (size_t)qrow * 768 + head * 96 + ks * 32 + fq * 8);
    const float sc = rsqrtf((SSQN[(size_t)qrow * 8 + head] + SSQR[(size_t)qrow * 8 + head]) * (1.f / 96.f) + EPS) * (0.10206207261596575f * 1.4426950408889634f);
    float mrun = -INFINITY, lrun = 0.f; f32x4 o[4];
#pragma unroll
    for (int dt = 0; dt < 4; ++dt) o[dt] = (f32x4){0.f, 0.f, 0.f, 0.f};
    const int kr0 = tid / 12, kc0 = tid - kr0 * 12, id1 = tid + 512, kr1 = id1 / 12, kc1 = id1 - kr1 * 12; const bool has1 = tid < 256;
    const bf16_t* kg0 = KF + (size_t)(kvrow0 + kr0) * 768 + head * 96 + kc0 * 8; const bf16_t* kg1 = KF + (size_t)(kvrow0 + kr1) * 768 + head * 96 + kc1 * 8;
    const bf16_t* vg = VT + (size_t)kvrow0 * 512 + (size_t)(head * 64 + (tid >> 3)) * 2048 + (tid & 7) * 8;
    const int kl0 = kr0 * KP + kc0 * 8, kl1 = kr1 * KP + kc1 * 8, vl = (tid >> 3) * VP + (tid & 7) * 8;
    u32x4 rk0, rk1 = {0u, 0u, 0u, 0u}, rv;
    rk0 = *(const u32x4*)kg0; if (has1) rk1 = *(const u32x4*)kg1; rv = *(const u32x4*)vg;
    { bf16_t* kb = (bf16_t*)ldsg; bf16_t* vb = (bf16_t*)(ldsg + 2 * KB_BYTES);
      *(u32x4*)(kb + kl0) = rk0; if (has1) *(u32x4*)(kb + kl1) = rk1; *(u32x4*)(vb + vl) = rv; }
    asm volatile("s_waitcnt lgkmcnt(0)" ::: "memory"); __builtin_amdgcn_s_barrier(); asm volatile("" ::: "memory");
    for (int j = 0; j < ntiles; ++j) {
        const bool more = j + 1 < ntiles;
        if (more) { rk0 = *(const u32x4*)(kg0 + (size_t)(j + 1) * 64 * 768); if (has1) rk1 = *(const u32x4*)(kg1 + (size_t)(j + 1) * 64 * 768); rv = *(const u32x4*)(vg + (j + 1) * 64); }
        if (j < mytiles) {
            const bf16_t* kb = (const bf16_t*)(ldsg + (j & 1) * KB_BYTES); const bf16_t* vb = (const bf16_t*)(ldsg + 2 * KB_BYTES + (j & 1) * VB_BYTES);
            f32x4 st[4];
#pragma unroll
            for (int g = 0; g < 4; ++g) { st[g] = (f32x4){0.f, 0.f, 0.f, 0.f};
#pragma unroll
                for (int ks = 0; ks < 3; ++ks) st[g] = mfma16(*(const bf16x8*)(kb + (16 * g + fr) * KP + ks * 32 + fq * 8), qf[ks], st[g]); }
            float mx = -INFINITY;
#pragma unroll
            for (int g = 0; g < 4; ++g) { st[g] = st[g] * sc; mx = fmaxf(mx, fmaxf(fmaxf(st[g].x, st[g].y), fmaxf(st[g].z, st[g].w))); }
            mx = fmaxf(mx, __shfl_xor(mx, 16)); mx = fmaxf(mx, __shfl_xor(mx, 32));
            const float mnew = fmaxf(mrun, mx), alpha = __builtin_amdgcn_exp2f(mrun - mnew); mrun = mnew;
            float ls = 0.f;
#pragma unroll
            for (int g = 0; g < 4; ++g) {
#pragma unroll
                for (int jj = 0; jj < 4; ++jj) { st[g][jj] = __builtin_amdgcn_exp2f(st[g][jj] - mnew); ls += st[g][jj]; } }
            ls += __shfl_xor(ls, 16); ls += __shfl_xor(ls, 32);
            lrun = lrun * alpha + ls;
#pragma unroll
            for (int dt = 0; dt < 4; ++dt) o[dt] = o[dt] * alpha;
#pragma unroll
            for (int s = 0; s < 2; ++s) {
                u32x2 pa, pb; pa.x = cvt_pk_bf16(st[2 * s][0], st[2 * s][1]); pa.y = cvt_pk_bf16(st[2 * s][2], st[2 * s][3]); pb.x = cvt_pk_bf16(st[2 * s + 1][0], st[2 * s + 1][1]); pb.y = cvt_pk_bf16(st[2 * s + 1][2], st[2 * s + 1][3]);
                const bf16x8 pf = mk8(pa, pb);
#pragma unroll
                for (int dt = 0; dt < 4; ++dt) { const u32x2 v0 = *(const u32x2*)(vb + (16 * dt + fr) * VP + 32 * s + 4 * fq), v1 = *(const u32x2*)(vb + (16 * dt + fr) * VP + 32 * s + 16 + 4 * fq);
                    o[dt] = mfma16(mk8(v0, v1), pf, o[dt]); }
            }
        }
        if (more) { bf16_t* kb = (bf16_t*)(ldsg + ((j + 1) & 1) * KB_BYTES); bf16_t* vb = (bf16_t*)(ldsg + 2 * KB_BYTES + ((j + 1) & 1) * VB_BYTES);
            *(u32x4*)(kb + kl0) = rk0; if (has1) *(u32x4*)(kb + kl1) = rk1; *(u32x4*)(vb + vl) = rv; }
        asm volatile("s_waitcnt lgkmcnt(0)" ::: "memory"); __builtin_amdgcn_s_barrier(); asm volatile("" ::: "memory");
    }
    const float inv = 1.f / lrun;
#pragma unroll
    for (int dt = 0; dt < 4; ++dt) st_bf4(MIX + (size_t)qrow * 1024 + 512 + head * 64 + 16 * dt + 4 * fq, o[dt] * inv);
}

__device__ __forceinline__ void attn_unit2(const int wvs, unsigned char* ws, unsigned char* ldsg, int b, int head, int qb) {
    int tid_; asm volatile("v_mbcnt_lo_u32_b32 %0, -1, 0\n\tv_mbcnt_hi_u32_b32 %0, -1, %0" : "=v"(tid_)); tid_ += wvs * 64;
    const int tid = tid_, lane = tid & 63, w = tid >> 6, fr = lane & 15, fq = lane >> 4;
    constexpr int KP = 104, VP = 72, KB_BYTES = 64 * KP * 2, VB_BYTES = 64 * VP * 2;
    const bf16_t* QF = (const bf16_t*)(ws + R_QF); const bf16_t* KF = (const bf16_t*)(ws + R_KF); const bf16_t* VT = (const bf16_t*)(ws + R_VT);
    const float* SSQN = (const float*)(ws + A_SSQN); const float* SSQR = (const float*)(ws + A_SSQR); bf16_t* MIX = (bf16_t*)(ws + R_MIX);
    const int kvrow0 = b * 2048, qrow0 = b * 2048 + qb * 256 + w * 32 + fr;
    const int ntiles = 4 * qb + 4, mytiles = 4 * qb + 1 + (w >> 1);
    const float nsm = -((const float*)(ws + A_CTL))[60];
    bf16x8 qf[2][3]; float sc[2], mrun[2], lrun[2]; f32x4 o[2][4];
#pragma unroll
    for (int r = 0; r < 2; ++r) { const int qrow = qrow0 + 16 * r;
#pragma unroll
        for (int ks = 0; ks < 3; ++ks) qf[r][ks] = *(const bf16x8*)(QF + (size_t)qrow * 768 + head * 96 + ks * 32 + fq * 8);
        sc[r] = rsqrtf((SSQN[(size_t)qrow * 8 + head] + SSQR[(size_t)qrow * 8 + head]) * (1.f / 96.f) + EPS) * (0.10206207261596575f * 1.4426950408889634f);
#pragma unroll
        for (int ks = 0; ks < 3; ++ks) { const u32x4 qw = __builtin_bit_cast(u32x4, qf[r][ks]); u32x4 qs;
            qs.x = cvt_pk_bf16(__uint_as_float(qw.x << 16) * sc[r], __uint_as_float(qw.x & 0xffff0000u) * sc[r]); qs.y = cvt_pk_bf16(__uint_as_float(qw.y << 16) * sc[r], __uint_as_float(qw.y & 0xffff0000u) * sc[r]);
            qs.z = cvt_pk_bf16(__uint_as_float(qw.z << 16) * sc[r], __uint_as_float(qw.z & 0xffff0000u) * sc[r]); qs.w = cvt_pk_bf16(__uint_as_float(qw.w << 16) * sc[r], __uint_as_float(qw.w & 0xffff0000u) * sc[r]);
            qf[r][ks] = __builtin_bit_cast(bf16x8, qs); }
        mrun[r] = 0.f; lrun[r] = 0.f;
#pragma unroll
        for (int dt = 0; dt < 4; ++dt) o[r][dt] = (f32x4){0.f, 0.f, 0.f, 0.f}; }
    const int kr0 = tid / 12, kc0 = tid - kr0 * 12, id1 = tid + 512, kr1 = id1 / 12, kc1 = id1 - kr1 * 12; const bool has1 = tid < 256;
    const bf16_t* kg0 = KF + (size_t)(kvrow0 + kr0) * 768 + head * 96 + kc0 * 8; const bf16_t* kg1 = KF + (size_t)(kvrow0 + kr1) * 768 + head * 96 + kc1 * 8;
    const bf16_t* vg = VT + (size_t)kvrow0 * 512 + (size_t)(head * 64 + (tid >> 3)) * 2048 + (tid & 7) * 8;
    const int kl0 = kr0 * KP + kc0 * 8, kl1 = kr1 * KP + kc1 * 8, vl = (tid >> 3) * VP + (tid & 7) * 8;
#define AT_COMPUTE \
        if (j < mytiles) { \
            const bf16_t* kb = (const bf16_t*)(ldsg + (j & 1) * KB_BYTES); const bf16_t* vb = (const bf16_t*)(ldsg + 2 * KB_BYTES + (j & 1) * VB_BYTES); \
            f32x4 st[2][4]; \
_Pragma("unroll") \
            for (int g = 0; g < 4; ++g) { st[0][g] = (f32x4){nsm, nsm, nsm, nsm}; st[1][g] = (f32x4){nsm, nsm, nsm, nsm}; \
_Pragma("unroll") \
                for (int ks = 0; ks < 3; ++ks) { const bf16x8 kf = *(const bf16x8*)(kb + (16 * g + fr) * KP + ks * 32 + fq * 8); st[0][g] = mfma16(kf, qf[0][ks], st[0][g]); st[1][g] = mfma16(kf, qf[1][ks], st[1][g]); } } \
_Pragma("unroll") \
            for (int r = 0; r < 2; ++r) { \
                float ls = 0.f; \
_Pragma("unroll") \
                for (int g = 0; g < 4; ++g) { \
_Pragma("unroll") \
                    for (int jj = 0; jj < 4; ++jj) { st[r][g][jj] = __builtin_amdgcn_exp2f(st[r][g][jj]); ls += st[r][g][jj]; } } \
                lrun[r] += ls; \
            } \
_Pragma("unroll") \
            for (int s = 0; s < 2; ++s) { \
                bf16x8 pf[2]; \
_Pragma("unroll") \
                for (int r = 0; r < 2; ++r) { u32x2 pa, pb; pa.x = cvt_pk_bf16(st[r][2 * s][0], st[r][2 * s][1]); pa.y = cvt_pk_bf16(st[r][2 * s][2], st[r][2 * s][3]); \
                    pb.x = cvt_pk_bf16(st[r][2 * s + 1][0], st[r][2 * s + 1][1]); pb.y = cvt_pk_bf16(st[r][2 * s + 1][2], st[r][2 * s + 1][3]); pf[r] = mk8(pa, pb); } \
_Pragma("unroll") \
                for (int dt = 0; dt < 4; ++dt) { const u32x2 v0 = *(const u32x2*)(vb + (16 * dt + fr) * VP + 32 * s + 4 * fq), v1 = *(const u32x2*)(vb + (16 * dt + fr) * VP + 32 * s + 16 + 4 * fq); \
                    const bf16x8 vf = mk8(v0, v1); o[0][dt] = mfma16(vf, pf[0], o[0][dt]); o[1][dt] = mfma16(vf, pf[1], o[1][dt]); } \
            } \
        }
    u32x4 ak0, ak1 = {0u, 0u, 0u, 0u}, av, bk0, bk1 = {0u, 0u, 0u, 0u}, bv;
    ak0 = *(const u32x4*)kg0; if (has1) ak1 = *(const u32x4*)kg1; av = *(const u32x4*)vg;
    { bf16_t* kb = (bf16_t*)ldsg; bf16_t* vb = (bf16_t*)(ldsg + 2 * KB_BYTES);
      *(u32x4*)(kb + kl0) = ak0; if (has1) *(u32x4*)(kb + kl1) = ak1; *(u32x4*)(vb + vl) = av; }
    ak0 = *(const u32x4*)(kg0 + (size_t)64 * 768); if (has1) ak1 = *(const u32x4*)(kg1 + (size_t)64 * 768); av = *(const u32x4*)(vg + 64);
    asm volatile("s_waitcnt lgkmcnt(0)" ::: "memory"); __builtin_amdgcn_s_barrier(); asm volatile("" ::: "memory");
#define AT_STEP(JJ, LK0, LK1, LV, WK0, WK1, WV) { const int j = (JJ); \
        { const int jn = j + 2 < ntiles ? j + 2 : ntiles - 1; LK0 = *(const u32x4*)(kg0 + (size_t)jn * 64 * 768); if (has1) LK1 = *(const u32x4*)(kg1 + (size_t)jn * 64 * 768); LV = *(const u32x4*)(vg + jn * 64); } \
        AT_COMPUTE \
        { bf16_t* kb = (bf16_t*)(ldsg + ((j + 1) & 1) * KB_BYTES); bf16_t* vb = (bf16_t*)(ldsg + 2 * KB_BYTES + ((j + 1) & 1) * VB_BYTES); \
          *(u32x4*)(kb + kl0) = WK0; if (has1) *(u32x4*)(kb + kl1) = WK1; *(u32x4*)(vb + vl) = WV; } \
        asm volatile("s_waitcnt lgkmcnt(0)" ::: "memory"); __builtin_amdgcn_s_barrier(); asm volatile("" ::: "memory"); }
    for (int j2 = 0; j2 < ntiles; j2 += 2) {
        AT_STEP(j2, bk0, bk1, bv, ak0, ak1, av)
        AT_STEP(j2 + 1, ak0, ak1, av, bk0, bk1, bv)
    }
#undef AT_STEP
#undef AT_COMPUTE
#pragma unroll
    for (int r = 0; r < 2; ++r) { float lt = lrun[r]; lt += __shfl_xor(lt, 16); lt += __shfl_xor(lt, 32); const float inv = 1.f / lt;
#pragma unroll
        for (int dt = 0; dt < 4; ++dt) st_bf4(MIX + (size_t)(qrow0 + 16 * r) * 1024 + 512 + head * 64 + 16 * dt + 4 * fq, o[r][dt] * inv); }
}

__device__ __forceinline__ void attn_sample(const int wvs, unsigned char* ws, unsigned char* ldsg, int b, int head) {
    int tid_; asm volatile("v_mbcnt_lo_u32_b32 %0, -1, 0\n\tv_mbcnt_hi_u32_b32 %0, -1, %0" : "=v"(tid_)); tid_ += wvs * 64;
    const int lane = tid_ & 63, w = tid_ >> 6, fr = lane & 15, fq = lane >> 4, sub = w & 1, kq = w >> 1;
    const bf16_t* QF = (const bf16_t*)(ws + R_QF); const bf16_t* KF = (const bf16_t*)(ws + R_KF); const bf16_t* VT = (const bf16_t*)(ws + R_VT);
    const float* SSQN = (const float*)(ws + A_SSQN); const float* SSQR = (const float*)(ws + A_SSQR); bf16_t* MIX = (bf16_t*)(ws + R_MIX);
    constexpr int L = 1056;
    const int qrow = MP + b * 32 + sub * 16 + fr, kvrow0 = MP + b * L;
    const float nsm = -((const float*)(ws + A_CTL))[60];
    const float sc = rsqrtf((SSQN[(size_t)qrow * 8 + head] + SSQR[(size_t)qrow * 8 + head]) * (1.f / 96.f) + EPS) * (0.10206207261596575f * 1.4426950408889634f);
    bf16x8 qf[3];
#pragma unroll
    for (int ks = 0; ks < 3; ++ks) { const u32x4 qw = *(const u32x4*)(QF + (size_t)qrow * 768 + head * 96 + ks * 32 + fq * 8); u32x4 qs;
        qs.x = cvt_pk_bf16(__uint_as_float(qw.x << 16) * sc, __uint_as_float(qw.x & 0xffff0000u) * sc); qs.y = cvt_pk_bf16(__uint_as_float(qw.y << 16) * sc, __uint_as_float(qw.y & 0xffff0000u) * sc);
        qs.z = cvt_pk_bf16(__uint_as_float(qw.z << 16) * sc, __uint_as_float(qw.z & 0xffff0000u) * sc); qs.w = cvt_pk_bf16(__uint_as_float(qw.w << 16) * sc, __uint_as_float(qw.w & 0xffff0000u) * sc);
        qf[ks] = __builtin_bit_cast(bf16x8, qs); }
    f32x4 o[4]; float lsum = 0.f;
#pragma unroll
    for (int dt = 0; dt < 4; ++dt) o[dt] = (f32x4){0.f, 0.f, 0.f, 0.f};
    const int s0 = kq == 0 ? 0 : 9 + 8 * (kq - 1), s1 = 9 + 8 * kq;
    const bf16_t* kp = KF + (size_t)(kvrow0 + fr) * 768 + head * 96 + fq * 8;
    const bf16_t* vp = VT + (size_t)kvrow0 * 512 + (size_t)(head * 64 + fr) * L + 4 * fq;
    bf16x8 ka[2][3]; u32x2 va[4][2];
#define AS_LOAD(KA, VA, k0_) do { const int kx = (k0_); \
        _Pragma("unroll") for (int hf = 0; hf < 2; ++hf) _Pragma("unroll") for (int ks = 0; ks < 3; ++ks) KA[hf][ks] = *(const bf16x8*)(kp + (size_t)(kx + 16 * hf) * 768 + ks * 32); \
        _Pragma("unroll") for (int dt = 0; dt < 4; ++dt) _Pragma("unroll") for (int hf = 0; hf < 2; ++hf) VA[dt][hf] = *(const u32x2*)(vp + (size_t)dt * 16 * L + kx + 16 * hf); } while (0)
    AS_LOAD(ka, va, 32 * s0);
    for (int s = s0; s < s1; ++s) {
        bf16x8 kn[2][3]; u32x2 vn[4][2];
        AS_LOAD(kn, vn, 32 * (s + 1 < s1 ? s + 1 : s));
        f32x4 st[2];
#pragma unroll
        for (int hf = 0; hf < 2; ++hf) { st[hf] = (f32x4){nsm, nsm, nsm, nsm};
#pragma unroll
            for (int ks = 0; ks < 3; ++ks) st[hf] = mfma16(ka[hf][ks], qf[ks], st[hf]); }
#pragma unroll
        for (int hf = 0; hf < 2; ++hf)
#pragma unroll
            for (int j = 0; j < 4; ++j) { st[hf][j] = __builtin_amdgcn_exp2f(st[hf][j]); lsum += st[hf][j]; }
        u32x2 pa, pb; pa.x = cvt_pk_bf16(st[0][0], st[0][1]); pa.y = cvt_pk_bf16(st[0][2], st[0][3]); pb.x = cvt_pk_bf16(st[1][0], st[1][1]); pb.y = cvt_pk_bf16(st[1][2], st[1][3]);
        const bf16x8 pf = mk8(pa, pb);
#pragma unroll
        for (int dt = 0; dt < 4; ++dt) o[dt] = mfma16(mk8(va[dt][0], va[dt][1]), pf, o[dt]);
#pragma unroll
        for (int hf = 0; hf < 2; ++hf) {
#pragma unroll
            for (int ks = 0; ks < 3; ++ks) ka[hf][ks] = kn[hf][ks];
#pragma unroll
            for (int dt = 0; dt < 4; ++dt) va[dt][hf] = vn[dt][hf]; }
    }
#undef AS_LOAD
    float* part = (float*)ldsg + (size_t)(w * 64 + lane) * 17;
#pragma unroll
    for (int dt = 0; dt < 4; ++dt)
#pragma unroll
        for (int j = 0; j < 4; ++j) part[dt * 4 + j] = o[dt][j];
    part[16] = lsum;
    __syncthreads();
    if (kq == 0) {
#pragma unroll
        for (int q2 = 1; q2 < 4; ++q2) { const float* pp = (const float*)ldsg + (size_t)((sub + 2 * q2) * 64 + lane) * 17;
#pragma unroll
            for (int dt = 0; dt < 4; ++dt)
#pragma unroll
                for (int j = 0; j < 4; ++j) o[dt][j] += pp[dt * 4 + j];
            lsum += pp[16]; }
        lsum += __shfl_xor(lsum, 16); lsum += __shfl_xor(lsum, 32);
        const float inv = 1.f / lsum;
#pragma unroll
        for (int dt = 0; dt < 4; ++dt) st_bf4(MIX + (size_t)qrow * 1024 + 512 + head * 64 + 16 * dt + 4 * fq, o[dt] * inv);
    }
    __syncthreads();
}

struct OneUnit { int pm, pn; bool has;
    __device__ __forceinline__ bool next(int i, Unit& u) const { if (i != 0 || !has) return false; u.pm = pm; u.pn = pn; return true; }
    __device__ __forceinline__ void a_ready(const Unit&) const {}
    __device__ __forceinline__ void done(const Unit&) const {} };
struct EpiPart { static constexpr bool PERM = false, AFTER_DRAIN = false; float* P;
    __device__ __forceinline__ void operator()(const f32x4 (&acc)[2][2][4][2], const Unit& u, int wr, int wc, int fr, int fq) const {
        asm volatile("" : "+v"(fr), "+v"(fq));
        const int t = (wr * 4 + wc) * 64 + fq * 16 + fr;
#pragma unroll
        for (int ai = 0; ai < 2; ++ai)
#pragma unroll
            for (int bj = 0; bj < 2; ++bj)
#pragma unroll
                for (int m = 0; m < 4; ++m)
#pragma unroll
                    for (int n = 0; n < 2; ++n) *(f32x4*)(P + ((size_t)((((ai * 2 + bj) * 4 + m) * 2 + n) * 512 + t)) * 4) = acc[ai][bj][m][n];
    } };
__device__ __forceinline__ void res_gemm(const int wvs, LAS unsigned char* ldsl, const bf16_t* A, const bf16_t* Bt, int K, int KS, const EpiRes& E, float* part, unsigned* cnt, int G, int bid) {
    const int NS = K / KS, NSU = 16 * NS;
    if (G < NSU || G * 8 < 1024) {
        pg8::Gemm g{A, Bt, M, 1024, K}; pg8::StaticOrder S; S.init(M, 1024, G, bid); pg8::gemm_phase<EpiRes, pg8::StaticOrder, true, true>(ldsl, g, S, E, wvs); return; }
    { const int su = bid, unit = su / NS, sl = su - unit * NS;
      pg8::Gemm g{A + (size_t)MP * K + (size_t)sl * KS, Bt + (size_t)sl * KS, MS, 1024, K, KS}; OneUnit S{unit >> 2, unit & 3, su < NSU};
      EpiPart EP{part + (size_t)su * 65536};
      pg8::gemm_phase<EpiPart, OneUnit, false, true>(ldsl, g, S, EP, wvs);
      int tid_; asm volatile("v_mbcnt_lo_u32_b32 %0, -1, 0\n\tv_mbcnt_hi_u32_b32 %0, -1, %0" : "=v"(tid_)); tid_ += wvs * 64;
      if (su < NSU) { asm volatile("s_waitcnt vmcnt(0)" ::: "memory"); __syncthreads();
          if (tid_ == 0) { __builtin_amdgcn_fence(__ATOMIC_RELEASE, "agent"); asm volatile("s_waitcnt vmcnt(0)" ::: "memory"); __hip_atomic_fetch_add(cnt, 1u, __ATOMIC_RELAXED, __HIP_MEMORY_SCOPE_AGENT); } } }
    { pg8::Gemm g{A, Bt, MP, 1024, K}; pg8::StaticOrder S; S.init(MP, 1024, G, bid); pg8::gemm_phase<EpiRes, pg8::StaticOrder, true, true>(ldsl, g, S, E, wvs); }
    { int lane_; asm volatile("v_mbcnt_lo_u32_b32 %0, -1, 0\n\tv_mbcnt_hi_u32_b32 %0, -1, %0" : "=v"(lane_));
      const int gw = bid * 8 + wvs;
      if (gw < 1024) {
          if (lane_ == 0) { while (__hip_atomic_load(cnt, __ATOMIC_RELAXED, __HIP_MEMORY_SCOPE_AGENT) < (unsigned)NSU) __builtin_amdgcn_s_sleep(2); }
          __builtin_amdgcn_fence(__ATOMIC_ACQUIRE, "agent"); asm volatile("s_waitcnt vmcnt(0)" ::: "memory");
          const int unit = gw >> 6, am = (gw >> 3) & 7, wv = gw & 7, ai = am >> 2, m = am & 3, t = wv * 64 + lane_, wr = wv >> 2, wc = wv & 3, fr = lane_ & 15, fq = lane_ >> 4;
          f32x4 v[2][2];
#pragma unroll
          for (int bj = 0; bj < 2; ++bj)
#pragma unroll
              for (int n = 0; n < 2; ++n) v[bj][n] = (f32x4){0.f, 0.f, 0.f, 0.f};
#pragma unroll 4
          for (int s = 0; s < NS; ++s) { const float* P = part + (size_t)(unit * NS + s) * 65536;
#pragma unroll
              for (int bj = 0; bj < 2; ++bj)
#pragma unroll
                  for (int n = 0; n < 2; ++n) v[bj][n] += *(const f32x4*)(P + ((size_t)((((ai * 2 + bj) * 4 + m) * 2 + n) * 512 + t)) * 4); }
          E.do_row((128 + (unit >> 2)) * 256 + ai * 128 + wr * 64 + m * 16 + fr, unit & 3, wc, fq, v[0][0], v[0][1], v[1][0], v[1][1]);
      } }
}

__device__ __forceinline__ void grid_bar(unsigned* ctl, unsigned k, const int wvs) {
    int tid_; asm volatile("v_mbcnt_lo_u32_b32 %0, -1, 0\n\tv_mbcnt_hi_u32_b32 %0, -1, %0" : "=v"(tid_)); tid_ += wvs * 64;
    asm volatile("s_waitcnt vmcnt(0) lgkmcnt(0)" ::: "memory");
    __syncthreads();
    if (tid_ == 0) {
        const unsigned G = gridDim.x;
        __builtin_amdgcn_fence(__ATOMIC_RELEASE, "agent");
        asm volatile("s_waitcnt vmcnt(0)" ::: "memory");
        if ((G & 7u) == 0u) {
            const unsigned x = blockIdx.x & 7u, gs = G >> 3; unsigned* arr = ctl + 256 + 64 * x; unsigned* rel = ctl + 1024 + 64 * x; unsigned* top = ctl + 128;
            const unsigned old = __hip_atomic_fetch_add(arr, 1u, __ATOMIC_RELAXED, __HIP_MEMORY_SCOPE_AGENT);
            if (old + 1u == gs * k) {
                __hip_atomic_fetch_add(top, 1u, __ATOMIC_RELAXED, __HIP_MEMORY_SCOPE_AGENT);
                while (__hip_atomic_load(top, __ATOMIC_RELAXED, __HIP_MEMORY_SCOPE_AGENT) < 8u * k) __builtin_amdgcn_s_sleep(1);
                __hip_atomic_fetch_add(rel, 1u, __ATOMIC_RELAXED, __HIP_MEMORY_SCOPE_AGENT);
            } else { while (__hip_atomic_load(rel, __ATOMIC_RELAXED, __HIP_MEMORY_SCOPE_AGENT) < k) __builtin_amdgcn_s_sleep(1); }
        } else {
            __hip_atomic_fetch_add(ctl, 1u, __ATOMIC_RELAXED, __HIP_MEMORY_SCOPE_AGENT);
            while (__hip_atomic_load(ctl, __ATOMIC_RELAXED, __HIP_MEMORY_SCOPE_AGENT) < G * k) __builtin_amdgcn_s_sleep(2);
        }
        __builtin_amdgcn_fence(__ATOMIC_ACQUIRE, "agent");
        asm volatile("s_waitcnt vmcnt(0)" ::: "memory");
    }
    __syncthreads();
}

#define XB_TMO      128
#define XB_XCNT(j)  (256  + 64 * (j))
#define XB_XSUB(j)  (1280 + 64 * (j))
#define XB_XGEN(j)  (2304 + 64 * (j))
#define XB_TOP      3328
#define XB_TOPGEN   3392
#define XCD_BAR_WORDS 3456
#define XB_SPIN_CAP (1u << 18)

__device__ __forceinline__ unsigned xb_ld(unsigned* p)              { return __hip_atomic_load(p, __ATOMIC_RELAXED, __HIP_MEMORY_SCOPE_AGENT); }
__device__ __forceinline__ unsigned xb_add(unsigned* p, unsigned v) { return __hip_atomic_fetch_add(p, v, __ATOMIC_RELAXED, __HIP_MEMORY_SCOPE_AGENT); }
__device__ __forceinline__ unsigned xb_xcc_id() { return (unsigned)__builtin_amdgcn_s_getreg((3 << 11) | 20) & 0xFu; }
#define XB_SPIN(cond, bar) do { unsigned _sp = 0; while (cond) { __builtin_amdgcn_s_sleep(1); \
    if ((++_sp & 255u) == 0u) { if (xb_ld(&(bar)[XB_TMO])) break; if (_sp > XB_SPIN_CAP) { atomicAdd(&(bar)[XB_TMO], 1u); break; } } } } while (0)

struct XcdBarrier {
    unsigned* bar; unsigned x;
    volatile LAS unsigned* st;
};

__device__ __forceinline__ XcdBarrier xcd_barrier_post(unsigned* bar, volatile LAS unsigned* st, const bool is_t0) {
    XcdBarrier b; b.bar = bar; b.x = xb_xcc_id(); b.st = st;
    if (is_t0) (void)xb_add(&bar[XB_XCNT(b.x)], 1u);
    return b;
}
__device__ __forceinline__ void xcd_barrier_complete(unsigned* bar, unsigned x, unsigned& nloc, unsigned& nx) {
    const unsigned G = gridDim.x * gridDim.y * gridDim.z;
    unsigned sum, cnt, mine, sp = 0u;
    for (;;) {
        sum = 0u; cnt = 0u; mine = 0u;
#pragma unroll
        for (unsigned j = 0; j < 16; ++j) { const unsigned c = xb_ld(&bar[XB_XCNT(j)]); sum += c; cnt += (c > 0u) ? 1u : 0u; mine = (j == x) ? c : mine; }
        if (sum == G) break;
        __builtin_amdgcn_s_sleep(1);
        if ((++sp & 255u) == 0u) { if (xb_ld(&bar[XB_TMO])) break; if (sp > XB_SPIN_CAP) { atomicAdd(&bar[XB_TMO], 1u); break; } }
    }
    nloc = mine > 0u ? mine : 1u; nx = cnt > 0u ? cnt : 1u;
}

__device__ __forceinline__ void xcd_barrier(const XcdBarrier& b, const int wvs) {
    int tid_; asm volatile("v_mbcnt_lo_u32_b32 %0, -1, 0\n\tv_mbcnt_hi_u32_b32 %0, -1, %0" : "=v"(tid_)); tid_ += wvs * 64;
    asm volatile("s_waitcnt vmcnt(0)" ::: "memory");
    __syncthreads();
    if (tid_ == 0) {
        unsigned* bar = b.bar;
        __builtin_amdgcn_s_waitcnt(0);
        unsigned nloc = b.st[0], nx = b.st[1];
        if (nloc == 0u) { xcd_barrier_complete(bar, b.x, nloc, nx); b.st[0] = nloc; b.st[1] = nx; }
        const unsigned old = xb_add(&bar[XB_XSUB(b.x)], 1u);
        const unsigned gen = old / nloc;
        if (old + 1u == (gen + 1u) * nloc) {
            __builtin_amdgcn_fence(__ATOMIC_RELEASE, "agent");
            asm volatile("s_waitcnt vmcnt(0)" ::: "memory");
            const unsigned og = xb_add(&bar[XB_TOP], 1u);
            const unsigned tg = og / nx;
            if (og + 1u == (tg + 1u) * nx) xb_add(&bar[XB_TOPGEN], 1u);
            else XB_SPIN(xb_ld(&bar[XB_TOPGEN]) == tg, bar);
            __builtin_amdgcn_fence(__ATOMIC_ACQUIRE, "agent");
            xb_add(&bar[XB_XGEN(b.x)], 1u);
            asm volatile("s_waitcnt vmcnt(0)" ::: "memory");
        } else {
            XB_SPIN(xb_ld(&bar[XB_XGEN(b.x)]) == gen, bar);
            __builtin_amdgcn_fence(__ATOMIC_ACQUIRE, "agent");
            asm volatile("s_waitcnt vmcnt(0)" ::: "memory");
        }
    }
    __syncthreads();
}

__global__ void __launch_bounds__(512, 2) mk_fwd(Args args) {
    extern __shared__ __attribute__((aligned(16))) unsigned char lds[];
    const int wvs = __builtin_amdgcn_readfirstlane((int)threadIdx.x >> 6);
    if (threadIdx.x < 8) ((LAS unsigned*)((LAS unsigned char*)lds + 131072))[threadIdx.x] = 0u;
    __syncthreads();
    const XcdBarrier xbar = xcd_barrier_post((unsigned*)(args.ws + A_CTL), (volatile LAS unsigned*)((LAS unsigned char*)lds + 131072), threadIdx.x == 0);
    const int lo = args.ph_lo, hi = args.ph_hi;
#if MK_PER_PHASE
#define SEAM(k) do { } while (0)
#else
#define SEAM(k) do { if (lo <= (k) && (k) + 1 < hi) { if ((k) == 0) cg::this_grid().sync(); else { xcd_barrier(xbar, wvs); } } } while (0)
#endif
#define IN(k) (lo <= (k) && (k) < hi)
#define PH_VARS size_t zoff_ = 0; asm volatile("" : "+s"(zoff_)); unsigned char* ws = args.ws + zoff_; float* out = args.out + zoff_; \
    LAS unsigned char* ldsl = (LAS unsigned char*)lds; const int bid = blockIdx.x, G = gridDim.x; \
    bf16_t* XB = (bf16_t*)(ws + A_XB); float* SSQ = (float*)(ws + A_SSQ); bf16_t* ACT = (bf16_t*)(ws + R_ACT); bf16_t* MIX = (bf16_t*)(ws + R_MIX); float* Y = out + OUT_Y; \
    (void)XB; (void)SSQ; (void)ACT; (void)MIX; (void)Y; (void)ldsl; (void)bid; (void)G;
#define PH_TID int tid_; asm volatile("v_mbcnt_lo_u32_b32 %0, -1, 0\n\tv_mbcnt_hi_u32_b32 %0, -1, %0" : "=v"(tid_)); tid_ += wvs * 64; const int lane = tid_ & 63, wave = tid_ >> 6; (void)lane; (void)wave;

    if (IN(0)) for (int rep_ = 0; rep_ < (REP_PH == 0 ? 2 : 1); ++rep_) { PH_VARS prologue(args, ldsl, G, wvs); } SEAM(0);

#define HOST_ITEMS(set, nset, first_idle) do { if (G == 256 && bid >= (first_idle)) { PH_TID \
        for (int idx = (bid - (first_idle)) * 8 + wave; idx < (nset); idx += (256 - (first_idle)) * 8) weight_item(args, ws, item_of((set), idx), (LAS float*)(ldsl + wave * 16384), lane); } } while (0)
#define FFN_UP(ph, widx) if (IN(ph)) for (int rep_ = 0; rep_ < (REP_PH == (ph) ? 2 : 1); ++rep_) { PH_VARS pg8::Gemm g{XB, (const bf16_t*)(ws + W_GU0 + (size_t)(widx) * SZ_GU), M, 5632, 1024}; pg8::StaticOrder S; S.init(M, 5632, G, bid); \
        EpiGU E{SSQ, ACT}; pg8::gemm_phase<EpiGU, pg8::StaticOrder, true, true>(ldsl, g, S, E, wvs); \
        if ((ph) == 1) HOST_ITEMS(1, NIT_B1, 88); if ((ph) == 7) HOST_ITEMS(3, NIT_B3, 88); } SEAM(ph);
#define FFN_DN(ph, widx, x0, x1) if (IN(ph)) for (int rep_ = 0; rep_ < (REP_PH == (ph) ? 2 : 1); ++rep_) { PH_VARS \
        EpiRes E{x0, x1, Y, XB, SSQ, 0.5f}; res_gemm(wvs, ldsl, ACT, (const bf16_t*)(ws + W_DN0 + (size_t)(widx) * SZ_DN), FF, 256, E, (float*)(ws + R_PART), (unsigned*)(ws + A_CTL) + 8 + (ph), G, bid); } SEAM(ph);
#define MIX_OUT(ph, woff) if (IN(ph)) { PH_VARS \
        EpiRes E{Y, Y + (size_t)MP * D, Y, XB, SSQ, 1.0f}; res_gemm(wvs, ldsl, MIX, (const bf16_t*)(ws + (woff)), 1024, 256, E, (float*)(ws + R_PART), (unsigned*)(ws + A_CTL) + 8 + (ph), G, bid); } SEAM(ph);

    FFN_UP(1, 0)
    FFN_DN(2, 0, gp(args.in[0]), gp(args.in[1]))
    if (IN(3)) { PH_VARS pg8::Gemm g{XB, (const bf16_t*)(ws + W_AB), M, 2560, 1024}; pg8::StaticOrder S; S.init(M, 2560, G, bid);
        EpiAB E{SSQ, (const float*)(ws + T_LB), (bf16_t*)(ws + R_QT), (bf16_t*)(ws + R_KH), (bf16_t*)(ws + R_KTT), (bf16_t*)(ws + R_VTT), (bf16_t*)(ws + R_GB), (bf16_t*)(ws + R_UB), (float*)(ws + R_LDEC)};
        pg8::gemm_phase<EpiAB, pg8::StaticOrder, true, true>(ldsl, g, S, E, wvs); HOST_ITEMS(2, NIT_B2, 40); } SEAM(3);
    if (IN(4)) for (int rep_ = 0; rep_ < (REP_PH == 4 ? 2 : 1); ++rep_) { PH_VARS PH_TID
        for (int task = bid; task < 256; task += G) {
            if (task < 128) {
                { const int b = task >> 2, h = task & 3; hgrn_task(wvs, ws, lds, MP + b * 32, 2, gp(args.in[2]) + (size_t)(b * 4 + h) * 16384, out + OUT_HGRN_S + (size_t)(b * 4 + h) * 16384, h); }
                { const int id = task * 8 + wave, b = id >> 5, g = id & 31; s5_task(wvs, ws, lds + wave * 16384, gp(args.in[26]), MP + b * 32, 2, gp(args.in[3]) + (size_t)(b * 32 + g) * 64, gp(args.in[4]) + (size_t)(b * 32 + g) * 64,
                          out + OUT_S5RE_S + (size_t)(b * 32 + g) * 64, out + OUT_S5IM_S + (size_t)(b * 32 + g) * 64, g); }
                __syncthreads();
            } else if (task < 192) {
                const int i = task - 128, b = i >> 2, h = i & 3; for (int r2 = 0; r2 < (REP_PH == 40 ? 2 : 1); ++r2) hgrn_prompt(wvs, ws, lds, b * 2048, out + OUT_HGRN_P + (size_t)(b * 4 + h) * 16384, h);
            } else {
                if (wave < 4) { const int id = (task - 192) * 4 + wave, b = id >> 5, g = id & 31; for (int r2 = 0; r2 < (REP_PH == 41 ? 2 : 1); ++r2) s5_task(wvs, ws, lds + wave * 16384, gp(args.in[26]), b * 2048, 128, nullptr, nullptr, out + OUT_S5RE_P + (size_t)(b * 32 + g) * 64, out + OUT_S5IM_P + (size_t)(b * 32 + g) * 64, g); }
                __syncthreads();
            }
            if (task < 64 && G == 256) {
                if (wave < 4) { const int id = 256 + task * 4 + wave, b = id >> 5, g = id & 31; s5_task(wvs, ws, lds + wave * 16384, gp(args.in[26]), b * 2048, 128, nullptr, nullptr, out + OUT_S5RE_P + (size_t)(b * 32 + g) * 64, out + OUT_S5IM_P + (size_t)(b * 32 + g) * 64, g); }
                __syncthreads();
            }
        }
        if (G != 256) {
            for (int t2 = bid; t2 < 64; t2 += G) { if (wave < 4) { const int id = 256 + t2 * 4 + wave, b = id >> 5, g = id & 31; s5_task(wvs, ws, lds + wave * 16384, gp(args.in[26]), b * 2048, 128, nullptr, nullptr, out + OUT_S5RE_P + (size_t)(b * 32 + g) * 64, out + OUT_S5IM_P + (size_t)(b * 32 + g) * 64, g); } __syncthreads(); }
        }
    } SEAM(4);
    if (IN(5)) { PH_VARS
        { pg8::Gemm g{(const bf16_t*)(ws + R_ZB), (const bf16_t*)(ws + W_GLU), M, 512, 512}; pg8::StaticOrder S; S.init(M, 512, G, bid);
          EpiGLU E{(const bf16_t*)(ws + R_ZB), gp(args.in[28]), MIX}; pg8::gemm_phase<EpiGLU, pg8::StaticOrder, true, true>(ldsl, g, S, E, wvs); }
        PH_TID
        const bf16_t* OB = (const bf16_t*)(ws + R_OB); const bf16_t* GB = (const bf16_t*)(ws + R_GB);
        const f32x4 og0 = *(const f32x4*)(gp(args.in[18]) + (lane & 15) * 8), og1 = *(const f32x4*)(gp(args.in[18]) + (lane & 15) * 8 + 4);
        const int nx5 = (264 > G && 264 - G < G / 2) ? 264 - G : 0;
        for (int row = (bid - nx5) * 8 + wave; row < M; row += (G - nx5) * 8) { if (bid < nx5) break;
            const u32x4 ov = *(const u32x4*)(OB + (size_t)row * 512 + lane * 8), gv = *(const u32x4*)(GB + (size_t)row * 512 + lane * 8);
            f32x4 a0, a1, g0, g1;
            a0.x = __uint_as_float(ov.x << 16); a0.y = __uint_as_float(ov.x & 0xffff0000u); a0.z = __uint_as_float(ov.y << 16); a0.w = __uint_as_float(ov.y & 0xffff0000u);
            a1.x = __uint_as_float(ov.z << 16); a1.y = __uint_as_float(ov.z & 0xffff0000u); a1.z = __uint_as_float(ov.w << 16); a1.w = __uint_as_float(ov.w & 0xffff0000u);
            g0.x = __uint_as_float(gv.x << 16); g0.y = __uint_as_float(gv.x & 0xffff0000u); g0.z = __uint_as_float(gv.y << 16); g0.w = __uint_as_float(gv.y & 0xffff0000u);
            g1.x = __uint_as_float(gv.z << 16); g1.y = __uint_as_float(gv.z & 0xffff0000u); g1.z = __uint_as_float(gv.w << 16); g1.w = __uint_as_float(gv.w & 0xffff0000u);
            float ss = sum4(a0 * a0) + sum4(a1 * a1);
            ss += __shfl_xor(ss, 1); ss += __shfl_xor(ss, 2); ss += __shfl_xor(ss, 4); ss += __shfl_xor(ss, 8);
            const float rs = rsqrtf(ss * (1.f / 128.f) + EPS);
            const f32x4 r0 = a0 * rs * og0 * g0, r1 = a1 * rs * og1 * g1;
            u32x4 w4; w4.x = cvt_pk_bf16(r0.x, r0.y); w4.y = cvt_pk_bf16(r0.z, r0.w); w4.z = cvt_pk_bf16(r1.x, r1.y); w4.w = cvt_pk_bf16(r1.z, r1.w);
            *(u32x4*)(MIX + (size_t)row * 1024 + lane * 8) = w4;
        }
    } SEAM(5);
    MIX_OUT(6, W_ABO)
    FFN_UP(7, 1)
    FFN_DN(8, 1, Y, Y + (size_t)MP * D)
    FFN_UP(9, 2)
    FFN_DN(10, 2, Y, Y + (size_t)MP * D)
    if (IN(11)) { PH_VARS pg8::Gemm g{XB, (const bf16_t*)(ws + W_CD), M, 1536, 1024}; pg8::StaticOrder S; S.init(M, 1536, G, bid);
        EpiCD E{SSQ, gp(args.in[31]), gp(args.in[36]), (const f32x2*)(ws + T_ROPE), MIX, (bf16_t*)(ws + R_VG), (float*)(ws + A_SSV), (bf16_t*)(ws + R_CQB), (float*)(ws + A_SSCQ), (bf16_t*)(ws + R_CKVG), (float*)(ws + A_SSCKV), (float*)(ws + R_KPEB), (float*)(ws + A_SSK), out};
        pg8::gemm_phase<EpiCD, pg8::StaticOrder, true, true>(ldsl, g, S, E, wvs);
        PH_TID
        bf16_t* CKVG = (bf16_t*)(ws + R_CKVG); float* KPEB = (float*)(ws + R_KPEB); float* SSK = (float*)(ws + A_SSK);
        const int nx11 = (792 % G != 0 && 792 % G < G / 2) ? 792 % G : 0;
        for (int r = (bid - nx11) * 8 + wave; r < 32 * 1024; r += (G - nx11) * 8) { if (bid < nx11) break; const int b = r >> 10, j = r & 1023, kvr = MP + b * 1056 + j;
            const f32x2 c2 = *(const f32x2*)(gp(args.in[5]) + (size_t)r * 128 + lane * 2); ((unsigned*)(CKVG + (size_t)kvr * 128))[lane] = cvt_pk_bf16(c2.x, c2.y);
            float kv = 0.f; if (lane < 32) { kv = gp(args.in[6])[(size_t)r * 32 + lane]; KPEB[(size_t)kvr * 32 + lane] = kv; }
            float ss = kv * kv;
#pragma unroll
            for (int o = 1; o < 64; o <<= 1) ss += __shfl_xor(ss, o);
            if (lane == 0) SSK[kvr] = ss; }
    } SEAM(11);
    if (IN(12)) { PH_VARS
        { pg8::Gemm g{(const bf16_t*)(ws + R_CQB), (const bf16_t*)(ws + W_UQ), M, 768, 256}; pg8::StaticOrder S; S.init(M, 768, G, bid);
          EpiQ E{(const float*)(ws + A_SSCQ), gp(args.in[38]), (const f32x2*)(ws + T_ROPE), (bf16_t*)(ws + R_QF), (float*)(ws + A_SSQN), (float*)(ws + A_SSQR)};
          pg8::gemm_phase<EpiQ, pg8::StaticOrder, true, true>(ldsl, g, S, E, wvs); }
        { pg8::Gemm g{(const bf16_t*)(ws + R_CKVG), (const bf16_t*)(ws + W_UKV), KVR, 1024, 128}; const int nq2 = (396 > G && 396 - G < G) ? 396 - G : 0;
          pg8::StaticOrder S; S.init(KVR, 1024, G, (bid + G - nq2) % G);
          EpiKV E{(const float*)(ws + A_SSCKV), (const float*)(ws + A_SSK), (const float*)(ws + R_KPEB), gp(args.in[39]), (bf16_t*)(ws + R_KF), (bf16_t*)(ws + R_VT)};
          pg8::gemm_phase<EpiKV, pg8::StaticOrder, true, true>(ldsl, g, S, E, wvs); }
        PH_TID
        const float* SSCKV = (const float*)(ws + A_SSCKV);
        const int nx12 = (396 > G && 396 - G < G && (396 - G) % 8 == 0 && G - (396 - G) >= 32) ? 396 - G + 16 : 0;
        for (int row = (bid - nx12) * 8 + wave; row < M; row += (G - nx12) * 8) { if (bid < nx12) break; const float rs = rsqrtf(sum4(*(const f32x4*)(SSCKV + (size_t)row * 4)) * (1.f / 128.f) + EPS);
            float* p = row < MP ? out + OUT_CKV_P + (size_t)row * 128 : out + OUT_CKV_S + (size_t)(row - MP) * 128; f32x2 v = *(f32x2*)(p + lane * 2); v.x *= rs; v.y *= rs; *(f32x2*)(p + lane * 2) = v; }
    } SEAM(12);
    if (IN(13)) { PH_VARS PH_TID
        for (int un = bid; un < 1024 + 128; un += G) {
            if (un < 1024) { const int gg = un & 3, ch = (un >> 2) & 15, b = un >> 6; spatial_unit(wvs, args, lds, b * 2048 + ch * 128, 128, gg, ch == 15 ? out + OUT_GV_P + (size_t)b * 128 * 512 : nullptr); }
            else { const int i = un - 1024, gg = i & 3, b = i >> 2; spatial_unit(wvs, args, lds, MP + b * 32, 32, gg, out + OUT_GV_S + (size_t)b * 32 * 512); }
        }
        const int gw = bid * 8 + wave, NGW = G * 8;
        for (int rep_ = 0; rep_ < (REP_PH == 13 ? 2 : 1); ++rep_) {
        if ((G & 7) == 0) { const int x = bid & 7, y = bid >> 3, PW = G >> 3;
            for (int slot = y; slot < 64; slot += PW) { const int combo = x * 16 + (slot >> 2), qbl = slot & 3, b = combo >> 3, head = combo & 7;
                attn_unit2(wvs, ws, lds, b, head, qbl); attn_unit2(wvs, ws, lds, b, head, 7 - qbl); } }
        else { for (int pu = bid; pu < 512; pu += G) { const int qbl = pu & 3, head = (pu >> 2) & 7, b = pu >> 5; attn_unit2(wvs, ws, lds, b, head, qbl); attn_unit2(wvs, ws, lds, b, head, 7 - qbl); } }
        for (int r3 = 0; r3 < (REP_PH == 14 ? 2 : 1); ++r3) for (int t = bid; t < 256; t += G) attn_sample(wvs, ws, lds, t >> 3, t & 7);
        }
    } SEAM(13);
    MIX_OUT(14, W_CDO)
    FFN_UP(15, 3)
    FFN_DN(16, 3, Y, Y + (size_t)MP * D)
}

extern "C" void kernel_launch(void* const* d_in, const int* in_sizes, int n_in, void* d_out, int out_size, void* d_ws, size_t ws_size, hipStream_t stream) {
    static int grid = 0;
    if (grid == 0) {
        if (n_in != 41 || (size_t)out_size != OUT_TOTAL || ws_size < WS_END) { fprintf(stderr, "kernel_launch: unexpected shapes: n_in %d out %d ws %zu (need %zu)\n", n_in, out_size, ws_size, (size_t)WS_END); grid = -1; return; }
        int dev = 0, cus = 0, per_cu = 0;
        hipGetDevice(&dev); hipDeviceGetAttribute(&cus, hipDeviceAttributeMultiprocessorCount, dev);
        hipFuncSetAttribute((const void*)mk_fwd, hipFuncAttributeMaxDynamicSharedMemorySize, LDS_BYTES);
        hipOccupancyMaxActiveBlocksPerMultiprocessor(&per_cu, (const void*)mk_fwd, 512, LDS_BYTES);
        if (per_cu < 1) { fprintf(stderr, "kernel_launch: occupancy query says %d blocks per CU\n", per_cu); per_cu = 1; }
        (void)hipGetLastError();
        grid = cus * 1;
    }
    if (grid < 0) return;
    Args a{};
    for (int i = 0; i < 41; ++i) a.in[i] = (const float*)d_in[i];
    a.out = (float*)d_out; a.ws = (unsigned char*)d_ws;
#if MK_PER_PHASE
    for (int ph = 0; ph < NPH; ++ph) { a.ph_lo = ph; a.ph_hi = ph + 1; hipLaunchKernelGGL(mk_fwd, dim3(grid), dim3(512), LDS_BYTES, stream, a); }
#else
    a.ph_lo = 0; a.ph_hi = NPH;
    hipMemsetAsync((unsigned char*)d_ws + A_CTL, 0, 16384, stream);
    void* kargs[] = {&a};
    hipError_t e = hipLaunchCooperativeKernel((const void*)mk_fwd, dim3(grid), dim3(512), kargs, LDS_BYTES, stream);
    if (e != hipSuccess) fprintf(stderr, "kernel_launch: cooperative launch failed: %s (grid %d)\n", hipGetErrorString(e), grid);
#endif
}
```

```cpp
#include <hip/hip_runtime.h>
#include <hip/hip_cooperative_groups.h>
#include <cstdio>
#include <cstdint>
namespace cg = cooperative_groups;
namespace pg8 {
#define PG8_LAS __attribute__((address_space(3)))
typedef unsigned short bf16_t;
typedef short bf16x8 __attribute__((ext_vector_type(8)));
typedef float f32x4 __attribute__((ext_vector_type(4)));
typedef unsigned u32x4 __attribute__((ext_vector_type(4)));
constexpr int BM = 256, BK = 64, HALF = 128, HTB = HALF * BK * 2  , STAGE_BYTES = 8 * HTB, NXCD = 8, WGM = 8;

__host__ __device__ __forceinline__ int lds_byte(int r, int c) { const int st = (r >> 4) * 2 + (c >> 5), rr = r & 15, cc = c & 31, ob = rr * 64 + cc * 2; return st * 1024 + (ob ^ (((ob >> 9) & 1) << 5)); }
__host__ __device__ __forceinline__ void stage_rc(int b, int& R, int& C) { const int st = b / 1024, sb = b % 1024, swz = sb ^ (((sb >> 9) & 1) << 5); R = (st >> 1) * 16 + swz / 64; C = (st & 1) * 32 + (swz % 64) / 2; }
__host__ __device__ __forceinline__ int perm32(int rho) { const int n = rho >> 4, i = rho & 15; return 8 * (i >> 2) + 4 * n + (i & 3); }

struct Unit { int pm, pn; };
struct Gemm { const bf16_t* A; const bf16_t* Bt; int M, N, K; int Kl = 0; };

struct StaticOrder {
    int nM, nN, nwg, G, c;
    __host__ __device__ void init(int M, int N, int G_, int c_) { nM = M / BM; nN = N / BM; nwg = nM * nN; G = G_; c = c_; }
    __host__ __device__ bool next(int i, Unit& u) const {
        const long L = (long)i * G + c; if (L >= nwg) return false;
        int wgid = (int)L; { const int q = nwg / NXCD, r = nwg % NXCD, xcd = wgid % NXCD, off = wgid / NXCD; wgid = (xcd < r ? xcd * (q + 1) : r * (q + 1) + (xcd - r) * q) + off; }
        const int nig = WGM * nN, gid = wgid / nig, fm = gid * WGM, gsz = (nM - fm) < WGM ? (nM - fm) : WGM;
        u.pm = fm + ((wgid % nig) % gsz); u.pn = (wgid % nig) / gsz; return true;
    }
    __device__ __forceinline__ void a_ready(const Unit&) const {}
    __device__ __forceinline__ void done(const Unit&) const {}
};

typedef __bf16 bf16x2_cv __attribute__((ext_vector_type(2))); typedef float f32x2_cv __attribute__((ext_vector_type(2)));
__device__ __forceinline__ unsigned cvt_pk_bf16(float lo, float hi) { const f32x2_cv v = {lo, hi}; const bf16x2_cv b = __builtin_convertvector(v, bf16x2_cv); return __builtin_bit_cast(unsigned, b); }

template <class Epi, class Sched, bool ALIGN_EPI = false, bool SP2 = false>
__device__ __forceinline__ void gemm_phase(PG8_LAS unsigned char* lds, const Gemm g, const Sched& S, const Epi& E, const int wvs) {
    int tid_; asm volatile("v_mbcnt_lo_u32_b32 %0, -1, 0\n\tv_mbcnt_hi_u32_b32 %0, -1, %0" : "=v"(tid_)); tid_ += wvs * 64;
    const int tid = tid_, wid = __builtin_amdgcn_readfirstlane(tid >> 6), lane = tid & 63, wr = wid >> 2, wc = wid & 3, fr = lane & 15, fq = lane >> 4;
    const int K = g.K, nt = (g.Kl ? g.Kl : K) / BK;
    unsigned voffA[2], voffB[2];
#pragma unroll
    for (int i = 0; i < 2; ++i) { int R, C; stage_rc(tid * 16 + i * 8192, R, C); const int Rb = Epi::PERM ? ((R & ~31) + perm32(R & 31)) : R;
        voffA[i] = (unsigned)(R * K + C) * 2u; voffB[i] = (unsigned)(Rb * K + C) * 2u; }
    const size_t kstep = (size_t)(BK * 2);
    const size_t hstep = (size_t)HALF * K * 2;
    const size_t tstep = 2 * hstep;
    const unsigned ldsw = (unsigned)wid * 1024u;
    const int aoff = lds_byte(wr * 64 + fr, fq * 8), boff = lds_byte(wc * 32 + fr, fq * 8);
#define PG8_SA(b, h) (((b) * 2 + (h)) * HTB)
#define PG8_SB(b, h) ((4 + (b) * 2 + (h)) * HTB)
#define PG8_STAGE(bufoff, gbase, voff) do { _Pragma("unroll") for (int _i = 0; _i < 2; ++_i) \
        __builtin_amdgcn_global_load_lds((const unsigned*)((const char*)(gbase) + (voff)[_i]), (PG8_LAS unsigned*)(lds + (bufoff) + ldsw + _i * 8192), 16, 0, 0); } while (0)
#define PG8_LDA(dst, b, h) do { _Pragma("unroll") for (int m = 0; m < 4; ++m) _Pragma("unroll") for (int k = 0; k < 2; ++k) dst[m][k] = *(const PG8_LAS bf16x8*)(lds + PG8_SA(b, h) + aoff + m * 2048 + k * 1024); } while (0)
#define PG8_LDB(dst, b, h) do { _Pragma("unroll") for (int n = 0; n < 2; ++n) _Pragma("unroll") for (int k = 0; k < 2; ++k) dst[n][k] = *(const PG8_LAS bf16x8*)(lds + PG8_SB(b, h) + boff + n * 2048 + k * 1024); } while (0)
#define PG8_MMA(ai, bj, At, Bt) do { __builtin_amdgcn_s_setprio(1); _Pragma("unroll") for (int m = 0; m < 4; ++m) _Pragma("unroll") for (int n = 0; n < 2; ++n) _Pragma("unroll") for (int k = 0; k < 2; ++k) \
        acc[ai][bj][m][n] = __builtin_amdgcn_mfma_f32_16x16x32_bf16(Bt[n][k], At[m][k], acc[ai][bj][m][n], 0, 0, 0); __builtin_amdgcn_s_setprio(0); } while (0)
#define PG8_WAIT_V(n) asm volatile("s_waitcnt vmcnt(" #n ")" ::: "memory")
#define PG8_WAIT_L(n) asm volatile("s_waitcnt lgkmcnt(" #n ")" ::: "memory")
#define PG8_BAR __builtin_amdgcn_s_barrier()
#define PG8_SCHED __builtin_amdgcn_sched_barrier(0)
    Unit cur, nxt; int ui = 0;
    if (!S.next(0, cur)) return;
    f32x4 acc[2][2][4][2];
#pragma unroll
    for (int a = 0; a < 2; ++a)
#pragma unroll
        for (int b = 0; b < 2; ++b)
#pragma unroll
            for (int m = 0; m < 4; ++m)
#pragma unroll
                for (int n = 0; n < 2; ++n) acc[a][b][m][n] = (f32x4){0.f, 0.f, 0.f, 0.f};
    bf16x8 At[4][2], B0[2][2], B1[2][2];
    const char* cA = (const char*)g.A + (size_t)cur.pm * tstep; const char* cB = (const char*)g.Bt + (size_t)cur.pn * tstep;
    S.a_ready(cur);
    if constexpr (SP2) {
        PG8_STAGE(PG8_SB(0, 0), cB, voffB); PG8_STAGE(PG8_SB(0, 1), cB + hstep, voffB); PG8_STAGE(PG8_SA(0, 0), cA, voffA); PG8_STAGE(PG8_SA(0, 1), cA + hstep, voffA);
        if (wr == 1) PG8_BAR;
        PG8_WAIT_V(2); PG8_BAR;
        PG8_STAGE(PG8_SB(1, 0), cB + kstep, voffB); PG8_STAGE(PG8_SA(1, 0), cA + kstep, voffA); PG8_STAGE(PG8_SB(1, 1), cB + hstep + kstep, voffB);
        PG8_WAIT_V(6); PG8_BAR;
    } else {
        PG8_STAGE(PG8_SB(0, 0), cB, voffB); PG8_STAGE(PG8_SA(0, 0), cA, voffA); PG8_STAGE(PG8_SB(0, 1), cB + hstep, voffB); PG8_STAGE(PG8_SA(0, 1), cA + hstep, voffA);
        if (wr == 1) PG8_BAR;
        PG8_WAIT_V(4); PG8_BAR;
        PG8_STAGE(PG8_SB(1, 0), cB + kstep, voffB); PG8_STAGE(PG8_SA(1, 0), cA + kstep, voffA); PG8_STAGE(PG8_SB(1, 1), cB + hstep + kstep, voffB);
        PG8_WAIT_V(6); PG8_BAR;
    }
    for (;;) {
        const bool has_next = S.next(ui + 1, nxt);
        const char* nA = has_next ? (const char*)g.A + (size_t)nxt.pm * tstep : cA; const char* nB = has_next ? (const char*)g.Bt + (size_t)nxt.pn * tstep : cB;
        for (int t = 0; t < nt; t += 2) {
            const bool last = (t == nt - 2);
            const char* a1 = cA + (size_t)(t + 1) * kstep;
            const char* a2 = last ? nA : cA + (size_t)(t + 2) * kstep; const char* b2 = last ? nB : cB + (size_t)(t + 2) * kstep;
            const char* a3 = a2 + kstep; const char* b3 = b2 + kstep;
            if (last && has_next) S.a_ready(nxt);
            if constexpr (SP2) {
            PG8_LDB(B0, 0, 0); PG8_LDB(B1, 0, 1); PG8_SCHED; PG8_LDA(At, 0, 0); PG8_STAGE(PG8_SA(1, 1), a1 + hstep, voffA);
            PG8_WAIT_V(8); PG8_WAIT_L(0); PG8_BAR; PG8_MMA(0, 0, At, B0); PG8_MMA(0, 1, At, B1); PG8_BAR; PG8_SCHED;
            PG8_LDA(At, 0, 1); PG8_STAGE(PG8_SB(0, 0), b2, voffB); PG8_STAGE(PG8_SB(0, 1), b2 + hstep, voffB); PG8_STAGE(PG8_SA(0, 0), a2, voffA);
            PG8_WAIT_V(8); PG8_WAIT_L(0); PG8_BAR; PG8_MMA(1, 0, At, B0); PG8_MMA(1, 1, At, B1); PG8_BAR; PG8_SCHED;
            PG8_LDB(B0, 1, 0); PG8_LDB(B1, 1, 1); PG8_SCHED; PG8_LDA(At, 1, 0); PG8_STAGE(PG8_SA(0, 1), a2 + hstep, voffA);
            PG8_WAIT_V(8); PG8_WAIT_L(0); PG8_BAR; PG8_MMA(0, 0, At, B0); PG8_MMA(0, 1, At, B1); PG8_BAR; PG8_SCHED;
            PG8_LDA(At, 1, 1); PG8_STAGE(PG8_SB(1, 0), b3, voffB); PG8_STAGE(PG8_SB(1, 1), b3 + hstep, voffB); PG8_STAGE(PG8_SA(1, 0), a3, voffA);
            PG8_WAIT_V(8); PG8_WAIT_L(0); PG8_BAR; PG8_MMA(1, 0, At, B0); PG8_MMA(1, 1, At, B1); PG8_BAR; PG8_SCHED;
            } else {
            PG8_LDB(B0, 0, 0); PG8_SCHED; PG8_LDA(At, 0, 0); PG8_STAGE(PG8_SA(1, 1), a1 + hstep, voffA);
            PG8_WAIT_L(8); PG8_BAR; PG8_WAIT_L(0); PG8_MMA(0, 0, At, B0); PG8_BAR; PG8_SCHED;
            PG8_LDB(B1, 0, 1); PG8_STAGE(PG8_SB(0, 0), b2, voffB);
            PG8_BAR; PG8_WAIT_L(0); PG8_MMA(0, 1, At, B1); PG8_BAR;
            PG8_LDA(At, 0, 1); PG8_STAGE(PG8_SA(0, 0), a2, voffA);
            PG8_BAR; PG8_WAIT_L(0); PG8_MMA(1, 0, At, B0); PG8_BAR; PG8_SCHED;
            PG8_STAGE(PG8_SB(0, 1), b2 + hstep, voffB);
            PG8_WAIT_V(6); PG8_BAR; PG8_MMA(1, 1, At, B1); PG8_BAR;
            PG8_LDB(B0, 1, 0); PG8_SCHED; PG8_LDA(At, 1, 0); PG8_STAGE(PG8_SA(0, 1), a2 + hstep, voffA);
            PG8_WAIT_L(8); PG8_BAR; PG8_WAIT_L(0); PG8_MMA(0, 0, At, B0); PG8_BAR; PG8_SCHED;
            PG8_LDB(B1, 1, 1); PG8_STAGE(PG8_SB(1, 0), b3, voffB);
            PG8_BAR; PG8_WAIT_L(0); PG8_MMA(0, 1, At, B1); PG8_BAR;
            PG8_LDA(At, 1, 1); PG8_STAGE(PG8_SA(1, 0), a3, voffA);
            PG8_BAR; PG8_WAIT_L(0); PG8_MMA(1, 0, At, B0); PG8_BAR; PG8_SCHED;
            PG8_STAGE(PG8_SB(1, 1), b3 + hstep, voffB);
            PG8_WAIT_V(6); PG8_BAR; PG8_MMA(1, 1, At, B1); PG8_BAR;
            }
        }
        if constexpr (ALIGN_EPI) { if (wr == 0) PG8_BAR; }
        if constexpr (!Epi::AFTER_DRAIN) { E(acc, cur, wr, wc, fr, fq); S.done(cur); }
        if (!has_next) break;
#pragma unroll
        for (int a = 0; a < 2; ++a)
#pragma unroll
            for (int b = 0; b < 2; ++b)
#pragma unroll
                for (int m = 0; m < 4; ++m)
#pragma unroll
                    for (int n = 0; n < 2; ++n) acc[a][b][m][n] = (f32x4){0.f, 0.f, 0.f, 0.f};
        cur = nxt; cA = nA; cB = nB; ++ui;
        if constexpr (ALIGN_EPI) { if (wr == 1) PG8_BAR; }
    }
    PG8_WAIT_V(0);
    if constexpr (!ALIGN_EPI) { if (wr == 0) PG8_BAR; }
    PG8_BAR;
    if constexpr (Epi::AFTER_DRAIN) { E.fused(acc, cur, wr, wc, fr, fq, lds, wid, lane); S.done(cur); }
#undef PG8_SA
#undef PG8_SB
#undef PG8_STAGE
#undef PG8_LDA
#undef PG8_LDB
#undef PG8_MMA
#undef PG8_WAIT_V
#undef PG8_WAIT_L
#undef PG8_BAR
#undef PG8_SCHED
}
}

#ifndef REP_PH
#define REP_PH -1
#endif
#ifndef MK_PER_PHASE
#define MK_PER_PHASE 0
#endif
#define LAS __attribute__((address_space(3)))
using pg8::bf16_t; using pg8::bf16x8; using pg8::f32x4; using pg8::Unit; using pg8::cvt_pk_bf16;
typedef unsigned u32x2 __attribute__((ext_vector_type(2)));
typedef unsigned u32x4 __attribute__((ext_vector_type(4)));
typedef float f32x2 __attribute__((ext_vector_type(2)));

constexpr int MP = 32768, MS = 1024, M = MP + MS, D = 1024, FF = 2816;
constexpr int KVR = 32768 + 32 * 1056;
constexpr float EPS = 1e-6f;
constexpr int NPH = 17;

constexpr size_t OUT_Y = 0;
constexpr size_t OUT_HGRN_P = 34603008, OUT_HGRN_S = OUT_HGRN_P + 1048576;
constexpr size_t OUT_S5RE_P = OUT_HGRN_S + 2097152, OUT_S5IM_P = OUT_S5RE_P + 32768;
constexpr size_t OUT_S5RE_S = OUT_S5IM_P + 32768, OUT_S5IM_S = OUT_S5RE_S + 65536;
constexpr size_t OUT_GV_P = OUT_S5IM_S + 65536, OUT_GV_S = OUT_GV_P + 1048576;
constexpr size_t OUT_CKV_P = OUT_GV_S + 524288, OUT_KPE_P = OUT_CKV_P + 4194304;
constexpr size_t OUT_CKV_S = OUT_KPE_P + 1048576, OUT_KPE_S = OUT_CKV_S + 131072;
constexpr size_t OUT_TOTAL = OUT_KPE_S + 32768;

constexpr size_t al256(size_t x) { return (x + 255) & ~(size_t)255; }
constexpr size_t SZ_GU = (size_t)5632 * 1024 * 2, SZ_DN = (size_t)1024 * 2816 * 2;
constexpr size_t W_GU0 = 0;
constexpr size_t W_DN0 = W_GU0 + 4 * SZ_GU;
constexpr size_t W_AB = W_DN0 + 4 * SZ_DN;
constexpr size_t W_ABO = W_AB + (size_t)2560 * 1024 * 2;
constexpr size_t W_GLU = W_ABO + (size_t)1024 * 1024 * 2;
constexpr size_t W_CD = W_GLU + (size_t)512 * 512 * 2;
constexpr size_t W_CDO = W_CD + (size_t)1536 * 1024 * 2;
constexpr size_t W_UQ = W_CDO + (size_t)1024 * 1024 * 2;
constexpr size_t W_UKV = W_UQ + (size_t)768 * 256 * 2;
constexpr size_t T_LAMBAR = W_UKV + (size_t)1024 * 128 * 2;
constexpr size_t T_BBT = T_LAMBAR + 2048 * 8;
constexpr size_t T_CCT = T_BBT + 65536 * 2;
constexpr size_t T_ROPE = T_CCT + 65536 * 2;
constexpr size_t T_LB = T_ROPE + 32768 * 8;
constexpr size_t T_WS = T_LB + 2048;
constexpr size_t A_XB = T_WS + 65536 * 2;
constexpr size_t A_SSQ = A_XB + (size_t)M * 1024 * 2;
constexpr size_t A_SSV = A_SSQ + (size_t)M * 16 * 4;
constexpr size_t A_SSCQ = A_SSV + (size_t)M * 8 * 4;
constexpr size_t A_SSCKV = A_SSCQ + (size_t)M * 4 * 4;
constexpr size_t A_SSQN = A_SSCKV + (size_t)M * 4 * 4;
constexpr size_t A_SSQR = A_SSQN + (size_t)M * 8 * 4;
constexpr size_t A_SSK = A_SSQR + (size_t)M * 8 * 4;
constexpr size_t A_CTL = al256(A_SSK + (size_t)KVR * 4);
constexpr size_t R0 = A_CTL + 16384;
constexpr size_t SZ_H = (size_t)M * 512 * 2;
constexpr size_t R_ACT = R0;
constexpr size_t R_MIX = R0;
constexpr size_t R_QT = R_MIX + 2 * SZ_H, R_KH = R_QT + SZ_H, R_KTT = R_KH + SZ_H, R_VTT = R_KTT + SZ_H;
constexpr size_t R_GB = R_VTT + SZ_H, R_UB = R_GB + SZ_H, R_OB = R_UB + SZ_H, R_ZB = R_OB + SZ_H;
constexpr size_t R_LDEC = R_ZB + SZ_H;
constexpr size_t R_END0 = R_LDEC + (size_t)(M / 16) * 512 * 4;
constexpr size_t R_VG = R_MIX + 2 * SZ_H;
constexpr size_t R_CQB = R_VG + SZ_H;
constexpr size_t R_CKVG = R_CQB + (size_t)M * 256 * 2;
constexpr size_t R_KPEB = R_CKVG + (size_t)KVR * 128 * 2;
constexpr size_t R_QF = R_KPEB + (size_t)KVR * 32 * 4;
constexpr size_t R_KF = R_QF + (size_t)M * 768 * 2;
constexpr size_t R_VT = R_KF + (size_t)KVR * 768 * 2;
constexpr size_t R_END1 = R_VT + (size_t)KVR * 512 * 2;
constexpr size_t R_PART = al256(R_ACT + (size_t)M * FF * 2);
constexpr size_t R_ENDA = R_PART + (size_t)176 * 65536 * 4;
constexpr size_t WS_END = (R_END1 > R_END0 ? (R_END1 > R_ENDA ? R_END1 : R_ENDA) : (R_END0 > R_ENDA ? R_END0 : R_ENDA));
static_assert(WS_END <= (size_t)536870912, "workspace map exceeds 512 MiB");

constexpr int LDS_BYTES = 147456;

template <class T> __device__ __forceinline__ T* gp(T* p) { return p; }
__device__ __forceinline__ float sum4(f32x4 a) { return (a.x + a.y) + (a.z + a.w); }
__device__ __forceinline__ float bf2f(unsigned short h) { return __uint_as_float((unsigned)h << 16); }
__device__ __forceinline__ void st_bf4(bf16_t* p, f32x4 v) { u32x2 w; w.x = cvt_pk_bf16(v.x, v.y); w.y = cvt_pk_bf16(v.z, v.w); *(u32x2*)p = w; }
__device__ __forceinline__ unsigned short bf1(float v) { return (unsigned short)(cvt_pk_bf16(v, 0.f) & 0xffffu); }
__device__ __forceinline__ float sigmoidf_(float x) { return __builtin_amdgcn_rcpf(1.f + __expf(-x)); }
__device__ __forceinline__ float gelu_tanh(float x) { const float y = 1.5957691216057308f * (x + 0.044715f * x * x * x); return x * __builtin_amdgcn_rcpf(1.f + __expf(-y)); }
__device__ __forceinline__ float rstd16(const float* ssq, int row) { const f32x4* p = (const f32x4*)(ssq + (size_t)row * 16); return rsqrtf((sum4(p[0]) + sum4(p[1]) + sum4(p[2]) + sum4(p[3])) * (1.f / 1024.f) + EPS); }
__device__ __forceinline__ int kvrow_of(int row) { return row < MP ? row : MP + ((row - MP) >> 5) * 1056 + 1024 + ((row - MP) & 31); }
__device__ __forceinline__ int pos_of(int row) { return row < MP ? (row & 2047) : 1024 + ((row - MP) & 31); }
__device__ __forceinline__ bf16x8 mk8(u32x2 a, u32x2 b) { u32x4 w; w.x = a.x; w.y = a.y; w.z = b.x; w.w = b.y; return __builtin_bit_cast(bf16x8, w); }
__device__ __forceinline__ f32x4 mfma16(bf16x8 a, bf16x8 b, f32x4 c) { return __builtin_amdgcn_mfma_f32_16x16x32_bf16(a, b, c, 0, 0, 0); }
#define LDSWAIT() asm volatile("s_waitcnt lgkmcnt(0)" ::: "memory")

#define EPI_ROWS_BEGIN _Pragma("unroll") for (int ai = 0; ai < 2; ++ai) _Pragma("unroll") for (int m = 0; m < 4; ++m) { const int row = u.pm * 256 + ai * 128 + wr * 64 + m * 16 + fr;
#define EPI_ROWS_END }

struct EpiGU {
    static constexpr bool PERM = true, AFTER_DRAIN = false;
    const float* ssq; bf16_t* act;
    __device__ __forceinline__ void operator()(const f32x4 (&acc)[2][2][4][2], const Unit& u, int wr, int wc, int fr, int fq) const {
        asm volatile("" : "+v"(fr), "+v"(fq));
        EPI_ROWS_BEGIN
            const float rs = rstd16(ssq, row); f32x4 a[2];
#pragma unroll
            for (int n = 0; n < 2; ++n) { const f32x4 g = acc[ai][0][m][n] * rs, up = acc[ai][1][m][n] * rs;
                a[n].x = g.x * sigmoidf_(g.x) * up.x; a[n].y = g.y * sigmoidf_(g.y) * up.y; a[n].z = g.z * sigmoidf_(g.z) * up.z; a[n].w = g.w * sigmoidf_(g.w) * up.w; }
            u32x4 w4; w4.x = cvt_pk_bf16(a[0].x, a[0].y); w4.y = cvt_pk_bf16(a[0].z, a[0].w); w4.z = cvt_pk_bf16(a[1].x, a[1].y); w4.w = cvt_pk_bf16(a[1].z, a[1].w);
            *(u32x4*)(act + (size_t)row * FF + u.pn * 128 + wc * 32 + 8 * fq) = w4;
        EPI_ROWS_END
    }
};
struct EpiRes {
    static constexpr bool PERM = false, AFTER_DRAIN = false;
    const float* xin0; const float* xin1; float* xout; bf16_t* xb; float* ssq; float scale;
    __device__ __forceinline__ void do_row(int row, int pn, int wc, int fq, const f32x4& a00, const f32x4& a01, const f32x4& a10, const f32x4& a11) const {
        const float* src = row < MP ? xin0 + (size_t)row * D : xin1 + (size_t)(row - MP) * D; float ss = 0.f;
#pragma unroll
        for (int bj = 0; bj < 2; ++bj)
#pragma unroll
            for (int n = 0; n < 2; ++n) { const int col = pn * 256 + bj * 128 + wc * 32 + n * 16 + fq * 4;
                const f32x4 o = *(const f32x4*)(src + col) + (bj ? (n ? a11 : a10) : (n ? a01 : a00)) * scale;
                *(f32x4*)(xout + (size_t)row * D + col) = o; st_bf4(xb + (size_t)row * D + col, o); ss += sum4(o * o); }
        ss += __shfl_xor(ss, 16); ss += __shfl_xor(ss, 32);
        if (fq == 0) ssq[(size_t)row * 16 + pn * 4 + wc] = ss;
    }
    __device__ __forceinline__ void operator()(const f32x4 (&acc)[2][2][4][2], const Unit& u, int wr, int wc, int fr, int fq) const {
        asm volatile("" : "+v"(fr), "+v"(fq));
        EPI_ROWS_BEGIN
            do_row(row, u.pn, wc, fq, acc[ai][0][m][0], acc[ai][0][m][1], acc[ai][1][m][0], acc[ai][1][m][1]);
        EPI_ROWS_END
    }
};
struct EpiAB {
    static constexpr bool PERM = false, AFTER_DRAIN = false;
    const float* ssq; const float* lb; bf16_t* QT; bf16_t* KH; bf16_t* KTT; bf16_t* VTT; bf16_t* GB; bf16_t* UB; float* LDEC;
    __device__ __forceinline__ void operator()(const f32x4 (&acc)[2][2][4][2], const Unit& u, int wr, int wc, int fr, int fq) const {
        asm volatile("" : "+v"(fr), "+v"(fq));
        if (u.pn < 4) {
            const int h = u.pn;
            EPI_ROWS_BEGIN
                const float rs = rstd16(ssq, row); const int blk = row >> 4;
#pragma unroll
                for (int n = 0; n < 2; ++n) { const int cl = h * 128 + wc * 32 + n * 16 + fq * 4; const f32x4 lbv = *(const f32x4*)(lb + cl);
                    f32x4 qt, kh, dec; float kt[4];
#pragma unroll
                    for (int j = 0; j < 4; ++j) { const float q = acc[ai][0][m][n][j] * rs, fz = acc[ai][1][m][n][j] * rs;
                        const float f = lbv[j] + (1.f - lbv[j]) * sigmoidf_(fz); float b = __logf(f);
#pragma unroll
                        for (int d = 1; d < 16; d <<= 1) { const float t = __shfl_up(b, d, 16); if (fr >= d) b += t; }
                        const float bend = __shfl(b, 15, 16); const float kk = 1.f - f;
                        qt[j] = q * __expf(b); kh[j] = kk * __expf(-b); kt[j] = kk * __expf(bend - b); dec[j] = __expf(bend); }
                    st_bf4(QT + (size_t)row * 512 + cl, qt); st_bf4(KH + (size_t)row * 512 + cl, kh);
#pragma unroll
                    for (int j = 0; j < 4; ++j) KTT[(size_t)blk * 8192 + (cl + j) * 16 + fr] = bf1(kt[j]);
                    if (fr == 15) *(f32x4*)(LDEC + (size_t)blk * 512 + cl) = dec; }
            EPI_ROWS_END
        } else if (u.pn < 6) {
            EPI_ROWS_BEGIN
                const float rs = rstd16(ssq, row); const int blk = row >> 4;
#pragma unroll
                for (int bj = 0; bj < 2; ++bj)
#pragma unroll
                    for (int n = 0; n < 2; ++n) { const int cl = (u.pn - 4) * 256 + bj * 128 + wc * 32 + n * 16 + fq * 4;
#pragma unroll
                        for (int j = 0; j < 4; ++j) VTT[(size_t)blk * 8192 + (cl + j) * 16 + fr] = bf1(acc[ai][bj][m][n][j] * rs); }
            EPI_ROWS_END
        } else if (u.pn < 8) {
            EPI_ROWS_BEGIN
                const float rs = rstd16(ssq, row);
#pragma unroll
                for (int bj = 0; bj < 2; ++bj)
#pragma unroll
                    for (int n = 0; n < 2; ++n) { const int cl = (u.pn - 6) * 256 + bj * 128 + wc * 32 + n * 16 + fq * 4; const f32x4 v = acc[ai][bj][m][n] * rs; f32x4 s;
                        s.x = sigmoidf_(v.x); s.y = sigmoidf_(v.y); s.z = sigmoidf_(v.z); s.w = sigmoidf_(v.w); st_bf4(GB + (size_t)row * 512 + cl, s); }
            EPI_ROWS_END
        } else {
            EPI_ROWS_BEGIN
                const float rs = rstd16(ssq, row);
#pragma unroll
                for (int bj = 0; bj < 2; ++bj)
#pragma unroll
                    for (int n = 0; n < 2; ++n) { const int cl = (u.pn - 8) * 256 + bj * 128 + wc * 32 + n * 16 + fq * 4; st_bf4(UB + (size_t)row * 512 + cl, acc[ai][bj][m][n] * rs); }
            EPI_ROWS_END
        }
    }
};
struct EpiGLU {
    static constexpr bool PERM = false, AFTER_DRAIN = false;
    const bf16_t* ZB; const float* bglu; bf16_t* MIX;
    __device__ __forceinline__ void operator()(const f32x4 (&acc)[2][2][4][2], const Unit& u, int wr, int wc, int fr, int fq) const {
        asm volatile("" : "+v"(fr), "+v"(fq));
        EPI_ROWS_BEGIN
#pragma unroll
            for (int bj = 0; bj < 2; ++bj)
#pragma unroll
                for (int n = 0; n < 2; ++n) { const int col = u.pn * 256 + bj * 128 + wc * 32 + n * 16 + fq * 4;
                    const u32x2 zz = *(const u32x2*)(ZB + (size_t)row * 512 + col); const f32x4 bv = *(const f32x4*)(bglu + col); const f32x4 a = acc[ai][bj][m][n] + bv; f32x4 o;
                    o.x = __uint_as_float(zz.x << 16) * sigmoidf_(a.x); o.y = __uint_as_float(zz.x & 0xffff0000u) * sigmoidf_(a.y);
                    o.z = __uint_as_float(zz.y << 16) * sigmoidf_(a.z); o.w = __uint_as_float(zz.y & 0xffff0000u) * sigmoidf_(a.w);
                    st_bf4(MIX + (size_t)row * 1024 + 512 + col, o); }
        EPI_ROWS_END
    }
};
struct EpiCD {
    static constexpr bool PERM = false, AFTER_DRAIN = false;
    const float* ssq; const float* vnorm; const float* kvnorm; const f32x2* rope; bf16_t* MIX; bf16_t* VG; float* SSV; bf16_t* CQB; float* SSCQ; bf16_t* CKVG; float* SSCKV; float* KPEB; float* SSK; float* out;
    __device__ __forceinline__ void operator()(const f32x4 (&acc)[2][2][4][2], const Unit& u, int wr, int wc, int fr, int fq) const {
        asm volatile("" : "+v"(fr), "+v"(fq));
        if (u.pn < 2) {
            EPI_ROWS_BEGIN
                const float rs = rstd16(ssq, row);
#pragma unroll
                for (int bj = 0; bj < 2; ++bj)
#pragma unroll
                    for (int n = 0; n < 2; ++n) { const int cl = u.pn * 256 + bj * 128 + wc * 32 + n * 16 + fq * 4; const f32x4 v = acc[ai][bj][m][n] * rs; f32x4 g;
                        g.x = gelu_tanh(v.x); g.y = gelu_tanh(v.y); g.z = gelu_tanh(v.z); g.w = gelu_tanh(v.w); st_bf4(MIX + (size_t)row * 1024 + cl, g); }
            EPI_ROWS_END
        } else if (u.pn < 4) {
            EPI_ROWS_BEGIN
                const float rs = rstd16(ssq, row); float ss = 0.f;
#pragma unroll
                for (int bj = 0; bj < 2; ++bj)
#pragma unroll
                    for (int n = 0; n < 2; ++n) { const int cl = (u.pn - 2) * 256 + bj * 128 + wc * 32 + n * 16 + fq * 4; const f32x4 v = acc[ai][bj][m][n] * rs; f32x4 g;
                        g.x = gelu_tanh(v.x); g.y = gelu_tanh(v.y); g.z = gelu_tanh(v.z); g.w = gelu_tanh(v.w); ss += sum4(g * g);
                        st_bf4(VG + (size_t)row * 512 + cl, g * *(const f32x4*)(vnorm + cl)); }
                ss += __shfl_xor(ss, 16); ss += __shfl_xor(ss, 32);
                if (fq == 0) SSV[(size_t)row * 8 + (u.pn - 2) * 4 + wc] = ss;
            EPI_ROWS_END
        } else if (u.pn == 4) {
            EPI_ROWS_BEGIN
                const float rs = rstd16(ssq, row); float ss = 0.f;
#pragma unroll
                for (int bj = 0; bj < 2; ++bj)
#pragma unroll
                    for (int n = 0; n < 2; ++n) { const int cl = bj * 128 + wc * 32 + n * 16 + fq * 4; const f32x4 v = acc[ai][bj][m][n] * rs; ss += sum4(v * v); st_bf4(CQB + (size_t)row * 256 + cl, v); }
                ss += __shfl_xor(ss, 16); ss += __shfl_xor(ss, 32);
                if (fq == 0) SSCQ[(size_t)row * 4 + wc] = ss;
            EPI_ROWS_END
        } else {
            EPI_ROWS_BEGIN
                const float rs = rstd16(ssq, row); const int kvr = kvrow_of(row); float ss = 0.f;
                float* ock = row < MP ? out + OUT_CKV_P + (size_t)row * 128 : out + OUT_CKV_S + (size_t)(row - MP) * 128;
#pragma unroll
                for (int n = 0; n < 2; ++n) { const int cl = wc * 32 + n * 16 + fq * 4; const f32x4 v = acc[ai][0][m][n] * rs; ss += sum4(v * v);
                    const f32x4 g = v * *(const f32x4*)(kvnorm + cl); st_bf4(CKVG + (size_t)kvr * 128 + cl, g); *(f32x4*)(ock + cl) = g; }
                ss += __shfl_xor(ss, 16); ss += __shfl_xor(ss, 32);
                if (fq == 0) SSCKV[(size_t)row * 4 + wc] = ss;
                if (wc == 0) {
                    const int pos = pos_of(row); float* okp = row < MP ? out + OUT_KPE_P + (size_t)row * 32 : out + OUT_KPE_S + (size_t)(row - MP) * 32;
                    const f32x4 x1 = acc[ai][1][m][0] * rs, x2 = acc[ai][1][m][1] * rs; f32x4 o1, o2; float s2 = 0.f;
#pragma unroll
                    for (int j = 0; j < 4; ++j) { const f32x2 cs = rope[pos * 16 + fq * 4 + j]; o1[j] = x1[j] * cs.x - x2[j] * cs.y; o2[j] = x1[j] * cs.y + x2[j] * cs.x; }
                    s2 = sum4(o1 * o1) + sum4(o2 * o2); s2 += __shfl_xor(s2, 16); s2 += __shfl_xor(s2, 32);
                    *(f32x4*)(okp + fq * 4) = o1; *(f32x4*)(okp + 16 + fq * 4) = o2;
                    *(f32x4*)(KPEB + (size_t)kvr * 32 + fq * 4) = o1; *(f32x4*)(KPEB + (size_t)kvr * 32 + 16 + fq * 4) = o2;
                    if (fq == 0) SSK[kvr] = s2;
                }
            EPI_ROWS_END
        }
    }
};
struct EpiQ {
    static constexpr bool PERM = false, AFTER_DRAIN = false;
    const float* SSCQ; const float* qgain; const f32x2* rope; bf16_t* QF; float* SSQN; float* SSQR;
    __device__ __forceinline__ void operator()(const f32x4 (&acc)[2][2][4][2], const Unit& u, int wr, int wc, int fr, int fq) const {
        asm volatile("" : "+v"(fr), "+v"(fq));
        if (u.pn < 2) {
            const int head = u.pn * 4 + wc;
            EPI_ROWS_BEGIN
                const float rs = rsqrtf(sum4(*(const f32x4*)(SSCQ + (size_t)row * 4)) * (1.f / 256.f) + EPS); float ss = 0.f;
#pragma unroll
                for (int bj = 0; bj < 2; ++bj)
#pragma unroll
                    for (int n = 0; n < 2; ++n) { const int d = bj * 32 + n * 16 + fq * 4; const f32x4 v = acc[ai][bj][m][n] * rs; ss += sum4(v * v);
                        st_bf4(QF + (size_t)row * 768 + head * 96 + d, v * *(const f32x4*)(qgain + d)); }
                ss += __shfl_xor(ss, 16); ss += __shfl_xor(ss, 32);
                if (fq == 0) SSQN[(size_t)row * 8 + head] = ss;
            EPI_ROWS_END
        } else {
            EPI_ROWS_BEGIN
                const float rs = rsqrtf(sum4(*(const f32x4*)(SSCQ + (size_t)row * 4)) * (1.f / 256.f) + EPS); const int pos = pos_of(row);
#pragma unroll
                for (int bj = 0; bj < 2; ++bj) { const int head = 2 * wc + bj; const f32x4 x1 = acc[ai][bj][m][0] * rs, x2 = acc[ai][bj][m][1] * rs; f32x4 o1, o2;
#pragma unroll
                    for (int j = 0; j < 4; ++j) { const f32x2 cs = rope[pos * 16 + fq * 4 + j]; o1[j] = x1[j] * cs.x - x2[j] * cs.y; o2[j] = x1[j] * cs.y + x2[j] * cs.x; }
                    float ss = sum4(x1 * x1) + sum4(x2 * x2); ss += __shfl_xor(ss, 16); ss += __shfl_xor(ss, 32);
                    st_bf4(QF + (size_t)row * 768 + head * 96 + 64 + fq * 4, o1 * *(const f32x4*)(qgain + 64 + fq * 4));
                    st_bf4(QF + (size_t)row * 768 + head * 96 + 80 + fq * 4, o2 * *(const f32x4*)(qgain + 80 + fq * 4));
                    if (fq == 0) SSQR[(size_t)row * 8 + head] = ss; }
            EPI_ROWS_END
        }
    }
};
struct EpiKV {
    static constexpr bool PERM = false, AFTER_DRAIN = false;
    const float* SSCKV; const float* SSK; const float* KPEB; const float* kgain; bf16_t* KF; bf16_t* VT;
    __device__ __forceinline__ float rstd_kv(int kvr) const {
        int row;
        if (kvr < MP) row = kvr; else { const int rel = kvr - MP, b = rel / 1056, j = rel - b * 1056; if (j < 1024) return 1.f; row = MP + b * 32 + (j - 1024); }
        return rsqrtf(sum4(*(const f32x4*)(SSCKV + (size_t)row * 4)) * (1.f / 128.f) + EPS);
    }
    __device__ __forceinline__ void operator()(const f32x4 (&acc)[2][2][4][2], const Unit& u, int wr, int wc, int fr, int fq) const {
        asm volatile("" : "+v"(fr), "+v"(fq));
        if (u.pn < 2) {
            const int head = u.pn * 4 + wc;
            EPI_ROWS_BEGIN
                const float rs = rstd_kv(row); float ss = 0.f;
#pragma unroll
                for (int bj = 0; bj < 2; ++bj)
#pragma unroll
                    for (int n = 0; n < 2; ++n) { const f32x4 v = acc[ai][bj][m][n] * rs; ss += sum4(v * v); }
                ss += __shfl_xor(ss, 16); ss += __shfl_xor(ss, 32);
                const float rk = rsqrtf((ss + SSK[row]) * (1.f / 96.f) + EPS);
#pragma unroll
                for (int bj = 0; bj < 2; ++bj)
#pragma unroll
                    for (int n = 0; n < 2; ++n) { const int d = bj * 32 + n * 16 + fq * 4; st_bf4(KF + (size_t)row * 768 + head * 96 + d, acc[ai][bj][m][n] * (rs * rk) * *(const f32x4*)(kgain + d)); }
                const f32x4 p0 = *(const f32x4*)(KPEB + (size_t)row * 32 + fq * 8), p1 = *(const f32x4*)(KPEB + (size_t)row * 32 + fq * 8 + 4);
                st_bf4(KF + (size_t)row * 768 + head * 96 + 64 + fq * 8, p0 * rk * *(const f32x4*)(kgain + 64 + fq * 8));
                st_bf4(KF + (size_t)row * 768 + head * 96 + 68 + fq * 8, p1 * rk * *(const f32x4*)(kgain + 68 + fq * 8));
            EPI_ROWS_END
        } else {
            EPI_ROWS_BEGIN
                const float rs = rstd_kv(row); int seq0, key, L;
                if (row < MP) { seq0 = row & ~2047; key = row & 2047; L = 2048; } else { const int rel = row - MP, b = rel / 1056; seq0 = MP + b * 1056; key = rel - b * 1056; L = 1056; }
                bf16_t* base = VT + (size_t)seq0 * 512 + key;
#pragma unroll
                for (int bj = 0; bj < 2; ++bj)
#pragma unroll
                    for (int n = 0; n < 2; ++n) { const int c = (u.pn - 2) * 256 + bj * 128 + wc * 32 + n * 16 + fq * 4;
#pragma unroll
                        for (int j = 0; j < 4; ++j) base[(size_t)(c + j) * L] = bf1(acc[ai][bj][m][n][j] * rs); }
            EPI_ROWS_END
        }
    }
};

struct Args { const float* in[41]; float* out; unsigned char* ws; int ph_lo, ph_hi; };

__device__ __forceinline__ void tr_item(const float* W, int ldw, int col0, const float* gain, bf16_t* WT, int K, int drow0, int k0, LAS float* scr, int lane, bool zero) {
    const int c = lane & 7;
    if (zero) {
#pragma unroll
        for (int j = 0; j < 4; ++j) { const int n = (lane >> 3) + 8 * j; *(u32x4*)(WT + (size_t)(drow0 + n) * K + k0 + 8 * c) = (u32x4){0u, 0u, 0u, 0u}; }
        return;
    }
    float tv[32];
#pragma unroll
    for (int i = 0; i < 32; ++i) { const int kk = 2 * i + (lane >> 5); tv[i] = W[(size_t)(k0 + kk) * ldw + col0 + (lane & 31)]; }
    if (gain) {
#pragma unroll
        for (int i = 0; i < 32; ++i) tv[i] *= gain[k0 + 2 * i + (lane >> 5)]; }
#pragma unroll
    for (int i = 0; i < 32; ++i) scr[(2 * i + (lane >> 5)) * 33 + (lane & 31)] = tv[i];
    LDSWAIT();
#pragma unroll
    for (int j = 0; j < 4; ++j) { const int n = (lane >> 3) + 8 * j; const LAS float* s = scr + (8 * c) * 33 + n;
        u32x4 o; o.x = cvt_pk_bf16(s[0 * 33], s[1 * 33]); o.y = cvt_pk_bf16(s[2 * 33], s[3 * 33]); o.z = cvt_pk_bf16(s[4 * 33], s[5 * 33]); o.w = cvt_pk_bf16(s[6 * 33], s[7 * 33]);
        *(u32x4*)(WT + (size_t)(drow0 + n) * K + k0 + 8 * c) = o; }
    LDSWAIT();
}
__device__ __forceinline__ void sincos_d(double a, double& s, double& c) {
    const double q = rint(a * 0.6366197723675814); double r = fma(-q, 1.5707963267948966, a); r = fma(-q, 6.123233995736766e-17, r);
    const double r2 = r * r;
    const double sr = r * (1.0 + r2 * (-1.0 / 6 + r2 * (1.0 / 120 + r2 * (-1.0 / 5040 + r2 * (1.0 / 362880 + r2 * (-1.0 / 39916800 + r2 * (1.0 / 6227020800.0 + r2 * (-1.0 / 1307674368000.0))))))));
    const double cr = 1.0 + r2 * (-0.5 + r2 * (1.0 / 24 + r2 * (-1.0 / 720 + r2 * (1.0 / 40320 + r2 * (-1.0 / 3628800 + r2 * (1.0 / 479001600 + r2 * (-1.0 / 87178291200.0 + r2 * (1.0 / 20922789888000.0))))))));
    const int n = ((int)q) & 3;
    s = (n == 0) ? sr : (n == 1) ? cr : (n == 2) ? -sr : -cr;
    c = (n == 0) ? cr : (n == 1) ? -sr : (n == 2) ? -cr : sr;
}
__device__ __forceinline__ double exp_d(double x) {
    const double y = x * 0.0625; double t = 1.0 + y * (1.0 + y * (0.5 + y * (1.0 / 6 + y * (1.0 / 24 + y * (1.0 / 120 + y * (1.0 / 720 + y * (1.0 / 5040 + y * (1.0 / 40320 + y * (1.0 / 362880 + y * (1.0 / 3628800 + y * (1.0 / 39916800 + y * (1.0 / 479001600 + y * (1.0 / 6227020800.0)))))))))))));
    t *= t; t *= t; t *= t; t *= t; return t;
}

constexpr int I_GU = 16 * 176, I_DN = 44 * 32, I_AB = 16 * 80, I_ABO = 16 * 32, I_GLU = 8 * 16, I_CD = 16 * 48, I_CDO = 16 * 32, I_UQ = 4 * 24, I_UKV = 2 * 32;
constexpr int NIT = 4 * I_GU + 4 * I_DN + I_AB + I_ABO + I_GLU + I_CD + I_CDO + I_UQ + I_UKV;
constexpr int I_L0 = I_AB + I_ABO + I_GLU, I_L1 = I_CD + I_CDO + I_UQ + I_UKV, IT_MISC = 4 * I_GU + 4 * I_DN;
constexpr int NIT_A = I_GU + I_DN + I_L0, NIT_B1 = I_GU + I_DN, NIT_B2 = I_GU + I_DN + I_L1, NIT_B3 = I_GU + I_DN;
__device__ __forceinline__ int item_of(int set, int idx) {
    if (idx < I_GU) return set * I_GU + idx; idx -= I_GU;
    if (idx < I_DN) return 4 * I_GU + set * I_DN + idx; idx -= I_DN;
    return set == 0 ? IT_MISC + idx : IT_MISC + I_L0 + idx;
}
__device__ __forceinline__ void weight_item(const Args& a, unsigned char* ws, int it, LAS float* scr, int lane) {
        int r = it;
        if (r < 4 * I_GU) { const int w = r / I_GU; r -= w * I_GU; const int l = w >> 1, f2 = w & 1; const int kb = r / 176, nbk = r % 176, pn = nbk >> 3, t32 = nbk & 7, bj = t32 >> 2;
            const float* Wg = gp(a.in[f2 ? 13 : 8]) + (size_t)l * 1024 * FF; const float* Wu = gp(a.in[f2 ? 14 : 9]) + (size_t)l * 1024 * FF; const float* gn = gp(a.in[f2 ? 12 : 7]) + l * 1024;
            tr_item(bj ? Wu : Wg, FF, pn * 128 + (t32 & 3) * 32, gn, (bf16_t*)(ws + W_GU0 + w * SZ_GU), 1024, nbk * 32, kb * 64, scr, lane, false); return; }
        r -= 4 * I_GU;
        if (r < 4 * I_DN) { const int w = r / I_DN; r -= w * I_DN; const int l = w >> 1, f2 = w & 1; const int kb = r / 32, nbk = r % 32;
            tr_item(gp(a.in[f2 ? 15 : 10]) + (size_t)l * FF * 1024, 1024, nbk * 32, nullptr, (bf16_t*)(ws + W_DN0 + w * SZ_DN), FF, nbk * 32, kb * 64, scr, lane, false); return; }
        r -= 4 * I_DN;
        if (r < I_AB) { const int kb = r / 80, nbk = r % 80, pn = nbk >> 3; int col0 = nbk * 32; if (pn < 4) { const int bj = (nbk & 7) >> 2; col0 = bj * 512 + pn * 128 + (nbk & 3) * 32; }
            tr_item(gp(a.in[16]), 2560, col0, gp(a.in[11]), (bf16_t*)(ws + W_AB), 1024, nbk * 32, kb * 64, scr, lane, false); return; }
        r -= I_AB;
        if (r < I_ABO) { const int kb = r / 32, nbk = r % 32; tr_item(gp(a.in[29]), 1024, nbk * 32, nullptr, (bf16_t*)(ws + W_ABO), 1024, nbk * 32, kb * 64, scr, lane, false); return; }
        r -= I_ABO;
        if (r < I_GLU) { const int kb = r / 16, nbk = r % 16; tr_item(gp(a.in[27]), 512, nbk * 32, nullptr, (bf16_t*)(ws + W_GLU), 512, nbk * 32, kb * 64, scr, lane, false); return; }
        r -= I_GLU;
        if (r < I_CD) { const int kb = r / 48, nbk = r % 48; tr_item(gp(a.in[30]), 1440, nbk * 32, gp(a.in[11]) + 1024, (bf16_t*)(ws + W_CD), 1024, nbk * 32, kb * 64, scr, lane, nbk >= 45); return; }
        r -= I_CD;
        if (r < I_CDO) { const int kb = r / 32, nbk = r % 32; tr_item(gp(a.in[40]), 1024, nbk * 32, nullptr, (bf16_t*)(ws + W_CDO), 1024, nbk * 32, kb * 64, scr, lane, false); return; }
        r -= I_CDO;
        if (r < I_UQ) { const int kb = r / 24, nbk = r % 24, pn = nbk >> 3, t32 = nbk & 7, bj = t32 >> 2, wc = t32 & 3; const int col0 = pn < 2 ? (pn * 4 + wc) * 96 + 32 * bj : (2 * wc + bj) * 96 + 64;
            tr_item(gp(a.in[35]), 768, col0, gp(a.in[34]), (bf16_t*)(ws + W_UQ), 256, nbk * 32, kb * 64, scr, lane, false); return; }
        r -= I_UQ;
        { const int kb = r / 32, nbk = r % 32, pn = nbk >> 3, t32 = nbk & 7, bj = t32 >> 2, wc = t32 & 3; int col0;
            if (pn < 2) col0 = (pn * 4 + wc) * 128 + 32 * bj; else { const int tc0 = t32 * 32; col0 = ((pn - 2) * 4 + (tc0 >> 6)) * 128 + 64 + (tc0 & 63); }
            tr_item(gp(a.in[37]), 1024, col0, nullptr, (bf16_t*)(ws + W_UKV), 128, nbk * 32, kb * 64, scr, lane, false); }
}

__device__ __forceinline__ void prologue(const Args& a, LAS unsigned char* lds, int G, const int wvs) {
    int tid_; asm volatile("v_mbcnt_lo_u32_b32 %0, -1, 0\n\tv_mbcnt_hi_u32_b32 %0, -1, %0" : "=v"(tid_)); tid_ += wvs * 64;
    const int tid = tid_, lane = tid & 63, wave = tid >> 6, bid = blockIdx.x;
    unsigned char* ws = gp(a.ws);
    LAS float* scr = (LAS float*)(lds + wave * 16384);
    const int gw = bid * 8 + wave, NGW = G * 8;
    if (G == 256) { for (int idx = gw; idx < NIT_A; idx += NGW) weight_item(a, ws, item_of(0, idx), scr, lane); }
    else { for (int it = gw; it < NIT; it += NGW) weight_item(a, ws, it, scr, lane); }
    { bf16_t* XB = (bf16_t*)(ws + A_XB); float* SSQ = (float*)(ws + A_SSQ);
      for (int row0 = gw * 2; row0 < M; row0 += NGW * 2) {
          const float* s0 = row0 < MP ? gp(a.in[0]) + (size_t)row0 * D : gp(a.in[1]) + (size_t)(row0 - MP) * D; const float* s1 = s0 + D;
          f32x4 v0[4], v1[4]; float ss0 = 0.f, ss1 = 0.f;
#pragma unroll
          for (int j = 0; j < 4; ++j) { v0[j] = ((const f32x4*)s0)[lane + 64 * j]; v1[j] = ((const f32x4*)s1)[lane + 64 * j]; }
#pragma unroll
          for (int j = 0; j < 4; ++j) { ss0 += sum4(v0[j] * v0[j]); ss1 += sum4(v1[j] * v1[j]); st_bf4(XB + (size_t)row0 * D + (lane + 64 * j) * 4, v0[j]); st_bf4(XB + (size_t)(row0 + 1) * D + (lane + 64 * j) * 4, v1[j]); }
#pragma unroll
          for (int o = 1; o < 64; o <<= 1) { ss0 += __shfl_xor(ss0, o); ss1 += __shfl_xor(ss1, o); }
          if (lane < 4) ((f32x4*)(SSQ + (size_t)row0 * 16))[lane] = (f32x4){lane == 0 ? ss0 : 0.f, 0.f, 0.f, 0.f};
          else if (lane < 8) ((f32x4*)(SSQ + (size_t)(row0 + 1) * 16))[lane - 4] = (f32x4){lane == 4 ? ss1 : 0.f, 0.f, 0.f, 0.f};
      } }
    const int gid = bid * 512 + tid, NT = G * 512;
    for (int i = gid; i < 65536; i += NT) {
        const int g = i >> 11, c = (i >> 4) & 127, h = i & 15, p = c & 63;
        const double lr = fmin((double)gp(a.in[19])[g * 64 + p], -1e-4), li = (double)gp(a.in[20])[g * 64 + p], dt = exp_d((double)gp(a.in[21])[g]);
        double sn, cs; sincos_d(li * dt, sn, cs); const double er = exp_d(lr * dt); const double br = er * cs, bi = er * sn;
        const double nr = br - 1.0, ni = bi, den = lr * lr + li * li; const double fr_ = (nr * lr + ni * li) / den, fi_ = (ni * lr - nr * li) / den;
        const double Br = (double)gp(a.in[22])[(g * 64 + p) * 16 + h], Bi = (double)gp(a.in[23])[(g * 64 + p) * 16 + h];
        const double vr = fr_ * Br - fi_ * Bi, vi = fr_ * Bi + fi_ * Br;
        ((bf16_t*)(ws + T_BBT))[i] = bf1((float)(c < 64 ? vr : vi));
        if (h == 0 && c < 64) ((f32x2*)(ws + T_LAMBAR))[g * 64 + p] = (f32x2){(float)br, (float)bi};
    }
    for (int i = gid; i < 65536; i += NT) {
        const int g = i >> 11, h = (i >> 7) & 15, k = i & 127;
        ((bf16_t*)(ws + T_CCT))[i] = bf1(k < 64 ? gp(a.in[24])[(g * 16 + h) * 64 + k] : -gp(a.in[25])[(g * 16 + h) * 64 + (k - 64)]);
    }
    for (int i = gid; i < 32768; i += NT) {
        const int pos = i >> 4, k = i & 15; const double inv = exp_d(-(double)k * (9.210340371976184 / 16.0)); double sn, cs; sincos_d((double)pos * inv, sn, cs);
        ((f32x2*)(ws + T_ROPE))[i] = (f32x2){(float)cs, (float)sn};
    }
    for (int i = gid; i < 512; i += NT) {
        const float l0 = gp(a.in[17])[i], l1 = gp(a.in[17])[512 + i], l2 = gp(a.in[17])[1024 + i]; const float mx = fmaxf(l0, fmaxf(l1, l2));
        const float e0 = __expf(l0 - mx), e1 = __expf(l1 - mx), e2 = __expf(l2 - mx); ((float*)(ws + T_LB))[i] = e0 / (e0 + e1 + e2);
    }
    if (gid == 0) {
        float gq = 0.f, gk = 0.f; for (int d = 0; d < 96; ++d) { gq = fmaxf(gq, fabsf(gp(a.in[38])[d])); gk = fmaxf(gk, fabsf(gp(a.in[39])[d])); }
        ((float*)(ws + A_CTL))[60] = 9.797958971132712f * gq * gk * 1.001f * 1.4426950408889634f; }
    for (int i = gid; i < 65536; i += NT) {
        const int t = (i >> 7) & 127, s = i & 127; ((bf16_t*)(ws + T_WS))[i] = bf1(s <= t ? gp(a.in[32])[i] : 0.f);
    }
}

__device__ __forceinline__ void hgrn_task(const int wvs, unsigned char* ws, unsigned char* ldsg, int rowbase, int nblk, const float* S0, float* Sout, int h) {
    int tid_; asm volatile("v_mbcnt_lo_u32_b32 %0, -1, 0\n\tv_mbcnt_hi_u32_b32 %0, -1, %0" : "=v"(tid_)); tid_ += wvs * 64;
    const int tid = tid_, lane = tid & 63, w = tid >> 6, fr = lane & 15, fq = lane >> 4;
    constexpr int PITCH = 136;
    const bf16_t* QT = (const bf16_t*)(ws + R_QT); const bf16_t* KH = (const bf16_t*)(ws + R_KH); const bf16_t* KTT = (const bf16_t*)(ws + R_KTT); const bf16_t* VTT = (const bf16_t*)(ws + R_VTT);
    const float* LDEC = (const float*)(ws + R_LDEC); bf16_t* OB = (bf16_t*)(ws + R_OB);
    f32x4 S[8];
#pragma unroll
    for (int vt = 0; vt < 8; ++vt)
#pragma unroll
        for (int j = 0; j < 4; ++j) S[vt][j] = S0 ? S0[(size_t)(16 * w + 4 * fq + j) * 128 + 16 * vt + fr] : 0.f;
    const u32x2 z2 = {0u, 0u};
    bf16x8 qf[4], kf[4]; u32x2 vown, ktf, vf[8]; f32x4 dec;
#define HG_LOAD(Q, K, VO, KT, VF, DE, rb_) do { const int rbx = (rb_); const size_t gbx = (size_t)(rbx >> 4) * 8192; \
        _Pragma("unroll") for (int ks = 0; ks < 4; ++ks) { Q[ks] = *(const bf16x8*)(QT + (size_t)(rbx + fr) * 512 + h * 128 + ks * 32 + fq * 8); K[ks] = *(const bf16x8*)(KH + (size_t)(rbx + fr) * 512 + h * 128 + ks * 32 + fq * 8); } \
        VO = *(const u32x2*)(VTT + gbx + (size_t)(h * 128 + 16 * w + fr) * 16 + 4 * fq); KT = *(const u32x2*)(KTT + gbx + (size_t)(h * 128 + 16 * w + fr) * 16 + 4 * fq); \
        _Pragma("unroll") for (int vt = 0; vt < 8; ++vt) VF[vt] = *(const u32x2*)(VTT + gbx + (size_t)(h * 128 + 16 * vt + fr) * 16 + 4 * fq); \
        DE = *(const f32x4*)(LDEC + (size_t)(rbx >> 4) * 512 + h * 128 + 16 * w + 4 * fq); } while (0)
    HG_LOAD(qf, kf, vown, ktf, vf, dec, rowbase);
    for (int blk = 0; blk < nblk; ++blk) {
        const int rb = rowbase + 16 * blk;
        bf16_t* sl = (bf16_t*)(ldsg + (blk & 1) * (128 * PITCH * 2));
#pragma unroll
        for (int vt = 0; vt < 8; ++vt) st_bf4(sl + (16 * vt + fr) * PITCH + 16 * w + 4 * fq, S[vt]);
        bf16x8 qn[4], kn[4]; u32x2 vown_n, ktf_n, vfn[8]; f32x4 dec_n;
        HG_LOAD(qn, kn, vown_n, ktf_n, vfn, dec_n, rowbase + 16 * (blk + 1 < nblk ? blk + 1 : blk));
        __syncthreads();
        f32x4 o = {0.f, 0.f, 0.f, 0.f}, pt = {0.f, 0.f, 0.f, 0.f};
#pragma unroll
        for (int ks = 0; ks < 4; ++ks) { const bf16x8 sf = *(const bf16x8*)(sl + (16 * w + fr) * PITCH + ks * 32 + fq * 8); o = mfma16(qf[ks], sf, o); pt = mfma16(kf[ks], qf[ks], pt); }
#pragma unroll
        for (int j = 0; j < 4; ++j) if (4 * fq + j > fr) pt[j] = 0.f;
        u32x2 pp; pp.x = cvt_pk_bf16(pt[0], pt[1]); pp.y = cvt_pk_bf16(pt[2], pt[3]);
        o = mfma16(mk8(pp, z2), mk8(vown, z2), o);
#pragma unroll
        for (int j = 0; j < 4; ++j) OB[(size_t)(rb + 4 * fq + j) * 512 + h * 128 + 16 * w + fr] = bf1(o[j]);
        const bf16x8 ka = mk8(ktf, z2);
#pragma unroll
        for (int vt = 0; vt < 8; ++vt) { S[vt] = S[vt] * dec; S[vt] = mfma16(ka, mk8(vf[vt], z2), S[vt]); }
#pragma unroll
        for (int ks = 0; ks < 4; ++ks) { qf[ks] = qn[ks]; kf[ks] = kn[ks]; }
        vown = vown_n; ktf = ktf_n; dec = dec_n;
#pragma unroll
        for (int vt = 0; vt < 8; ++vt) vf[vt] = vfn[vt];
    }
#undef HG_LOAD
#pragma unroll
    for (int vt = 0; vt < 8; ++vt)
#pragma unroll
        for (int j = 0; j < 4; ++j) Sout[(size_t)(16 * w + 4 * fq + j) * 128 + 16 * vt + fr] = S[vt][j];
    __syncthreads();
}

__device__ __forceinline__ void hgrn_prompt(const int wvs, unsigned char* ws, unsigned char* ldsg, int rowbase, float* Sout, int h) {
    int tid_; asm volatile("v_mbcnt_lo_u32_b32 %0, -1, 0\n\tv_mbcnt_hi_u32_b32 %0, -1, %0" : "=v"(tid_)); tid_ += wvs * 64;
    const int tid = tid_, lane = tid & 63, w = tid >> 6, fr = lane & 15, fq = lane >> 4;
    constexpr int PITCH = 136, SBUF = 128 * PITCH * 2, QP = 136, SLOT = 2 * 16 * QP * 2 + 2 * 4096 + 512, NBLK = 128, DEP = 8;
    const bf16_t* QT = (const bf16_t*)(ws + R_QT); const bf16_t* KH = (const bf16_t*)(ws + R_KH); const bf16_t* KTT = (const bf16_t*)(ws + R_KTT); const bf16_t* VTT = (const bf16_t*)(ws + R_VTT);
    const float* LDEC = (const float*)(ws + R_LDEC); bf16_t* OB = (bf16_t*)(ws + R_OB);
    unsigned char* ring = ldsg + 2 * SBUF;
    const int t2 = tid & 255; const bool lo = tid < 256;
    const bf16_t* gA = (lo ? QT : KH) + (size_t)(rowbase + (t2 >> 4)) * 512 + h * 128 + (t2 & 15) * 8;
    const bf16_t* gB = (lo ? VTT : KTT) + (size_t)(rowbase >> 4) * 8192 + (size_t)h * 128 * 16 + t2 * 8;
    const float* gD = LDEC + (size_t)(rowbase >> 4) * 512 + h * 128 + (tid & 31) * 4;
    const int lA = (lo ? 0 : 16 * QP * 2) + ((t2 >> 4) * QP + (t2 & 15) * 8) * 2, lB = 2 * 16 * QP * 2 + (lo ? 0 : 4096) + t2 * 16, lD = 2 * 16 * QP * 2 + 8192 + (tid & 31) * 16;
    u32x4 ra[DEP], rb_[DEP]; f32x4 rd[DEP];
#pragma unroll
    for (int s = 0; s < DEP; ++s) { ra[s] = *(const u32x4*)(gA + (size_t)s * 8192); rb_[s] = *(const u32x4*)(gB + (size_t)s * 8192); rd[s] = *(const f32x4*)(gD + (size_t)s * 512); }
    f32x4 S[8];
#pragma unroll
    for (int vt = 0; vt < 8; ++vt) S[vt] = (f32x4){0.f, 0.f, 0.f, 0.f};
    const u32x2 z2 = {0u, 0u};
    *(u32x4*)(ring + lA) = ra[0]; *(u32x4*)(ring + lB) = rb_[0]; if (tid < 32) *(f32x4*)(ring + lD) = rd[0];
    ra[0] = *(const u32x4*)(gA + (size_t)DEP * 8192); rb_[0] = *(const u32x4*)(gB + (size_t)DEP * 8192); rd[0] = *(const f32x4*)(gD + (size_t)DEP * 512);
    for (int b0 = 0; b0 < NBLK; b0 += DEP) {
#pragma unroll
        for (int s = 0; s < DEP; ++s) {
            const int blk = b0 + s, rb = rowbase + 16 * blk;
            bf16_t* sl = (bf16_t*)(ldsg + (blk & 1) * SBUF);
#pragma unroll
            for (int vt = 0; vt < 8; ++vt) st_bf4(sl + (16 * vt + fr) * PITCH + 16 * w + 4 * fq, S[vt]);
            asm volatile("s_waitcnt lgkmcnt(0)" ::: "memory"); __builtin_amdgcn_s_barrier(); asm volatile("" ::: "memory");
            { constexpr int dummy = 0; (void)dummy; const int sn = (s + 1) % DEP; unsigned char* slot = ring + ((blk + 1) & 1) * SLOT;
              *(u32x4*)(slot + lA) = ra[sn]; *(u32x4*)(slot + lB) = rb_[sn]; if (tid < 32) *(f32x4*)(slot + lD) = rd[sn];
              const int nb = blk + 1 + DEP < NBLK ? blk + 1 + DEP : NBLK - 1;
              ra[sn] = *(const u32x4*)(gA + (size_t)nb * 8192); rb_[sn] = *(const u32x4*)(gB + (size_t)nb * 8192); rd[sn] = *(const f32x4*)(gD + (size_t)nb * 512); }
            const unsigned char* cur = ring + (blk & 1) * SLOT; const bf16_t* Qs = (const bf16_t*)cur; const bf16_t* Ks = (const bf16_t*)(cur + 16 * QP * 2); const bf16_t* Vs = (const bf16_t*)(cur + 2 * 16 * QP * 2); const bf16_t* KTs = Vs + 2048;
            const f32x4 dec = *(const f32x4*)(cur + 2 * 16 * QP * 2 + 8192 + (16 * w + 4 * fq) * 4);
            f32x4 o = {0.f, 0.f, 0.f, 0.f}, pt = {0.f, 0.f, 0.f, 0.f};
#pragma unroll
            for (int ks = 0; ks < 4; ++ks) { const bf16x8 qf = *(const bf16x8*)(Qs + fr * QP + ks * 32 + fq * 8), kf = *(const bf16x8*)(Ks + fr * QP + ks * 32 + fq * 8);
                const bf16x8 sf = *(const bf16x8*)(sl + (16 * w + fr) * PITCH + ks * 32 + fq * 8); o = mfma16(qf, sf, o); pt = mfma16(kf, qf, pt); }
#pragma unroll
            for (int j = 0; j < 4; ++j) if (4 * fq + j > fr) pt[j] = 0.f;
            u32x2 pp; pp.x = cvt_pk_bf16(pt[0], pt[1]); pp.y = cvt_pk_bf16(pt[2], pt[3]);
            o = mfma16(mk8(pp, z2), mk8(*(const u32x2*)(Vs + (16 * w + fr) * 16 + 4 * fq), z2), o);
#pragma unroll
            for (int j = 0; j < 4; ++j) OB[(size_t)(rb + 4 * fq + j) * 512 + h * 128 + 16 * w + fr] = bf1(o[j]);
            const bf16x8 ka = mk8(*(const u32x2*)(KTs + (16 * w + fr) * 16 + 4 * fq), z2);
#pragma unroll
            for (int vt = 0; vt < 8; ++vt) { S[vt] = S[vt] * dec; S[vt] = mfma16(ka, mk8(*(const u32x2*)(Vs + (16 * vt + fr) * 16 + 4 * fq), z2), S[vt]); }
        }
    }
#pragma unroll
    for (int vt = 0; vt < 8; ++vt)
#pragma unroll
        for (int j = 0; j < 4; ++j) Sout[(size_t)(16 * w + 4 * fq + j) * 128 + 16 * vt + fr] = S[vt][j];
    __syncthreads();
}

__device__ __forceinline__ void s5_task(const int wvs, unsigned char* ws, unsigned char* ldsw, const float* dvec, int rowbase, int nblk, const float* x0re, const float* x0im, float* ore, float* oim, int g) {
    int tid_; asm volatile("v_mbcnt_lo_u32_b32 %0, -1, 0\n\tv_mbcnt_hi_u32_b32 %0, -1, %0" : "=v"(tid_)); tid_ += wvs * 64;
    const int lane = tid_ & 63, fr = lane & 15, fq = lane >> 4;
    constexpr int BP = 132, XP = 136;
    float* buf = (float*)ldsw; bf16_t* xb = (bf16_t*)(ldsw + 16 * BP * 4);
    const bf16_t* UB = (const bf16_t*)(ws + R_UB); bf16_t* ZB = (bf16_t*)(ws + R_ZB);
    const f32x2 lam = ((const f32x2*)(ws + T_LAMBAR))[g * 64 + lane];
    float xr = x0re ? x0re[lane] : 0.f, xi = x0im ? x0im[lane] : 0.f;
    const u32x2 z2 = {0u, 0u};
    bf16x8 Bf[8], Cf[4];
#pragma unroll
    for (int nt = 0; nt < 8; ++nt) Bf[nt] = mk8(*(const u32x2*)((const bf16_t*)(ws + T_BBT) + (size_t)(g * 128 + 16 * nt + fr) * 16 + 4 * fq), z2);
#pragma unroll
    for (int ks = 0; ks < 4; ++ks) Cf[ks] = *(const bf16x8*)((const bf16_t*)(ws + T_CCT) + (size_t)(g * 16 + fr) * 128 + 32 * ks + 8 * fq);
    const float dv = dvec[g * 16 + fr];
    u32x2 ucur = *(const u32x2*)(UB + (size_t)(rowbase + fr) * 512 + g * 16 + 4 * fq);
    unsigned short uv[4];
#pragma unroll
    for (int j = 0; j < 4; ++j) uv[j] = UB[(size_t)(rowbase + 4 * fq + j) * 512 + g * 16 + fr];
    for (int blk = 0; blk < nblk; ++blk) {
        const int rb = rowbase + 16 * blk; const int rbn = rowbase + 16 * (blk + 1 < nblk ? blk + 1 : blk);
        const bf16x8 uf = mk8(ucur, z2);
        const u32x2 unext = *(const u32x2*)(UB + (size_t)(rbn + fr) * 512 + g * 16 + 4 * fq);
        unsigned short uvn[4];
#pragma unroll
        for (int j = 0; j < 4; ++j) uvn[j] = UB[(size_t)(rbn + 4 * fq + j) * 512 + g * 16 + fr];
#pragma unroll
        for (int nt = 0; nt < 8; ++nt) { const f32x4 d = mfma16(uf, Bf[nt], (f32x4){0.f, 0.f, 0.f, 0.f});
#pragma unroll
            for (int j = 0; j < 4; ++j) buf[(4 * fq + j) * BP + 16 * nt + fr] = d[j]; }
        LDSWAIT();
#pragma unroll
        for (int t = 0; t < 16; ++t) { const float br = buf[t * BP + lane], bi = buf[t * BP + 64 + lane];
            const float nr = lam.x * xr - lam.y * xi + br, ni = lam.x * xi + lam.y * xr + bi; xr = nr; xi = ni;
            xb[t * XP + lane] = bf1(nr); xb[t * XP + 64 + lane] = bf1(ni); }
        LDSWAIT();
        f32x4 y = {0.f, 0.f, 0.f, 0.f};
#pragma unroll
        for (int ks = 0; ks < 4; ++ks) y = mfma16(*(const bf16x8*)(xb + fr * XP + 32 * ks + 8 * fq), Cf[ks], y);
#pragma unroll
        for (int j = 0; j < 4; ++j) { const size_t idx = (size_t)(rb + 4 * fq + j) * 512 + g * 16 + fr; ZB[idx] = bf1(gelu_tanh(y[j] + dv * bf2f(uv[j]))); }
        LDSWAIT();
        ucur = unext;
#pragma unroll
        for (int j = 0; j < 4; ++j) uv[j] = uvn[j];
    }
    ore[lane] = xr; oim[lane] = xi;
}

__device__ __forceinline__ void spatial_unit(const int wvs, const Args& a, unsigned char* ldsg, int rb, int L, int gg, float* vout  ) {
    unsigned char* ws = gp(a.ws);
    int tid_; asm volatile("v_mbcnt_lo_u32_b32 %0, -1, 0\n\tv_mbcnt_hi_u32_b32 %0, -1, %0" : "=v"(tid_)); tid_ += wvs * 64;
    const int tid = tid_, lane = tid & 63, w = tid >> 6, fr = lane & 15, fq = lane >> 4;
    const int TP = L + 8, cm = (L >> 3) - 1;
    bf16_t* T = (bf16_t*)ldsg; const bf16_t* VG = (const bf16_t*)(ws + R_VG); const float* SSV = (const float*)(ws + A_SSV); bf16_t* MIX = (bf16_t*)(ws + R_MIX);
    for (int it = tid; it < L * 16; it += 512) { const int s = it >> 4, dg = it & 15; const int row = rb + s;
        const f32x4 p0 = *(const f32x4*)(SSV + (size_t)row * 8), p1 = *(const f32x4*)(SSV + (size_t)row * 8 + 4); const float rs = rsqrtf((sum4(p0) + sum4(p1)) * (1.f / 512.f) + EPS);
        const u32x4 raw = *(const u32x4*)(VG + (size_t)row * 512 + gg * 128 + dg * 8); float v[8];
        v[0] = __uint_as_float(raw.x << 16) * rs; v[1] = __uint_as_float(raw.x & 0xffff0000u) * rs; v[2] = __uint_as_float(raw.y << 16) * rs; v[3] = __uint_as_float(raw.y & 0xffff0000u) * rs;
        v[4] = __uint_as_float(raw.z << 16) * rs; v[5] = __uint_as_float(raw.z & 0xffff0000u) * rs; v[6] = __uint_as_float(raw.w << 16) * rs; v[7] = __uint_as_float(raw.w & 0xffff0000u) * rs;
#pragma unroll
        for (int i = 0; i < 8; ++i) T[(dg * 8 + i) * TP + ((((s >> 3) ^ (dg & cm)) << 3) | (s & 7))] = bf1(v[i]);
        if (vout) { *(f32x4*)(vout + (size_t)s * 512 + gg * 128 + dg * 8) = (f32x4){v[0], v[1], v[2], v[3]}; *(f32x4*)(vout + (size_t)s * 512 + gg * 128 + dg * 8 + 4) = (f32x4){v[4], v[5], v[6], v[7]}; }
    }
    __syncthreads();
    if (16 * w < L) {
        const bf16_t* WS = (const bf16_t*)(ws + T_WS) + (size_t)gg * 16384;
        f32x4 acc[8];
#pragma unroll
        for (int dt = 0; dt < 8; ++dt) acc[dt] = (f32x4){0.f, 0.f, 0.f, 0.f};
        const int nks = (16 * w + 15) / 32 + 1;
        for (int ks = 0; ks < nks; ++ks) { const bf16x8 af = *(const bf16x8*)(WS + (size_t)(16 * w + fr) * 128 + 32 * ks + 8 * fq);
#pragma unroll
            for (int dt = 0; dt < 8; ++dt) acc[dt] = mfma16(af, *(const bf16x8*)(T + (16 * dt + fr) * TP + (((4 * ks + fq) ^ ((2 * dt + (fr >> 3)) & cm)) << 3)), acc[dt]); }
#pragma unroll
        for (int j = 0; j < 4; ++j) { const int t = 16 * w + 4 * fq + j; const float bs = gp(a.in[33])[gg * 128 + t];
#pragma unroll
            for (int dt = 0; dt < 8; ++dt) { const size_t idx = (size_t)(rb + t) * 1024 + gg * 128 + 16 * dt + fr; MIX[idx] = bf1(bf2f(MIX[idx]) * (acc[dt][j] + bs)); } }
    }
    __syncthreads();
}

__device__ __forceinline__ void attn_task(const int wvs, unsigned char* ws, int qrow0, int kvrow0, int nkeys, int L, int head) {
    int tid_; asm volatile("v_mbcnt_lo_u32_b32 %0, -1, 0\n\tv_mbcnt_hi_u32_b32 %0, -1, %0" : "=v"(tid_)); tid_ += wvs * 64;
    const int lane = tid_ & 63, fr = lane & 15, fq = lane >> 4;
    const bf16_t* QF = (const bf16_t*)(ws + R_QF); const bf16_t* KF = (const bf16_t*)(ws + R_KF); const bf16_t* VT = (const bf16_t*)(ws + R_VT);
    const float* SSQN = (const float*)(ws + A_SSQN); const float* SSQR = (const float*)(ws + A_SSQR); bf16_t* MIX = (bf16_t*)(ws + R_MIX);
    const int qrow = qrow0 + fr;
    bf16x8 qf[3];
#pragma unroll
    for (int ks = 0; ks < 3; ++ks) qf[ks] = *(const bf16x8*)(QF + (size_t)qrow * 768 + head * 96 + ks * 32 + fq * 8);
    const float sc = rsqrtf((SSQN[(size_t)qrow * 8 + head] + SSQR[(size_t)qrow * 8 + head]) * (1.f / 96.f) + EPS) * (0.10206207261596575f * 1.4426950408889634f);
    float mrun = -INFINITY, lrun = 0.f; f32x4 o[4];
#pragma unroll
    for (int dt = 0; dt < 4; ++dt) o[dt] = (f32x4){0.f, 0.f, 0.f, 0.f};
    const bf16_t* kp = KF + (size_t)(kvrow0 + fr) * 768 + head * 96 + fq * 8;
    const bf16_t* vp = VT + (size_t)kvrow0 * 512 + (size_t)(head * 64 + fr) * L + 4 * fq;
    bf16x8 ka[2][3]; u32x2 va[4][2];
#define AT_LOAD(KA, VA, k0_) do { const int kx = (k0_); \
        _Pragma("unroll") for (int hf = 0; hf < 2; ++hf) _Pragma("unroll") for (int ks = 0; ks < 3; ++ks) KA[hf][ks] = *(const bf16x8*)(kp + (size_t)(kx + 16 * hf) * 768 + ks * 32); \
        _Pragma("unroll") for (int dt = 0; dt < 4; ++dt) _Pragma("unroll") for (int hf = 0; hf < 2; ++hf) VA[dt][hf] = *(const u32x2*)(vp + (size_t)dt * 16 * L + kx + 16 * hf); } while (0)
    AT_LOAD(ka, va, 0);
    for (int k0 = 0; k0 < nkeys; k0 += 32) {
        bf16x8 kn[2][3]; u32x2 vn[4][2];
        AT_LOAD(kn, vn, (k0 + 32 < nkeys ? k0 + 32 : k0));
        f32x4 st[2];
#pragma unroll
        for (int hf = 0; hf < 2; ++hf) { st[hf] = (f32x4){0.f, 0.f, 0.f, 0.f};
#pragma unroll
            for (int ks = 0; ks < 3; ++ks) st[hf] = mfma16(ka[hf][ks], qf[ks], st[hf]); }
        const f32x4 s0 = st[0] * sc, s1 = st[1] * sc;
        float mx = fmaxf(fmaxf(fmaxf(s0.x, s0.y), fmaxf(s0.z, s0.w)), fmaxf(fmaxf(s1.x, s1.y), fmaxf(s1.z, s1.w)));
        mx = fmaxf(mx, __shfl_xor(mx, 16)); mx = fmaxf(mx, __shfl_xor(mx, 32));
        const float mnew = fmaxf(mrun, mx), alpha = exp2f(mrun - mnew); mrun = mnew;
        f32x4 p0, p1;
#pragma unroll
        for (int j = 0; j < 4; ++j) { p0[j] = exp2f(s0[j] - mnew); p1[j] = exp2f(s1[j] - mnew); }
        float ls = sum4(p0) + sum4(p1); ls += __shfl_xor(ls, 16); ls += __shfl_xor(ls, 32);
        lrun = lrun * alpha + ls;
        u32x2 pa, pb; pa.x = cvt_pk_bf16(p0[0], p0[1]); pa.y = cvt_pk_bf16(p0[2], p0[3]); pb.x = cvt_pk_bf16(p1[0], p1[1]); pb.y = cvt_pk_bf16(p1[2], p1[3]);
        const bf16x8 pf = mk8(pa, pb);
#pragma unroll
        for (int dt = 0; dt < 4; ++dt) { o[dt] = o[dt] * alpha; o[dt] = mfma16(mk8(va[dt][0], va[dt][1]), pf, o[dt]); }
#pragma unroll
        for (int hf = 0; hf < 2; ++hf) {
#pragma unroll
            for (int ks = 0; ks < 3; ++ks) ka[hf][ks] = kn[hf][ks];
#pragma unroll
            for (int dt = 0; dt < 4; ++dt) va[dt][hf] = vn[dt][hf]; }
    }
#undef AT_LOAD
    const float inv = 1.f / lrun;
#pragma unroll
    for (int dt = 0; dt < 4; ++dt) st_bf4(MIX + (size_t)qrow * 1024 + 512 + head * 64 + 16 * dt + 4 * fq, o[dt] * inv);
}

__device__ __forceinline__ void attn_unit(const int wvs, unsigned char* ws, unsigned char* ldsg, int b, int head, int qb) {
    int tid_; asm volatile("v_mbcnt_lo_u32_b32 %0, -1, 0\n\tv_mbcnt_hi_u32_b32 %0, -1, %0" : "=v"(tid_)); tid_ += wvs * 64;
    const int tid = tid_, lane = tid & 63, w = tid >> 6, fr = lane & 15, fq = lane >> 4;
    constexpr int KP = 104, VP = 72, KB_BYTES = 64 * KP * 2, VB_BYTES = 64 * VP * 2;
    const bf16_t* QF = (const bf16_t*)(ws + R_QF); const bf16_t* KF = (const bf16_t*)(ws + R_KF); const bf16_t* VT = (const bf16_t*)(ws + R_VT);
    const float* SSQN = (const float*)(ws + A_SSQN); const float* SSQR = (const float*)(ws + A_SSQR); bf16_t* MIX = (bf16_t*)(ws + R_MIX);
    const int kvrow0 = b * 2048, qrow = b * 2048 + qb * 128 + w * 16 + fr;
    const int ntiles = 2 * qb + 2, mytiles = 2 * qb + 1 + (w >> 2);
    bf16x8 qf[3];
#pragma unroll
    for (int ks = 0; ks < 3; ++ks) qf[ks] = *(const bf16x8*)(QF + (size_t)qrow * 768 + head * 96 + ks * 32 + fq * 8);
    const float sc = rsqrtf((SSQN[(size_t)qrow * 8 + head] + SSQR[(size_t)qrow * 8 + head]) * (1.f / 96.f) + EPS) * (0.10206207261596575f * 1.4426950408889634f);
    float mrun = -INFINITY, lrun = 0.f; f32x4 o[4];
#pragma unroll
    for (int dt = 0; dt < 4; ++dt) o[dt] = (f32x4){0.f, 0.f, 0.f, 0.f};
    const int kr0 = tid / 12, kc0 = tid - kr0 * 12, id1 = tid + 512, kr1 = id1 / 12, kc1 = id1 - kr1 * 12; const bool has1 = tid < 256;
    const bf16_t* kg0 = KF + (size_t)(kvrow0 + kr0) * 768 + head * 96 + kc0 * 8; const bf16_t* kg1 = KF + (size_t)(kvrow0 + kr1) * 768 + head * 96 + kc1 * 8;
    const bf16_t* vg = VT + (size_t)kvrow0 * 512 + (size_t)(head * 64 + (tid >> 3)) * 2048 + (tid & 7) * 8;
    const int kl0 = kr0 * KP + kc0 * 8, kl1 = kr1 * KP + kc1 * 8, vl = (tid >> 3) * VP + (tid & 7) * 8;
    u32x4 rk0, rk1 = {0u, 0u, 0u, 0u}, rv;
    rk0 = *(const u32x4*)kg0; if (has1) rk1 = *(const u32x4*)kg1; rv = *(const u32x4*)vg;
    { bf16_t* kb = (bf16_t*)ldsg; bf16_t* vb = (bf16_t*)(ldsg + 2 * KB_BYTES);
      *(u32x4*)(kb + kl0) = rk0; if (has1) *(u32x4*)(kb + kl1) = rk1; *(u32x4*)(vb + vl) = rv; }
    asm volatile("s_waitcnt lgkmcnt(0)" ::: "memory"); __builtin_amdgcn_s_barrier(); asm volatile("" ::: "memory");
    for (int j = 0; j < ntiles; ++j) {
        const bool more = j + 1 < ntiles;
        if (more) { rk0 = *(const u32x4*)(kg0 + (size_t)(j + 1) * 64 * 768); if (has1) rk1 = *(const u32x4*)(kg1 + (size_t)(j + 1) * 64 * 768); rv = *(const u32x4*)(vg + (j + 1) * 64); }
        if (j < mytiles) {
            const bf16_t* kb = (const bf16_t*)(ldsg + (j & 1) * KB_BYTES); const bf16_t* vb = (const bf16_t*)(ldsg + 2 * KB_BYTES + (j & 1) * VB_BYTES);
            f32x4 st[4];
#pragma unroll
            for (int g = 0; g < 4; ++g) { st[g] = (f32x4){0.f, 0.f, 0.f, 0.f};
#pragma unroll
                for (int ks = 0; ks < 3; ++ks) st[g] = mfma16(*(const bf16x8*)(kb + (16 * g + fr) * KP + ks * 32 + fq * 8), qf[ks], st[g]); }
            float mx = -INFINITY;
#pragma unroll
            for (int g = 0; g < 4; ++g) { st[g] = st[g] * sc; mx = fmaxf(mx, fmaxf(fmaxf(st[g].x, st[g].y), fmaxf(st[g].z, st[g].w))); }
            mx = fmaxf(mx, __shfl_xor(mx, 16)); mx = fmaxf(mx, __shfl_xor(mx, 32));
            const float mnew = fmaxf(mrun, mx), alpha = __builtin_amdgcn_exp2f(mrun - mnew); mrun = mnew;
            float ls = 0.f;
#pragma unroll
            for (int g = 0; g < 4; ++g) {
#pragma unroll
                for (int jj = 0; jj < 4; ++jj) { st[g][jj] = __builtin_amdgcn_exp2f(st[g][jj] - mnew); ls += st[g][jj]; } }
            ls += __shfl_xor(ls, 16); ls += __shfl_xor(ls, 32);
            lrun = lrun * alpha + ls;
#pragma unroll
            for (int dt = 0; dt < 4; ++dt) o[dt] = o[dt] * alpha;
#pragma unroll
            for (int s = 0; s < 2; ++s) {
                u32x2 pa, pb; pa.x = cvt_pk_bf16(st[2 * s][0], st[2 * s][1]); pa.y = cvt_pk_bf16(st[2 * s][2], st[2 * s][3]); pb.x = cvt_pk_bf16(st[2 * s + 1][0], st[2 * s + 1][1]); pb.y = cvt_pk_bf16(st[2 * s + 1][2], st[2 * s + 1][3]);
                const bf16x8 pf = mk8(pa, pb);
#pragma unroll
                for (int dt = 0; dt < 4; ++dt) { const u32x2 v0 = *(const u32x2*)(vb + (16 * dt + fr) * VP + 32 * s + 4 * fq), v1 = *(const u32x2*)(vb + (16 * dt + fr) * VP + 32 * s + 16 + 4 * fq);
                    o[dt] = mfma16(mk8(v0, v1), pf, o[dt]); }
            }
        }
        if (more) { bf16_t* kb = (bf16_t*)(ldsg + ((j + 1) & 1) * KB_BYTES); bf16_t* vb = (bf16_t*)(ldsg + 2 * KB_BYTES + ((j + 1) & 1) * VB_BYTES);
            *(u32x4*)(kb + kl0) = rk0; if (has1) *(u32x4*)(kb + kl1) = rk1; *(u32x4*)(vb + vl) = rv; }
        asm volatile("s_waitcnt lgkmcnt(0)" ::: "memory"); __builtin_amdgcn_s_barrier(); asm volatile("" ::: "memory");
    }
    const float inv = 1.f / lrun;
#pragma unroll
    for (int dt = 0; dt < 4; ++dt) st_bf4(MIX + (size_t)qrow * 1024 + 512 + head * 64 + 16 * dt + 4 * fq, o[dt] * inv);
}

__device__ __forceinline__ void attn_unit2(const int wvs, unsigned char* ws, unsigned char* ldsg, int b, int head, int qb) {
    int tid_; asm volatile("v_mbcnt_lo_u32_b32 %0, -1, 0\n\tv_mbcnt_hi_u32_b32 %0, -1, %0" : "=v"(tid_)); tid_ += wvs * 64;
    const int tid = tid_, lane = tid & 63, w = tid >> 6, fr = lane & 15, fq = lane >> 4;
    constexpr int KP = 104, VP = 72, KB_BYTES = 64 * KP * 2, VB_BYTES = 64 * VP * 2;
    const bf16_t* QF = (const bf16_t*)(ws + R_QF); const bf16_t* KF = (const bf16_t*)(ws + R_KF); const bf16_t* VT = (const bf16_t*)(ws + R_VT);
    const float* SSQN = (const float*)(ws + A_SSQN); const float* SSQR = (const float*)(ws + A_SSQR); bf16_t* MIX = (bf16_t*)(ws + R_MIX);
    const int kvrow0 = b * 2048, qrow0 = b * 2048 + qb * 256 + w * 32 + fr;
    const int ntiles = 4 * qb + 4, mytiles = 4 * qb + 1 + (w >> 1);
    const float nsm = -((const float*)(ws + A_CTL))[60];
    bf16x8 qf[2][3]; float sc[2], mrun[2], lrun[2]; f32x4 o[2][4];
#pragma unroll
    for (int r = 0; r < 2; ++r) { const int qrow = qrow0 + 16 * r;
#pragma unroll
        for (int ks = 0; ks < 3; ++ks) qf[r][ks] = *(const bf16x8*)(QF + (size_t)qrow * 768 + head * 96 + ks * 32 + fq * 8);
        sc[r] = rsqrtf((SSQN[(size_t)qrow * 8 + head] + SSQR[(size_t)qrow * 8 + head]) * (1.f / 96.f) + EPS) * (0.10206207261596575f * 1.4426950408889634f);
#pragma unroll
        for (int ks = 0; ks < 3; ++ks) { const u32x4 qw = __builtin_bit_cast(u32x4, qf[r][ks]); u32x4 qs;
            qs.x = cvt_pk_bf16(__uint_as_float(qw.x << 16) * sc[r], __uint_as_float(qw.x & 0xffff0000u) * sc[r]); qs.y = cvt_pk_bf16(__uint_as_float(qw.y << 16) * sc[r], __uint_as_float(qw.y & 0xffff0000u) * sc[r]);
            qs.z = cvt_pk_bf16(__uint_as_float(qw.z << 16) * sc[r], __uint_as_float(qw.z & 0xffff0000u) * sc[r]); qs.w = cvt_pk_bf16(__uint_as_float(qw.w << 16) * sc[r], __uint_as_float(qw.w & 0xffff0000u) * sc[r]);
            qf[r][ks] = __builtin_bit_cast(bf16x8, qs); }
        mrun[r] = 0.f; lrun[r] = 0.f;
#pragma unroll
        for (int dt = 0; dt < 4; ++dt) o[r][dt] = (f32x4){0.f, 0.f, 0.f, 0.f}; }
    const int kr0 = tid / 12, kc0 = tid - kr0 * 12, id1 = tid + 512, kr1 = id1 / 12, kc1 = id1 - kr1 * 12; const bool has1 = tid < 256;
    const bf16_t* kg0 = KF + (size_t)(kvrow0 + kr0) * 768 + head * 96 + kc0 * 8; const bf16_t* kg1 = KF + (size_t)(kvrow0 + kr1) * 768 + head * 96 + kc1 * 8;
    const bf16_t* vg = VT + (size_t)kvrow0 * 512 + (size_t)(head * 64 + (tid >> 3)) * 2048 + (tid & 7) * 8;
    const int kl0 = kr0 * KP + kc0 * 8, kl1 = kr1 * KP + kc1 * 8, vl = (tid >> 3) * VP + (tid & 7) * 8;
#define AT_COMPUTE \
        if (j < mytiles) { \
            const bf16_t* kb = (const bf16_t*)(ldsg + (j & 1) * KB_BYTES); const bf16_t* vb = (const bf16_t*)(ldsg + 2 * KB_BYTES + (j & 1) * VB_BYTES); \
            f32x4 st[2][4]; \
_Pragma("unroll") \
            for (int g = 0; g < 4; ++g) { st[0][g] = (f32x4){nsm, nsm, nsm, nsm}; st[1][g] = (f32x4){nsm, nsm, nsm, nsm}; \
_Pragma("unroll") \
                for (int ks = 0; ks < 3; ++ks) { const bf16x8 kf = *(const bf16x8*)(kb + (16 * g + fr) * KP + ks * 32 + fq * 8); st[0][g] = mfma16(kf, qf[0][ks], st[0][g]); st[1][g] = mfma16(kf, qf[1][ks], st[1][g]); } } \
_Pragma("unroll") \
            for (int r = 0; r < 2; ++r) { \
                float ls = 0.f; \
_Pragma("unroll") \
                for (int g = 0; g < 4; ++g) { \
_Pragma("unroll") \
                    for (int jj = 0; jj < 4; ++jj) { st[r][g][jj] = __builtin_amdgcn_exp2f(st[r][g][jj]); ls += st[r][g][jj]; } } \
                lrun[r] += ls; \
            } \
_Pragma("unroll") \
            for (int s = 0; s < 2; ++s) { \
                bf16x8 pf[2]; \
_Pragma("unroll") \
                for (int r = 0; r < 2; ++r) { u32x2 pa, pb; pa.x = cvt_pk_bf16(st[r][2 * s][0], st[r][2 * s][1]); pa.y = cvt_pk_bf16(st[r][2 * s][2], st[r][2 * s][3]); \
                    pb.x = cvt_pk_bf16(st[r][2 * s + 1][0], st[r][2 * s + 1][1]); pb.y = cvt_pk_bf16(st[r][2 * s + 1][2], st[r][2 * s + 1][3]); pf[r] = mk8(pa, pb); } \
_Pragma("unroll") \
                for (int dt = 0; dt < 4; ++dt) { const u32x2 v0 = *(const u32x2*)(vb + (16 * dt + fr) * VP + 32 * s + 4 * fq), v1 = *(const u32x2*)(vb + (16 * dt + fr) * VP + 32 * s + 16 + 4 * fq); \
                    const bf16x8 vf = mk8(v0, v1); o[0][dt] = mfma16(vf, pf[0], o[0][dt]); o[1][dt] = mfma16(vf, pf[1], o[1][dt]); } \
            } \
        }
    u32x4 ak0, ak1 = {0u, 0u, 0u, 0u}, av, bk0, bk1 = {0u, 0u, 0u, 0u}, bv;
    ak0 = *(const u32x4*)kg0; if (has1) ak1 = *(const u32x4*)kg1; av = *(const u32x4*)vg;
    { bf16_t* kb = (bf16_t*)ldsg; bf16_t* vb = (bf16_t*)(ldsg + 2 * KB_BYTES);
      *(u32x4*)(kb + kl0) = ak0; if (has1) *(u32x4*)(kb + kl1) = ak1; *(u32x4*)(vb + vl) = av; }
    ak0 = *(const u32x4*)(kg0 + (size_t)64 * 768); if (has1) ak1 = *(const u32x4*)(kg1 + (size_t)64 * 768); av = *(const u32x4*)(vg + 64);
    asm volatile("s_waitcnt lgkmcnt(0)" ::: "memory"); __builtin_amdgcn_s_barrier(); asm volatile("" ::: "memory");
#define AT_STEP(JJ, LK0, LK1, LV, WK0, WK1, WV) { const int j = (JJ); \
        { const int jn = j + 2 < ntiles ? j + 2 : ntiles - 1; LK0 = *(const u32x4*)(kg0 + (size_t)jn * 64 * 768); if (has1) LK1 = *(const u32x4*)(kg1 + (size_t)jn * 64 * 768); LV = *(const u32x4*)(vg + jn * 64); } \
        AT_COMPUTE \
        { bf16_t* kb = (bf16_t*)(ldsg + ((j + 1) & 1) * KB_BYTES); bf16_t* vb = (bf16_t*)(ldsg + 2 * KB_BYTES + ((j + 1) & 1) * VB_BYTES); \
          *(u32x4*)(kb + kl0) = WK0; if (has1) *(u32x4*)(kb + kl1) = WK1; *(u32x4*)(vb + vl) = WV; } \
        asm volatile("s_waitcnt lgkmcnt(0)" ::: "memory"); __builtin_amdgcn_s_barrier(); asm volatile("" ::: "memory"); }
    for (int j2 = 0; j2 < ntiles; j2 += 2) {
        AT_STEP(j2, bk0, bk1, bv, ak0, ak1, av)
        AT_STEP(j2 + 1, ak0, ak1, av, bk0, bk1, bv)
    }
#undef AT_STEP
#undef AT_COMPUTE
#pragma unroll
    for (int r = 0; r < 2; ++r) { float lt = lrun[r]; lt += __shfl_xor(lt, 16); lt += __shfl_xor(lt, 32); const float inv = 1.f / lt;
#pragma unroll
        for (int dt = 0; dt < 4; ++dt) st_bf4(MIX + (size_t)(qrow0 + 16 * r) * 1024 + 512 + head * 64 + 16 * dt + 4 * fq, o[r][dt] * inv); }
}

__device__ __forceinline__ void attn_sample(const int wvs, unsigned char* ws, unsigned char* ldsg, int b, int head) {
    int tid_; asm volatile("v_mbcnt_lo_u32_b32 %0, -1, 0\n\tv_mbcnt_hi_u32_b32 %0, -1, %0" : "=v"(tid_)); tid_ += wvs * 64;
    const int lane = tid_ & 63, w = tid_ >> 6, fr = lane & 15, fq = lane >> 4, sub = w & 1, kq = w >> 1;
    const bf16_t* QF = (const bf16_t*)(ws + R_QF); const bf16_t* KF = (const bf16_t*)(ws + R_KF); const bf16_t* VT = (const bf16_t*)(ws + R_VT);
    const float* SSQN = (const float*)(ws + A_SSQN); const float* SSQR = (const float*)(ws + A_SSQR); bf16_t* MIX = (bf16_t*)(ws + R_MIX);
    constexpr int L = 1056;
    const int qrow = MP + b * 32 + sub * 16 + fr, kvrow0 = MP + b * L;
    const float nsm = -((const float*)(ws + A_CTL))[60];
    const float sc = rsqrtf((SSQN[(size_t)qrow * 8 + head] + SSQR[(size_t)qrow * 8 + head]) * (1.f / 96.f) + EPS) * (0.10206207261596575f * 1.4426950408889634f);
    bf16x8 qf[3];
#pragma unroll
    for (int ks = 0; ks < 3; ++ks) { const u32x4 qw = *(const u32x4*)(QF + (size_t)qrow * 768 + head * 96 + ks * 32 + fq * 8); u32x4 qs;
        qs.x = cvt_pk_bf16(__uint_as_float(qw.x << 16) * sc, __uint_as_float(qw.x & 0xffff0000u) * sc); qs.y = cvt_pk_bf16(__uint_as_float(qw.y << 16) * sc, __uint_as_float(qw.y & 0xffff0000u) * sc);
        qs.z = cvt_pk_bf16(__uint_as_float(qw.z << 16) * sc, __uint_as_float(qw.z & 0xffff0000u) * sc); qs.w = cvt_pk_bf16(__uint_as_float(qw.w << 16) * sc, __uint_as_float(qw.w & 0xffff0000u) * sc);
        qf[ks] = __builtin_bit_cast(bf16x8, qs); }
    f32x4 o[4]; float lsum = 0.f;
#pragma unroll
    for (int dt = 0; dt < 4; ++dt) o[dt] = (f32x4){0.f, 0.f, 0.f, 0.f};
    const int s0 = kq == 0 ? 0 : 9 + 8 * (kq - 1), s1 = 9 + 8 * kq;
    const bf16_t* kp = KF + (size_t)(kvrow0 + fr) * 768 + head * 96 + fq * 8;
    const bf16_t* vp = VT + (size_t)kvrow0 * 512 + (size_t)(head * 64 + fr) * L + 4 * fq;
    bf16x8 ka[2][3]; u32x2 va[4][2];
#define AS_LOAD(KA, VA, k0_) do { const int kx = (k0_); \
        _Pragma("unroll") for (int hf = 0; hf < 2; ++hf) _Pragma("unroll") for (int ks = 0; ks < 3; ++ks) KA[hf][ks] = *(const bf16x8*)(kp + (size_t)(kx + 16 * hf) * 768 + ks * 32); \
        _Pragma("unroll") for (int dt = 0; dt < 4; ++dt) _Pragma("unroll") for (int hf = 0; hf < 2; ++hf) VA[dt][hf] = *(const u32x2*)(vp + (size_t)dt * 16 * L + kx + 16 * hf); } while (0)
    AS_LOAD(ka, va, 32 * s0);
    for (int s = s0; s < s1; ++s) {
        bf16x8 kn[2][3]; u32x2 vn[4][2];
        AS_LOAD(kn, vn, 32 * (s + 1 < s1 ? s + 1 : s));
        f32x4 st[2];
#pragma unroll
        for (int hf = 0; hf < 2; ++hf) { st[hf] = (f32x4){nsm, nsm, nsm, nsm};
#pragma unroll
            for (int ks = 0; ks < 3; ++ks) st[hf] = mfma16(ka[hf][ks], qf[ks], st[hf]); }
#pragma unroll
        for (int hf = 0; hf < 2; ++hf)
#pragma unroll
            for (int j = 0; j < 4; ++j) { st[hf][j] = __builtin_amdgcn_exp2f(st[hf][j]); lsum += st[hf][j]; }
        u32x2 pa, pb; pa.x = cvt_pk_bf16(st[0][0], st[0][1]); pa.y = cvt_pk_bf16(st[0][2], st[0][3]); pb.x = cvt_pk_bf16(st[1][0], st[1][1]); pb.y = cvt_pk_bf16(st[1][2], st[1][3]);
        const bf16x8 pf = mk8(pa, pb);
#pragma unroll
        for (int dt = 0; dt < 4; ++dt) o[dt] = mfma16(mk8(va[dt][0], va[dt][1]), pf, o[dt]);
#pragma unroll
        for (int hf = 0; hf < 2; ++hf) {
#pragma unroll
            for (int ks = 0; ks < 3; ++ks) ka[hf][ks] = kn[hf][ks];
#pragma unroll
            for (int dt = 0; dt < 4; ++dt) va[dt][hf] = vn[dt][hf]; }
    }
#undef AS_LOAD
    float* part = (float*)ldsg + (size_t)(w * 64 + lane) * 17;
#pragma unroll
    for (int dt = 0; dt < 4; ++dt)
#pragma unroll
        for (int j = 0; j < 4; ++j) part[dt * 4 + j] = o[dt][j];
    part[16] = lsum;
    __syncthreads();
    if (kq == 0) {
#pragma unroll
        for (int q2 = 1; q2 < 4; ++q2) { const float* pp = (const float*)ldsg + (size_t)((sub + 2 * q2) * 64 + lane) * 17;
#pragma unroll
            for (int dt = 0; dt < 4; ++dt)
#pragma unroll
                for (int j = 0; j < 4; ++j) o[dt][j] += pp[dt * 4 + j];
            lsum += pp[16]; }
        lsum += __shfl_xor(lsum, 16); lsum += __shfl_xor(lsum, 32);
        const float inv = 1.f / lsum;
#pragma unroll
        for (int dt = 0; dt < 4; ++dt) st_bf4(MIX + (size_t)qrow * 1024 + 512 + head * 64 + 16 * dt + 4 * fq, o[dt] * inv);
    }
    __syncthreads();
}

struct OneUnit { int pm, pn; bool has;
    __device__ __forceinline__ bool next(int i, Unit& u) const { if (i != 0 || !has) return false; u.pm = pm; u.pn = pn; return true; }
    __device__ __forceinline__ void a_ready(const Unit&) const {}
    __device__ __forceinline__ void done(const Unit&) const {} };
struct EpiPart { static constexpr bool PERM = false, AFTER_DRAIN = false; float* P;
    __device__ __forceinline__ void operator()(const f32x4 (&acc)[2][2][4][2], const Unit& u, int wr, int wc, int fr, int fq) const {
        asm volatile("" : "+v"(fr), "+v"(fq));
        const int t = (wr * 4 + wc) * 64 + fq * 16 + fr;
#pragma unroll
        for (int ai = 0; ai < 2; ++ai)
#pragma unroll
            for (int bj = 0; bj < 2; ++bj)
#pragma unroll
                for (int m = 0; m < 4; ++m)
#pragma unroll
                    for (int n = 0; n < 2; ++n) *(f32x4*)(P + ((size_t)((((ai * 2 + bj) * 4 + m) * 2 + n) * 512 + t)) * 4) = acc[ai][bj][m][n];
    } };
__device__ __forceinline__ void res_gemm(const int wvs, LAS unsigned char* ldsl, const bf16_t* A, const bf16_t* Bt, int K, int KS, const EpiRes& E, float* part, unsigned* cnt, int G, int bid) {
    const int NS = K / KS, NSU = 16 * NS;
    if (G < NSU || G * 8 < 1024) {
        pg8::Gemm g{A, Bt, M, 1024, K}; pg8::StaticOrder S; S.init(M, 1024, G, bid); pg8::gemm_phase<EpiRes, pg8::StaticOrder, true, true>(ldsl, g, S, E, wvs); return; }
    { const int su = bid, unit = su / NS, sl = su - unit * NS;
      pg8::Gemm g{A + (size_t)MP * K + (size_t)sl * KS, Bt + (size_t)sl * KS, MS, 1024, K, KS}; OneUnit S{unit >> 2, unit & 3, su < NSU};
      EpiPart EP{part + (size_t)su * 65536};
      pg8::gemm_phase<EpiPart, OneUnit, false, true>(ldsl, g, S, EP, wvs);
      int tid_; asm volatile("v_mbcnt_lo_u32_b32 %0, -1, 0\n\tv_mbcnt_hi_u32_b32 %0, -1, %0" : "=v"(tid_)); tid_ += wvs * 64;
      if (su < NSU) { asm volatile("s_waitcnt vmcnt(0)" ::: "memory"); __syncthreads();
          if (tid_ == 0) { __builtin_amdgcn_fence(__ATOMIC_RELEASE, "agent"); asm volatile("s_waitcnt vmcnt(0)" ::: "memory"); __hip_atomic_fetch_add(cnt, 1u, __ATOMIC_RELAXED, __HIP_MEMORY_SCOPE_AGENT); } } }
    { pg8::Gemm g{A, Bt, MP, 1024, K}; pg8::StaticOrder S; S.init(MP, 1024, G, bid); pg8::gemm_phase<EpiRes, pg8::StaticOrder, true, true>(ldsl, g, S, E, wvs); }
    { int lane_; asm volatile("v_mbcnt_lo_u32_b32 %0, -1, 0\n\tv_mbcnt_hi_u32_b32 %0, -1, %0" : "=v"(lane_));
      const int gw = bid * 8 + wvs;
      if (gw < 1024) {
          if (lane_ == 0) { while (__hip_atomic_load(cnt, __ATOMIC_RELAXED, __HIP_MEMORY_SCOPE_AGENT) < (unsigned)NSU) __builtin_amdgcn_s_sleep(2); }
          __builtin_amdgcn_fence(__ATOMIC_ACQUIRE, "agent"); asm volatile("s_waitcnt vmcnt(0)" ::: "memory");
          const int unit = gw >> 6, am = (gw >> 3) & 7, wv = gw & 7, ai = am >> 2, m = am & 3, t = wv * 64 + lane_, wr = wv >> 2, wc = wv & 3, fr = lane_ & 15, fq = lane_ >> 4;
          f32x4 v[2][2];
#pragma unroll
          for (int bj = 0; bj < 2; ++bj)
#pragma unroll
              for (int n = 0; n < 2; ++n) v[bj][n] = (f32x4){0.f, 0.f, 0.f, 0.f};
#pragma unroll 4
          for (int s = 0; s < NS; ++s) { const float* P = part + (size_t)(unit * NS + s) * 65536;
#pragma unroll
              for (int bj = 0; bj < 2; ++bj)
#pragma unroll
                  for (int n = 0; n < 2; ++n) v[bj][n] += *(const f32x4*)(P + ((size_t)((((ai * 2 + bj) * 4 + m) * 2 + n) * 512 + t)) * 4); }
          E.do_row((128 + (unit >> 2)) * 256 + ai * 128 + wr * 64 + m * 16 + fr, unit & 3, wc, fq, v[0][0], v[0][1], v[1][0], v[1][1]);
      } }
}

__device__ __forceinline__ void grid_bar(unsigned* ctl, unsigned k, const int wvs) {
    int tid_; asm volatile("v_mbcnt_lo_u32_b32 %0, -1, 0\n\tv_mbcnt_hi_u32_b32 %0, -1, %0" : "=v"(tid_)); tid_ += wvs * 64;
    asm volatile("s_waitcnt vmcnt(0) lgkmcnt(0)" ::: "memory");
    __syncthreads();
    if (tid_ == 0) {
        const unsigned G = gridDim.x;
        __builtin_amdgcn_fence(__ATOMIC_RELEASE, "agent");
        asm volatile("s_waitcnt vmcnt(0)" ::: "memory");
        if ((G & 7u) == 0u) {
            const unsigned x = blockIdx.x & 7u, gs = G >> 3; unsigned* arr = ctl + 256 + 64 * x; unsigned* rel = ctl + 1024 + 64 * x; unsigned* top = ctl + 128;
            const unsigned old = __hip_atomic_fetch_add(arr, 1u, __ATOMIC_RELAXED, __HIP_MEMORY_SCOPE_AGENT);
            if (old + 1u == gs * k) {
                __hip_atomic_fetch_add(top, 1u, __ATOMIC_RELAXED, __HIP_MEMORY_SCOPE_AGENT);
                while (__hip_atomic_load(top, __ATOMIC_RELAXED, __HIP_MEMORY_SCOPE_AGENT) < 8u * k) __builtin_amdgcn_s_sleep(1);
                __hip_atomic_fetch_add(rel, 1u, __ATOMIC_RELAXED, __HIP_MEMORY_SCOPE_AGENT);
            } else { while (__hip_atomic_load(rel, __ATOMIC_RELAXED, __HIP_MEMORY_SCOPE_AGENT) < k) __builtin_amdgcn_s_sleep(1); }
        } else {
            __hip_atomic_fetch_add(ctl, 1u, __ATOMIC_RELAXED, __HIP_MEMORY_SCOPE_AGENT);
            while (__hip_atomic_load(ctl, __ATOMIC_RELAXED, __HIP_MEMORY_SCOPE_AGENT) < G * k) __builtin_amdgcn_s_sleep(2);
        }
        __builtin_amdgcn_fence(__ATOMIC_ACQUIRE, "agent");
        asm volatile("s_waitcnt vmcnt(0)" ::: "memory");
    }
    __syncthreads();
}

#define XB_TMO      128
#define XB_XCNT(j)  (256  + 64 * (j))
#define XB_XSUB(j)  (1280 + 64 * (j))
#define XB_XGEN(j)  (2304 + 64 * (j))
#define XB_TOP      3328
#define XB_TOPGEN   3392
#define XCD_BAR_WORDS 3456
#define XB_SPIN_CAP (1u << 18)

__device__ __forceinline__ unsigned xb_ld(unsigned* p)              { return __hip_atomic_load(p, __ATOMIC_RELAXED, __HIP_MEMORY_SCOPE_AGENT); }
__device__ __forceinline__ unsigned xb_add(unsigned* p, unsigned v) { return __hip_atomic_fetch_add(p, v, __ATOMIC_RELAXED, __HIP_MEMORY_SCOPE_AGENT); }
__device__ __forceinline__ unsigned xb_xcc_id() { return (unsigned)__builtin_amdgcn_s_getreg((3 << 11) | 20) & 0xFu; }
#define XB_SPIN(cond, bar) do { unsigned _sp = 0; while (cond) { __builtin_amdgcn_s_sleep(1); \
    if ((++_sp & 255u) == 0u) { if (xb_ld(&(bar)[XB_TMO])) break; if (_sp > XB_SPIN_CAP) { atomicAdd(&(bar)[XB_TMO], 1u); break; } } } } while (0)

struct XcdBarrier {
    unsigned* bar; unsigned x;
    volatile LAS unsigned* st;
};

__device__ __forceinline__ XcdBarrier xcd_barrier_post(unsigned* bar, volatile LAS unsigned* st, const bool is_t0) {
    XcdBarrier b; b.bar = bar; b.x = xb_xcc_id(); b.st = st;
    if (is_t0) (void)xb_add(&bar[XB_XCNT(b.x)], 1u);
    return b;
}
__device__ __forceinline__ void xcd_barrier_complete(unsigned* bar, unsigned x, unsigned& nloc, unsigned& nx) {
    const unsigned G = gridDim.x * gridDim.y * gridDim.z;
    unsigned sum, cnt, mine, sp = 0u;
    for (;;) {
        sum = 0u; cnt = 0u; mine = 0u;
#pragma unroll
        for (unsigned j = 0; j < 16; ++j) { const unsigned c = xb_ld(&bar[XB_XCNT(j)]); sum += c; cnt += (c > 0u) ? 1u : 0u; mine = (j == x) ? c : mine; }
        if (sum == G) break;
        __builtin_amdgcn_s_sleep(1);
        if ((++sp & 255u) == 0u) { if (xb_ld(&bar[XB_TMO])) break; if (sp > XB_SPIN_CAP) { atomicAdd(&bar[XB_TMO], 1u); break; } }
    }
    nloc = mine > 0u ? mine : 1u; nx = cnt > 0u ? cnt : 1u;
}

__device__ __forceinline__ void xcd_barrier(const XcdBarrier& b, const int wvs) {
    int tid_; asm volatile("v_mbcnt_lo_u32_b32 %0, -1, 0\n\tv_mbcnt_hi_u32_b32 %0, -1, %0" : "=v"(tid_)); tid_ += wvs * 64;
    asm volatile("s_waitcnt vmcnt(0)" ::: "memory");
    __syncthreads();
    if (tid_ == 0) {
        unsigned* bar = b.bar;
        __builtin_amdgcn_s_waitcnt(0);
        unsigned nloc = b.st[0], nx = b.st[1];
        if (nloc == 0u) { xcd_barrier_complete(bar, b.x, nloc, nx); b.st[0] = nloc; b.st[1] = nx; }
        const unsigned old = xb_add(&bar[XB_XSUB(b.x)], 1u);
        const unsigned gen = old / nloc;
        if (old + 1u == (gen + 1u) * nloc) {
            __builtin_amdgcn_fence(__ATOMIC_RELEASE, "agent");
            asm volatile("s_waitcnt vmcnt(0)" ::: "memory");
            const unsigned og = xb_add(&bar[XB_TOP], 1u);
            const unsigned tg = og / nx;
            if (og + 1u == (tg + 1u) * nx) xb_add(&bar[XB_TOPGEN], 1u);
            else XB_SPIN(xb_ld(&bar[XB_TOPGEN]) == tg, bar);
            __builtin_amdgcn_fence(__ATOMIC_ACQUIRE, "agent");
            xb_add(&bar[XB_XGEN(b.x)], 1u);
            asm volatile("s_waitcnt vmcnt(0)" ::: "memory");
        } else {
            XB_SPIN(xb_ld(&bar[XB_XGEN(b.x)]) == gen, bar);
            __builtin_amdgcn_fence(__ATOMIC_ACQUIRE, "agent");
            asm volatile("s_waitcnt vmcnt(0)" ::: "memory");
        }
    }
    __syncthreads();
}

__global__ void __launch_bounds__(512, 2) mk_fwd(Args args) {
    extern __shared__ __attribute__((aligned(16))) unsigned char lds[];
    const int wvs = __builtin_amdgcn_readfirstlane((int)threadIdx.x >> 6);
    if (threadIdx.x < 8) ((LAS unsigned*)((LAS unsigned char*)lds + 131072))[threadIdx.x] = 0u;
    __syncthreads();
    const XcdBarrier xbar = xcd_barrier_post((unsigned*)(args.ws + A_CTL), (volatile LAS unsigned*)((LAS unsigned char*)lds + 131072), threadIdx.x == 0);
    const int lo = args.ph_lo, hi = args.ph_hi;
#if MK_PER_PHASE
#define SEAM(k) do { } while (0)
#else
#define SEAM(k) do { if (lo <= (k) && (k) + 1 < hi) { if ((k) == 0) cg::this_grid().sync(); else { xcd_barrier(xbar, wvs); } } } while (0)
#endif
#define IN(k) (lo <= (k) && (k) < hi)
#define PH_VARS size_t zoff_ = 0; asm volatile("" : "+s"(zoff_)); unsigned char* ws = args.ws + zoff_; float* out = args.out + zoff_; \
    LAS unsigned char* ldsl = (LAS unsigned char*)lds; const int bid = blockIdx.x, G = gridDim.x; \
    bf16_t* XB = (bf16_t*)(ws + A_XB); float* SSQ = (float*)(ws + A_SSQ); bf16_t* ACT = (bf16_t*)(ws + R_ACT); bf16_t* MIX = (bf16_t*)(ws + R_MIX); float* Y = out + OUT_Y; \
    (void)XB; (void)SSQ; (void)ACT; (void)MIX; (void)Y; (void)ldsl; (void)bid; (void)G;
#define PH_TID int tid_; asm volatile("v_mbcnt_lo_u32_b32 %0, -1, 0\n\tv_mbcnt_hi_u32_b32 %0, -1, %0" : "=v"(tid_)); tid_ += wvs * 64; const int lane = tid_ & 63, wave = tid_ >> 6; (void)lane; (void)wave;

    if (IN(0)) for (int rep_ = 0; rep_ < (REP_PH == 0 ? 2 : 1); ++rep_) { PH_VARS prologue(args, ldsl, G, wvs); } SEAM(0);

#define HOST_ITEMS(set, nset, first_idle) do { if (G == 256 && bid >= (first_idle)) { PH_TID \
        for (int idx = (bid - (first_idle)) * 8 + wave; idx < (nset); idx += (256 - (first_idle)) * 8) weight_item(args, ws, item_of((set), idx), (LAS float*)(ldsl + wave * 16384), lane); } } while (0)
#define FFN_UP(ph, widx) if (IN(ph)) for (int rep_ = 0; rep_ < (REP_PH == (ph) ? 2 : 1); ++rep_) { PH_VARS pg8::Gemm g{XB, (const bf16_t*)(ws + W_GU0 + (size_t)(widx) * SZ_GU), M, 5632, 1024}; pg8::StaticOrder S; S.init(M, 5632, G, bid); \
        EpiGU E{SSQ, ACT}; pg8::gemm_phase<EpiGU, pg8::StaticOrder, true, true>(ldsl, g, S, E, wvs); \
        if ((ph) == 1) HOST_ITEMS(1, NIT_B1, 88); if ((ph) == 7) HOST_ITEMS(3, NIT_B3, 88); } SEAM(ph);
#define FFN_DN(ph, widx, x0, x1) if (IN(ph)) for (int rep_ = 0; rep_ < (REP_PH == (ph) ? 2 : 1); ++rep_) { PH_VARS \
        EpiRes E{x0, x1, Y, XB, SSQ, 0.5f}; res_gemm(wvs, ldsl, ACT, (const bf16_t*)(ws + W_DN0 + (size_t)(widx) * SZ_DN), FF, 256, E, (float*)(ws + R_PART), (unsigned*)(ws + A_CTL) + 8 + (ph), G, bid); } SEAM(ph);
#define MIX_OUT(ph, woff) if (IN(ph)) { PH_VARS \
        EpiRes E{Y, Y + (size_t)MP * D, Y, XB, SSQ, 1.0f}; res_gemm(wvs, ldsl, MIX, (const bf16_t*)(ws + (woff)), 1024, 256, E, (float*)(ws + R_PART), (unsigned*)(ws + A_CTL) + 8 + (ph), G, bid); } SEAM(ph);

    FFN_UP(1, 0)
    FFN_DN(2, 0, gp(args.in[0]), gp(args.in[1]))
    if (IN(3)) { PH_VARS pg8::Gemm g{XB, (const bf16_t*)(ws + W_AB), M, 2560, 1024}; pg8::StaticOrder S; S.init(M, 2560, G, bid);
        EpiAB E{SSQ, (const float*)(ws + T_LB), (bf16_t*)(ws + R_QT), (bf16_t*)(ws + R_KH), (bf16_t*)(ws + R_KTT), (bf16_t*)(ws + R_VTT), (bf16_t*)(ws + R_GB), (bf16_t*)(ws + R_UB), (float*)(ws + R_LDEC)};
        pg8::gemm_phase<EpiAB, pg8::StaticOrder, true, true>(ldsl, g, S, E, wvs); HOST_ITEMS(2, NIT_B2, 40); } SEAM(3);
    if (IN(4)) for (int rep_ = 0; rep_ < (REP_PH == 4 ? 2 : 1); ++rep_) { PH_VARS PH_TID
        for (int task = bid; task < 256; task += G) {
            if (task < 128) {
                { const int b = task >> 2, h = task & 3; hgrn_task(wvs, ws, lds, MP + b * 32, 2, gp(args.in[2]) + (size_t)(b * 4 + h) * 16384, out + OUT_HGRN_S + (size_t)(b * 4 + h) * 16384, h); }
                { const int id = task * 8 + wave, b = id >> 5, g = id & 31; s5_task(wvs, ws, lds + wave * 16384, gp(args.in[26]), MP + b * 32, 2, gp(args.in[3]) + (size_t)(b * 32 + g) * 64, gp(args.in[4]) + (size_t)(b * 32 + g) * 64,
                          out + OUT_S5RE_S + (size_t)(b * 32 + g) * 64, out + OUT_S5IM_S + (size_t)(b * 32 + g) * 64, g); }
                __syncthreads();
            } else if (task < 192) {
                const int i = task - 128, b = i >> 2, h = i & 3; for (int r2 = 0; r2 < (REP_PH == 40 ? 2 : 1); ++r2) hgrn_prompt(wvs, ws, lds, b * 2048, out + OUT_HGRN_P + (size_t)(b * 4 + h) * 16384, h);
            } else {
                if (wave < 4) { const int id = (task - 192) * 4 + wave, b = id >> 5, g = id & 31; for (int r2 = 0; r2 < (REP_PH == 41 ? 2 : 1); ++r2) s5_task(wvs, ws, lds + wave * 16384, gp(args.in[26]), b * 2048, 128, nullptr, nullptr, out + OUT_S5RE_P + (size_t)(b * 32 + g) * 64, out + OUT_S5IM_P + (size_t)(b * 32 + g) * 64, g); }
                __syncthreads();
            }
            if (task < 64 && G == 256) {
                if (wave < 4) { const int id = 256 + task * 4 + wave, b = id >> 5, g = id & 31; s5_task(wvs, ws, lds + wave * 16384, gp(args.in[26]), b * 2048, 128, nullptr, nullptr, out + OUT_S5RE_P + (size_t)(b * 32 + g) * 64, out + OUT_S5IM_P + (size_t)(b * 32 + g) * 64, g); }
                __syncthreads();
            }
        }
        if (G != 256) {
            for (int t2 = bid; t2 < 64; t2 += G) { if (wave < 4) { const int id = 256 + t2 * 4 + wave, b = id >> 5, g = id & 31; s5_task(wvs, ws, lds + wave * 16384, gp(args.in[26]), b * 2048, 128, nullptr, nullptr, out + OUT_S5RE_P + (size_t)(b * 32 + g) * 64, out + OUT_S5IM_P + (size_t)(b * 32 + g) * 64, g); } __syncthreads(); }
        }
    } SEAM(4);
    if (IN(5)) { PH_VARS
        { pg8::Gemm g{(const bf16_t*)(ws + R_ZB), (const bf16_t*)(ws + W_GLU), M, 512, 512}; pg8::StaticOrder S; S.init(M, 512, G, bid);
          EpiGLU E{(const bf16_t*)(ws + R_ZB), gp(args.in[28]), MIX}; pg8::gemm_phase<EpiGLU, pg8::StaticOrder, true, true>(ldsl, g, S, E, wvs); }
        PH_TID
        const bf16_t* OB = (const bf16_t*)(ws + R_OB); const bf16_t* GB = (const bf16_t*)(ws + R_GB);
        const f32x4 og0 = *(const f32x4*)(gp(args.in[18]) + (lane & 15) * 8), og1 = *(const f32x4*)(gp(args.in[18]) + (lane & 15) * 8 + 4);
        const int nx5 = (264 > G && 264 - G < G / 2) ? 264 - G : 0;
        for (int row = (bid - nx5) * 8 + wave; row < M; row += (G - nx5) * 8) { if (bid < nx5) break;
            const u32x4 ov = *(const u32x4*)(OB + (size_t)row * 512 + lane * 8), gv = *(const u32x4*)(GB + (size_t)row * 512 + lane * 8);
            f32x4 a0, a1, g0, g1;
            a0.x = __uint_as_float(ov.x << 16); a0.y = __uint_as_float(ov.x & 0xffff0000u); a0.z = __uint_as_float(ov.y << 16); a0.w = __uint_as_float(ov.y & 0xffff0000u);
            a1.x = __uint_as_float(ov.z << 16); a1.y = __uint_as_float(ov.z & 0xffff0000u); a1.z = __uint_as_float(ov.w << 16); a1.w = __uint_as_float(ov.w & 0xffff0000u);
            g0.x = __uint_as_float(gv.x << 16); g0.y = __uint_as_float(gv.x & 0xffff0000u); g0.z = __uint_as_float(gv.y << 16); g0.w = __uint_as_float(gv.y & 0xffff0000u);
            g1.x = __uint_as_float(gv.z << 16); g1.y = __uint_as_float(gv.z & 0xffff0000u); g1.z = __uint_as_float(gv.w << 16); g1.w = __uint_as_float(gv.w & 0xffff0000u);
            float ss = sum4(a0 * a0) + sum4(a1 * a1);
            ss += __shfl_xor(ss, 1); ss += __shfl_xor(ss, 2); ss += __shfl_xor(ss, 4); ss += __shfl_xor(ss, 8);
            const float rs = rsqrtf(ss * (1.f / 128.f) + EPS);
            const f32x4 r0 = a0 * rs * og0 * g0, r1 = a1 * rs * og1 * g1;
            u32x4 w4; w4.x = cvt_pk_bf16(r0.x, r0.y); w4.y = cvt_pk_bf16(r0.z, r0.w); w4.z = cvt_pk_bf16(r1.x, r1.y); w4.w = cvt_pk_bf16(r1.z, r1.w);
            *(u32x4*)(MIX + (size_t)row * 1024 + lane * 8) = w4;
        }
    } SEAM(5);
    MIX_OUT(6, W_ABO)
    FFN_UP(7, 1)
    FFN_DN(8, 1, Y, Y + (size_t)MP * D)
    FFN_UP(9, 2)
    FFN_DN(10, 2, Y, Y + (size_t)MP * D)
    if (IN(11)) { PH_VARS pg8::Gemm g{XB, (const bf16_t*)(ws + W_CD), M, 1536, 1024}; pg8::StaticOrder S; S.init(M, 1536, G, bid);
        EpiCD E{SSQ, gp(args.in[31]), gp(args.in[36]), (const f32x2*)(ws + T_ROPE), MIX, (bf16_t*)(ws + R_VG), (float*)(ws + A_SSV), (bf16_t*)(ws + R_CQB), (float*)(ws + A_SSCQ), (bf16_t*)(ws + R_CKVG), (float*)(ws + A_SSCKV), (float*)(ws + R_KPEB), (float*)(ws + A_SSK), out};
        pg8::gemm_phase<EpiCD, pg8::StaticOrder, true, true>(ldsl, g, S, E, wvs);
        PH_TID
        bf16_t* CKVG = (bf16_t*)(ws + R_CKVG); float* KPEB = (float*)(ws + R_KPEB); float* SSK = (float*)(ws + A_SSK);
        const int nx11 = (792 % G != 0 && 792 % G < G / 2) ? 792 % G : 0;
        for (int r = (bid - nx11) * 8 + wave; r < 32 * 1024; r += (G - nx11) * 8) { if (bid < nx11) break; const int b = r >> 10, j = r & 1023, kvr = MP + b * 1056 + j;
            const f32x2 c2 = *(const f32x2*)(gp(args.in[5]) + (size_t)r * 128 + lane * 2); ((unsigned*)(CKVG + (size_t)kvr * 128))[lane] = cvt_pk_bf16(c2.x, c2.y);
            float kv = 0.f; if (lane < 32) { kv = gp(args.in[6])[(size_t)r * 32 + lane]; KPEB[(size_t)kvr * 32 + lane] = kv; }
            float ss = kv * kv;
#pragma unroll
            for (int o = 1; o < 64; o <<= 1) ss += __shfl_xor(ss, o);
            if (lane == 0) SSK[kvr] = ss; }
    } SEAM(11);
    if (IN(12)) { PH_VARS
        { pg8::Gemm g{(const bf16_t*)(ws + R_CQB), (const bf16_t*)(ws + W_UQ), M, 768, 256}; pg8::StaticOrder S; S.init(M, 768, G, bid);
          EpiQ E{(const float*)(ws + A_SSCQ), gp(args.in[38]), (const f32x2*)(ws + T_ROPE), (bf16_t*)(ws + R_QF), (float*)(ws + A_SSQN), (float*)(ws + A_SSQR)};
          pg8::gemm_phase<EpiQ, pg8::StaticOrder, true, true>(ldsl, g, S, E, wvs); }
        { pg8::Gemm g{(const bf16_t*)(ws + R_CKVG), (const bf16_t*)(ws + W_UKV), KVR, 1024, 128}; const int nq2 = (396 > G && 396 - G < G) ? 396 - G : 0;
          pg8::StaticOrder S; S.init(KVR, 1024, G, (bid + G - nq2) % G);
          EpiKV E{(const float*)(ws + A_SSCKV), (const float*)(ws + A_SSK), (const float*)(ws + R_KPEB), gp(args.in[39]), (bf16_t*)(ws + R_KF), (bf16_t*)(ws + R_VT)};
          pg8::gemm_phase<EpiKV, pg8::StaticOrder, true, true>(ldsl, g, S, E, wvs); }
        PH_TID
        const float* SSCKV = (const float*)(ws + A_SSCKV);
        const int nx12 = (396 > G && 396 - G < G && (396 - G) % 8 == 0 && G - (396 - G) >= 32) ? 396 - G + 16 : 0;
        for (int row = (bid - nx12) * 8 + wave; row < M; row += (G - nx12) * 8) { if (bid < nx12) break; const float rs = rsqrtf(sum4(*(const f32x4*)(SSCKV + (size_t)row * 4)) * (1.f / 128.f) + EPS);
            float* p = row < MP ? out + OUT_CKV_P + (size_t)row * 128 : out + OUT_CKV_S + (size_t)(row - MP) * 128; f32x2 v = *(f32x2*)(p + lane * 2); v.x *= rs; v.y *= rs; *(f32x2*)(p + lane * 2) = v; }
    } SEAM(12);
    if (IN(13)) { PH_VARS PH_TID
        for (int un = bid; un < 1024 + 128; un += G) {
            if (un < 1024) { const int gg = un & 3, ch = (un >> 2) & 15, b = un >> 6; spatial_unit(wvs, args, lds, b * 2048 + ch * 128, 128, gg, ch == 15 ? out + OUT_GV_P + (size_t)b * 128 * 512 : nullptr); }
            else { const int i = un - 1024, gg = i & 3, b = i >> 2; spatial_unit(wvs, args, lds, MP + b * 32, 32, gg, out + OUT_GV_S + (size_t)b * 32 * 512); }
        }
        const int gw = bid * 8 + wave, NGW = G * 8;
        for (int rep_ = 0; rep_ < (REP_PH == 13 ? 2 : 1); ++rep_) {
        if ((G & 7) == 0) { const int x = bid & 7, y = bid >> 3, PW = G >> 3;
            for (int slot = y; slot < 64; slot += PW) { const int combo = x * 16 + (slot >> 2), qbl = slot & 3, b = combo >> 3, head = combo & 7;
                attn_unit2(wvs, ws, lds, b, head, qbl); attn_unit2(wvs, ws, lds, b, head, 7 - qbl); } }
        else { for (int pu = bid; pu < 512; pu += G) { const int qbl = pu & 3, head = (pu >> 2) & 7, b = pu >> 5; attn_unit2(wvs, ws, lds, b, head, qbl); attn_unit2(wvs, ws, lds, b, head, 7 - qbl); } }
        for (int r3 = 0; r3 < (REP_PH == 14 ? 2 : 1); ++r3) for (int t = bid; t < 256; t += G) attn_sample(wvs, ws, lds, t >> 3, t & 7);
        }
    } SEAM(13);
    MIX_OUT(14, W_CDO)
    FFN_UP(15, 3)
    FFN_DN(16, 3, Y, Y + (size_t)MP * D)
}

extern "C" void kernel_launch(void* const* d_in, const int* in_sizes, int n_in, void* d_out, int out_size, void* d_ws, size_t ws_size, hipStream_t stream) {
    static int grid = 0;
    if (grid == 0) {
        if (n_in != 41 || (size_t)out_size != OUT_TOTAL || ws_size < WS_END) { fprintf(stderr, "kernel_launch: unexpected shapes: n_in %d out %d ws %zu (need %zu)\n", n_in, out_size, ws_size, (size_t)WS_END); grid = -1; return; }
        int dev = 0, cus = 0, per_cu = 0;
        hipGetDevice(&dev); hipDeviceGetAttribute(&cus, hipDeviceAttributeMultiprocessorCount, dev);
        hipFuncSetAttribute((const void*)mk_fwd, hipFuncAttributeMaxDynamicSharedMemorySize, LDS_BYTES);
        hipOccupancyMaxActiveBlocksPerMultiprocessor(&per_cu, (const void*)mk_fwd, 512, LDS_BYTES);
        if (per_cu < 1) { fprintf(stderr, "kernel_launch: occupancy query says %d blocks per CU\n", per_cu); per_cu = 1; }
        (void)hipGetLastError();
        grid = cus * 1;
    }
    if (grid < 0) return;
    Args a{};
    for (int i = 0; i < 41; ++i) a.in[i] = (const float*)d_in[i];
    a.out = (float*)d_out; a.ws = (unsigned char*)d_ws;
#if MK_PER_PHASE
    for (int ph = 0; ph < NPH; ++ph) { a.ph_lo = ph; a.ph_hi = ph + 1; hipLaunchKernelGGL(mk_fwd, dim3(grid), dim3(512), LDS_BYTES, stream, a); }
#else
    a.ph_lo = 0; a.ph_hi = NPH;
    hipMemsetAsync((unsigned char*)d_ws + A_CTL, 0, 16384, stream);
    void* kargs[] = {&a};
    hipError_t e = hipLaunchCooperativeKernel((const void*)mk_fwd, dim3(grid), dim3(512), kargs, LDS_BYTES, stream);
    if (e != hipSuccess) fprintf(stderr, "kernel_launch: cooperative launch failed: %s (grid %d)\n", hipGetErrorString(e), grid);
#endif
}
```

```cpp
#include <hip/hip_runtime.h>
#include <hip/hip_cooperative_groups.h>
#include <cstdio>
#include <cstdint>
namespace cg = cooperative_groups;
namespace pg8 {
#define PG8_LAS __attribute__((address_space(3)))
typedef unsigned short bf16_t;
typedef short bf16x8 __attribute__((ext_vector_type(8)));
typedef float f32x4 __attribute__((ext_vector_type(4)));
typedef unsigned u32x4 __attribute__((ext_vector_type(4)));
constexpr int BM = 256, BK = 64, HALF = 128, HTB = HALF * BK * 2  , STAGE_BYTES = 8 * HTB, NXCD = 8, WGM = 8;

__host__ __device__ __forceinline__ int lds_byte(int r, int c) { const int st = (r >> 4) * 2 + (c >> 5), rr = r & 15, cc = c & 31, ob = rr * 64 + cc * 2; return st * 1024 + (ob ^ (((ob >> 9) & 1) << 5)); }
__host__ __device__ __forceinline__ void stage_rc(int b, int& R, int& C) { const int st = b / 1024, sb = b % 1024, swz = sb ^ (((sb >> 9) & 1) << 5); R = (st >> 1) * 16 + swz / 64; C = (st & 1) * 32 + (swz % 64) / 2; }
__host__ __device__ __forceinline__ int perm32(int rho) { const int n = rho >> 4, i = rho & 15; return 8 * (i >> 2) + 4 * n + (i & 3); }

struct Unit { int pm, pn; };
struct Gemm { const bf16_t* A; const bf16_t* Bt; int M, N, K; int Kl = 0; };

struct StaticOrder {
    int nM, nN, nwg, G, c;
    __host__ __device__ void init(int M, int N, int G_, int c_) { nM = M / BM; nN = N / BM; nwg = nM * nN; G = G_; c = c_; }
    __host__ __device__ bool next(int i, Unit& u) const {
        const long L = (long)i * G + c; if (L >= nwg) return false;
        int wgid = (int)L; { const int q = nwg / NXCD, r = nwg % NXCD, xcd = wgid % NXCD, off = wgid / NXCD; wgid = (xcd < r ? xcd * (q + 1) : r * (q + 1) + (xcd - r) * q) + off; }
        const int nig = WGM * nN, gid = wgid / nig, fm = gid * WGM, gsz = (nM - fm) < WGM ? (nM - fm) : WGM;
        u.pm = fm + ((wgid % nig) % gsz); u.pn = (wgid % nig) / gsz; return true;
    }
    __device__ __forceinline__ void a_ready(const Unit&) const {}
    __device__ __forceinline__ void done(const Unit&) const {}
};

typedef __bf16 bf16x2_cv __attribute__((ext_vector_type(2))); typedef float f32x2_cv __attribute__((ext_vector_type(2)));
__device__ __forceinline__ unsigned cvt_pk_bf16(float lo, float hi) { const f32x2_cv v = {lo, hi}; const bf16x2_cv b = __builtin_convertvector(v, bf16x2_cv); return __builtin_bit_cast(unsigned, b); }

template <class Epi, class Sched, bool ALIGN_EPI = false, bool SP2 = false>
__device__ __forceinline__ void gemm_phase(PG8_LAS unsigned char* lds, const Gemm g, const Sched& S, const Epi& E, const int wvs) {
    int tid_; asm volatile("v_mbcnt_lo_u32_b32 %0, -1, 0\n\tv_mbcnt_hi_u32_b32 %0, -1, %0" : "=v"(tid_)); tid_ += wvs * 64;
    const int tid = tid_, wid = __builtin_amdgcn_readfirstlane(tid >> 6), lane = tid & 63, wr = wid >> 2, wc = wid & 3, fr = lane & 15, fq = lane >> 4;
    const int K = g.K, nt = (g.Kl ? g.Kl : K) / BK;
    unsigned voffA[2], voffB[2];
#pragma unroll
    for (int i = 0; i < 2; ++i) { int R, C; stage_rc(tid * 16 + i * 8192, R, C); const int Rb = Epi::PERM ? ((R & ~31) + perm32(R & 31)) : R;
        voffA[i] = (unsigned)(R * K + C) * 2u; voffB[i] = (unsigned)(Rb * K + C) * 2u; }
    const size_t kstep = (size_t)(BK * 2);
    const size_t hstep = (size_t)HALF * K * 2;
    const size_t tstep = 2 * hstep;
    const unsigned ldsw = (unsigned)wid * 1024u;
    const int aoff = lds_byte(wr * 64 + fr, fq * 8), boff = lds_byte(wc * 32 + fr, fq * 8);
#define PG8_SA(b, h) (((b) * 2 + (h)) * HTB)
#define PG8_SB(b, h) ((4 + (b) * 2 + (h)) * HTB)
#define PG8_STAGE(bufoff, gbase, voff) do { _Pragma("unroll") for (int _i = 0; _i < 2; ++_i) \
        __builtin_amdgcn_global_load_lds((const unsigned*)((const char*)(gbase) + (voff)[_i]), (PG8_LAS unsigned*)(lds + (bufoff) + ldsw + _i * 8192), 16, 0, 0); } while (0)
#define PG8_LDA(dst, b, h) do { _Pragma("unroll") for (int m = 0; m < 4; ++m) _Pragma("unroll") for (int k = 0; k < 2; ++k) dst[m][k] = *(const PG8_LAS bf16x8*)(lds + PG8_SA(b, h) + aoff + m * 2048 + k * 1024); } while (0)
#define PG8_LDB(dst, b, h) do { _Pragma("unroll") for (int n = 0; n < 2; ++n) _Pragma("unroll") for (int k = 0; k < 2; ++k) dst[n][k] = *(const PG8_LAS bf16x8*)(lds + PG8_SB(b, h) + boff + n * 2048 + k * 1024); } while (0)
#define PG8_MMA(ai, bj, At, Bt) do { __builtin_amdgcn_s_setprio(1); _Pragma("unroll") for (int m = 0; m < 4; ++m) _Pragma("unroll") for (int n = 0; n < 2; ++n) _Pragma("unroll") for (int k = 0; k < 2; ++k) \
        acc[ai][bj][m][n] = __builtin_amdgcn_mfma_f32_16x16x32_bf16(Bt[n][k], At[m][k], acc[ai][bj][m][n], 0, 0, 0); __builtin_amdgcn_s_setprio(0); } while (0)
#define PG8_WAIT_V(n) asm volatile("s_waitcnt vmcnt(" #n ")" ::: "memory")
#define PG8_WAIT_L(n) asm volatile("s_waitcnt lgkmcnt(" #n ")" ::: "memory")
#define PG8_BAR __builtin_amdgcn_s_barrier()
#define PG8_SCHED __builtin_amdgcn_sched_barrier(0)
    Unit cur, nxt; int ui = 0;
    if (!S.next(0, cur)) return;
    f32x4 acc[2][2][4][2];
#pragma unroll
    for (int a = 0; a < 2; ++a)
#pragma unroll
        for (int b = 0; b < 2; ++b)
#pragma unroll
            for (int m = 0; m < 4; ++m)
#pragma unroll
                for (int n = 0; n < 2; ++n) acc[a][b][m][n] = (f32x4){0.f, 0.f, 0.f, 0.f};
    bf16x8 At[4][2], B0[2][2], B1[2][2];
    const char* cA = (const char*)g.A + (size_t)cur.pm * tstep; const char* cB = (const char*)g.Bt + (size_t)cur.pn * tstep;
    S.a_ready(cur);
    if constexpr (SP2) {
        PG8_STAGE(PG8_SB(0, 0), cB, voffB); PG8_STAGE(PG8_SB(0, 1), cB + hstep, voffB); PG8_STAGE(PG8_SA(0, 0), cA, voffA); PG8_STAGE(PG8_SA(0, 1), cA + hstep, voffA);
        if (wr == 1) PG8_BAR;
        PG8_WAIT_V(2); PG8_BAR;
        PG8_STAGE(PG8_SB(1, 0), cB + kstep, voffB); PG8_STAGE(PG8_SA(1, 0), cA + kstep, voffA); PG8_STAGE(PG8_SB(1, 1), cB + hstep + kstep, voffB);
        PG8_WAIT_V(6); PG8_BAR;
    } else {
        PG8_STAGE(PG8_SB(0, 0), cB, voffB); PG8_STAGE(PG8_SA(0, 0), cA, voffA); PG8_STAGE(PG8_SB(0, 1), cB + hstep, voffB); PG8_STAGE(PG8_SA(0, 1), cA + hstep, voffA);
        if (wr == 1) PG8_BAR;
        PG8_WAIT_V(4); PG8_BAR;
        PG8_STAGE(PG8_SB(1, 0), cB + kstep, voffB); PG8_STAGE(PG8_SA(1, 0), cA + kstep, voffA); PG8_STAGE(PG8_SB(1, 1), cB + hstep + kstep, voffB);
        PG8_WAIT_V(6); PG8_BAR;
    }
    for (;;) {
        const bool has_next = S.next(ui + 1, nxt);
        const char* nA = has_next ? (const char*)g.A + (size_t)nxt.pm * tstep : cA; const char* nB = has_next ? (const char*)g.Bt + (size_t)nxt.pn * tstep : cB;
        for (int t = 0; t < nt; t += 2) {
            const bool last = (t == nt - 2);
            const char* a1 = cA + (size_t)(t + 1) * kstep;
            const char* a2 = last ? nA : cA + (size_t)(t + 2) * kstep; const char* b2 = last ? nB : cB + (size_t)(t + 2) * kstep;
            const char* a3 = a2 + kstep; const char* b3 = b2 + kstep;
            if (last && has_next) S.a_ready(nxt);
            if constexpr (SP2) {
            PG8_LDB(B0, 0, 0); PG8_LDB(B1, 0, 1); PG8_SCHED; PG8_LDA(At, 0, 0); PG8_STAGE(PG8_SA(1, 1), a1 + hstep, voffA);
            PG8_WAIT_V(8); PG8_WAIT_L(0); PG8_BAR; PG8_MMA(0, 0, At, B0); PG8_MMA(0, 1, At, B1); PG8_BAR; PG8_SCHED;
            PG8_LDA(At, 0, 1); PG8_STAGE(PG8_SB(0, 0), b2, voffB); PG8_STAGE(PG8_SB(0, 1), b2 + hstep, voffB); PG8_STAGE(PG8_SA(0, 0), a2, voffA);
            PG8_WAIT_V(8); PG8_WAIT_L(0); PG8_BAR; PG8_MMA(1, 0, At, B0); PG8_MMA(1, 1, At, B1); PG8_BAR; PG8_SCHED;
            PG8_LDB(B0, 1, 0); PG8_LDB(B1, 1, 1); PG8_SCHED; PG8_LDA(At, 1, 0); PG8_STAGE(PG8_SA(0, 1), a2 + hstep, voffA);
            PG8_WAIT_V(8); PG8_WAIT_L(0); PG8_BAR; PG8_MMA(0, 0, At, B0); PG8_MMA(0, 1, At, B1); PG8_BAR; PG8_SCHED;
            PG8_LDA(At, 1, 1); PG8_STAGE(PG8_SB(1, 0), b3, voffB); PG8_STAGE(PG8_SB(1, 1), b3 + hstep, voffB); PG8_STAGE(PG8_SA(1, 0), a3, voffA);
            PG8_WAIT_V(8); PG8_WAIT_L(0); PG8_BAR; PG8_MMA(1, 0, At, B0); PG8_MMA(1, 1, At, B1); PG8_BAR; PG8_SCHED;
            } else {
            PG8_LDB(B0, 0, 0); PG8_SCHED; PG8_LDA(At, 0, 0); PG8_STAGE(PG8_SA(1, 1), a1 + hstep, voffA);
            PG8_WAIT_L(8); PG8_BAR; PG8_WAIT_L(0); PG8_MMA(0, 0, At, B0); PG8_BAR; PG8_SCHED;
            PG8_LDB(B1, 0, 1); PG8_STAGE(PG8_SB(0, 0), b2, voffB);
            PG8_BAR; PG8_WAIT_L(0); PG8_MMA(0, 1, At, B1); PG8_BAR;
            PG8_LDA(At, 0, 1); PG8_STAGE(PG8_SA(0, 0), a2, voffA);
            PG8_BAR; PG8_WAIT_L(0); PG8_MMA(1, 0, At, B0); PG8_BAR; PG8_SCHED;
            PG8_STAGE(PG8_SB(0, 1), b2 + hstep, voffB);
            PG8_WAIT_V(6); PG8_BAR; PG8_MMA(1, 1, At, B1); PG8_BAR;
            PG8_LDB(B0, 1, 0); PG8_SCHED; PG8_LDA(At, 1, 0); PG8_STAGE(PG8_SA(0, 1), a2 + hstep, voffA);
            PG8_WAIT_L(8); PG8_BAR; PG8_WAIT_L(0); PG8_MMA(0, 0, At, B0); PG8_BAR; PG8_SCHED;
            PG8_LDB(B1, 1, 1); PG8_STAGE(PG8_SB(1, 0), b3, voffB);
            PG8_BAR; PG8_WAIT_L(0); PG8_MMA(0, 1, At, B1); PG8_BAR;
            PG8_LDA(At, 1, 1); PG8_STAGE(PG8_SA(1, 0), a3, voffA);
            PG8_BAR; PG8_WAIT_L(0); PG8_MMA(1, 0, At, B0); PG8_BAR; PG8_SCHED;
            PG8_STAGE(PG8_SB(1, 1), b3 + hstep, voffB);
            PG8_WAIT_V(6); PG8_BAR; PG8_MMA(1, 1, At, B1); PG8_BAR;
            }
        }
        if constexpr (ALIGN_EPI) { if (wr == 0) PG8_BAR; }
        if constexpr (!Epi::AFTER_DRAIN) { E(acc, cur, wr, wc, fr, fq); S.done(cur); }
        if (!has_next) break;
#pragma unroll
        for (int a = 0; a < 2; ++a)
#pragma unroll
            for (int b = 0; b < 2; ++b)
#pragma unroll
                for (int m = 0; m < 4; ++m)
#pragma unroll
                    for (int n = 0; n < 2; ++n) acc[a][b][m][n] = (f32x4){0.f, 0.f, 0.f, 0.f};
        cur = nxt; cA = nA; cB = nB; ++ui;
        if constexpr (ALIGN_EPI) { if (wr == 1) PG8_BAR; }
    }
    PG8_WAIT_V(0);
    if constexpr (!ALIGN_EPI) { if (wr == 0) PG8_BAR; }
    PG8_BAR;
    if constexpr (Epi::AFTER_DRAIN) { E.fused(acc, cur, wr, wc, fr, fq, lds, wid, lane); S.done(cur); }
#undef PG8_SA
#undef PG8_SB
#undef PG8_STAGE
#undef PG8_LDA
#undef PG8_LDB
#undef PG8_MMA
#undef PG8_WAIT_V
#undef PG8_WAIT_L
#undef PG8_BAR
#undef PG8_SCHED
}
}

#ifndef REP_PH
#define REP_PH -1
#endif
#ifndef MK_PER_PHASE
#define MK_PER_PHASE 0
#endif
#define LAS __attribute__((address_space(3)))
using pg8::bf16_t; using pg8::bf16x8; using pg8::f32x4; using pg8::Unit; using pg8::cvt_pk_bf16;
typedef unsigned u32x2 __attribute__((ext_vector_type(2)));
typedef unsigned u32x4 __attribute__((ext_vector_type(4)));
typedef float f32x2 __attribute__((ext_vector_type(2)));

constexpr int MP = 32768, MS = 1024, M = MP + MS, D = 1024, FF = 2816;
constexpr int KVR = 32768 + 32 * 1056;
constexpr float EPS = 1e-6f;
constexpr int NPH = 17;

constexpr size_t OUT_Y = 0;
constexpr size_t OUT_HGRN_P = 34603008, OUT_HGRN_S = OUT_HGRN_P + 1048576;
constexpr size_t OUT_S5RE_P = OUT_HGRN_S + 2097152, OUT_S5IM_P = OUT_S5RE_P + 32768;
constexpr size_t OUT_S5RE_S = OUT_S5IM_P + 32768, OUT_S5IM_S = OUT_S5RE_S + 65536;
constexpr size_t OUT_GV_P = OUT_S5IM_S + 65536, OUT_GV_S = OUT_GV_P + 1048576;
constexpr size_t OUT_CKV_P = OUT_GV_S + 524288, OUT_KPE_P = OUT_CKV_P + 4194304;
constexpr size_t OUT_CKV_S = OUT_KPE_P + 1048576, OUT_KPE_S = OUT_CKV_S + 131072;
constexpr size_t OUT_TOTAL = OUT_KPE_S + 32768;

constexpr size_t al256(size_t x) { return (x + 255) & ~(size_t)255; }
constexpr size_t SZ_GU = (size_t)5632 * 1024 * 2, SZ_DN = (size_t)1024 * 2816 * 2;
constexpr size_t W_GU0 = 0;
constexpr size_t W_DN0 = W_GU0 + 4 * SZ_GU;
constexpr size_t W_AB = W_DN0 + 4 * SZ_DN;
constexpr size_t W_ABO = W_AB + (size_t)2560 * 1024 * 2;
constexpr size_t W_GLU = W_ABO + (size_t)1024 * 1024 * 2;
constexpr size_t W_CD = W_GLU + (size_t)512 * 512 * 2;
constexpr size_t W_CDO = W_CD + (size_t)1536 * 1024 * 2;
constexpr size_t W_UQ = W_CDO + (size_t)1024 * 1024 * 2;
constexpr size_t W_UKV = W_UQ + (size_t)768 * 256 * 2;
constexpr size_t T_LAMBAR = W_UKV + (size_t)1024 * 128 * 2;
constexpr size_t T_BBT = T_LAMBAR + 2048 * 8;
constexpr size_t T_CCT = T_BBT + 65536 * 2;
constexpr size_t T_ROPE = T_CCT + 65536 * 2;
constexpr size_t T_LB = T_ROPE + 32768 * 8;
constexpr size_t T_WS = T_LB + 2048;
constexpr size_t A_XB = T_WS + 65536 * 2;
constexpr size_t A_SSQ = A_XB + (size_t)M * 1024 * 2;
constexpr size_t A_SSV = A_SSQ + (size_t)M * 16 * 4;
constexpr size_t A_SSCQ = A_SSV + (size_t)M * 8 * 4;
constexpr size_t A_SSCKV = A_SSCQ + (size_t)M * 4 * 4;
constexpr size_t A_SSQN = A_SSCKV + (size_t)M * 4 * 4;
constexpr size_t A_SSQR = A_SSQN + (size_t)M * 8 * 4;
constexpr size_t A_SSK = A_SSQR + (size_t)M * 8 * 4;
constexpr size_t A_CTL = al256(A_SSK + (size_t)KVR * 4);
constexpr size_t R0 = A_CTL + 16384;
constexpr size_t SZ_H = (size_t)M * 512 * 2;
constexpr size_t R_ACT = R0;
constexpr size_t R_MIX = R0;
constexpr size_t R_QT = R_MIX + 2 * SZ_H, R_KH = R_QT + SZ_H, R_KTT = R_KH + SZ_H, R_VTT = R_KTT + SZ_H;
constexpr size_t R_GB = R_VTT + SZ_H, R_UB = R_GB + SZ_H, R_OB = R_UB + SZ_H, R_ZB = R_OB + SZ_H;
constexpr size_t R_LDEC = R_ZB + SZ_H;
constexpr size_t R_END0 = R_LDEC + (size_t)(M / 16) * 512 * 4;
constexpr size_t R_VG = R_MIX + 2 * SZ_H;
constexpr size_t R_CQB = R_VG + SZ_H;
constexpr size_t R_CKVG = R_CQB + (size_t)M * 256 * 2;
constexpr size_t R_KPEB = R_CKVG + (size_t)KVR * 128 * 2;
constexpr size_t R_QF = R_KPEB + (size_t)KVR * 32 * 4;
constexpr size_t R_KF = R_QF + (size_t)M * 768 * 2;
constexpr size_t R_VT = R_KF + (size_t)KVR * 768 * 2;
constexpr size_t R_END1 = R_VT + (size_t)KVR * 512 * 2;
constexpr size_t R_PART = al256(R_ACT + (size_t)M * FF * 2);
constexpr size_t R_ENDA = R_PART + (size_t)176 * 65536 * 4;
constexpr size_t WS_END = (R_END1 > R_END0 ? (R_END1 > R_ENDA ? R_END1 : R_ENDA) : (R_END0 > R_ENDA ? R_END0 : R_ENDA));
static_assert(WS_END <= (size_t)536870912, "workspace map exceeds 512 MiB");

constexpr int LDS_BYTES = 147456;

template <class T> __device__ __forceinline__ T* gp(T* p) { return p; }
__device__ __forceinline__ float sum4(f32x4 a) { return (a.x + a.y) + (a.z + a.w); }
__device__ __forceinline__ float bf2f(unsigned short h) { return __uint_as_float((unsigned)h << 16); }
__device__ __forceinline__ void st_bf4(bf16_t* p, f32x4 v) { u32x2 w; w.x = cvt_pk_bf16(v.x, v.y); w.y = cvt_pk_bf16(v.z, v.w); *(u32x2*)p = w; }
__device__ __forceinline__ unsigned short bf1(float v) { return (unsigned short)(cvt_pk_bf16(v, 0.f) & 0xffffu); }
__device__ __forceinline__ float sigmoidf_(float x) { return __builtin_amdgcn_rcpf(1.f + __expf(-x)); }
__device__ __forceinline__ float gelu_tanh(float x) { const float y = 1.5957691216057308f * (x + 0.044715f * x * x * x); return x * __builtin_amdgcn_rcpf(1.f + __expf(-y)); }
__device__ __forceinline__ float rstd16(const float* ssq, int row) { const f32x4* p = (const f32x4*)(ssq + (size_t)row * 16); return rsqrtf((sum4(p[0]) + sum4(p[1]) + sum4(p[2]) + sum4(p[3])) * (1.f / 1024.f) + EPS); }
__device__ __forceinline__ int kvrow_of(int row) { return row < MP ? row : MP + ((row - MP) >> 5) * 1056 + 1024 + ((row - MP) & 31); }
__device__ __forceinline__ int pos_of(int row) { return row < MP ? (row & 2047) : 1024 + ((row - MP) & 31); }
__device__ __forceinline__ bf16x8 mk8(u32x2 a, u32x2 b) { u32x4 w; w.x = a.x; w.y = a.y; w.z = b.x; w.w = b.y; return __builtin_bit_cast(bf16x8, w); }
__device__ __forceinline__ f32x4 mfma16(bf16x8 a, bf16x8 b, f32x4 c) { return __builtin_amdgcn_mfma_f32_16x16x32_bf16(a, b, c, 0, 0, 0); }
#define LDSWAIT() asm volatile("s_waitcnt lgkmcnt(0)" ::: "memory")

#define EPI_ROWS_BEGIN _Pragma("unroll") for (int ai = 0; ai < 2; ++ai) _Pragma("unroll") for (int m = 0; m < 4; ++m) { const int row = u.pm * 256 + ai * 128 + wr * 64 + m * 16 + fr;
#define EPI_ROWS_END }

struct EpiGU {
    static constexpr bool PERM = true, AFTER_DRAIN = false;
    const float* ssq; bf16_t* act;
    __device__ __forceinline__ void operator()(const f32x4 (&acc)[2][2][4][2], const Unit& u, int wr, int wc, int fr, int fq) const {
        asm volatile("" : "+v"(fr), "+v"(fq));
        EPI_ROWS_BEGIN
            const float rs = rstd16(ssq, row); f32x4 a[2];
#pragma unroll
            for (int n = 0; n < 2; ++n) { const f32x4 g = acc[ai][0][m][n] * rs, up = acc[ai][1][m][n] * rs;
                a[n].x = g.x * sigmoidf_(g.x) * up.x; a[n].y = g.y * sigmoidf_(g.y) * up.y; a[n].z = g.z * sigmoidf_(g.z) * up.z; a[n].w = g.w * sigmoidf_(g.w) * up.w; }
            u32x4 w4; w4.x = cvt_pk_bf16(a[0].x, a[0].y); w4.y = cvt_pk_bf16(a[0].z, a[0].w); w4.z = cvt_pk_bf16(a[1].x, a[1].y); w4.w = cvt_pk_bf16(a[1].z, a[1].w);
            *(u32x4*)(act + (size_t)row * FF + u.pn * 128 + wc * 32 + 8 * fq) = w4;
        EPI_ROWS_END
    }
};
struct EpiRes {
    static constexpr bool PERM = false, AFTER_DRAIN = false;
    const float* xin0; const float* xin1; float* xout; bf16_t* xb; float* ssq; float scale;
    __device__ __forceinline__ void do_row(int row, int pn, int wc, int fq, const f32x4& a00, const f32x4& a01, const f32x4& a10, const f32x4& a11) const {
        const float* src = row < MP ? xin0 + (size_t)row * D : xin1 + (size_t)(row - MP) * D; float ss = 0.f;
#pragma unroll
        for (int bj = 0; bj < 2; ++bj)
#pragma unroll
            for (int n = 0; n < 2; ++n) { const int col = pn * 256 + bj * 128 + wc * 32 + n * 16 + fq * 4;
                const f32x4 o = *(const f32x4*)(src + col) + (bj ? (n ? a11 : a10) : (n ? a01 : a00)) * scale;
                *(f32x4*)(xout + (size_t)row * D + col) = o; st_bf4(xb + (size_t)row * D + col, o); ss += sum4(o * o); }
        ss += __shfl_xor(ss, 16); ss += __shfl_xor(ss, 32);
        if (fq == 0) ssq[(size_t)row * 16 + pn * 4 + wc] = ss;
    }
    __device__ __forceinline__ void operator()(const f32x4 (&acc)[2][2][4][2], const Unit& u, int wr, int wc, int fr, int fq) const {
        asm volatile("" : "+v"(fr), "+v"(fq));
        EPI_ROWS_BEGIN
            do_row(row, u.pn, wc, fq, acc[ai][0][m][0], acc[ai][0][m][1], acc[ai][1][m][0], acc[ai][1][m][1]);
        EPI_ROWS_END
    }
};
struct EpiAB {
    static constexpr bool PERM = true, AFTER_DRAIN = false;
    const float* ssq; const float* lb; bf16_t* QT; bf16_t* KH; bf16_t* KTT; bf16_t* VTT; bf16_t* GB; bf16_t* UB; float* LDEC;
    __device__ __forceinline__ void operator()(const f32x4 (&acc)[2][2][4][2], const Unit& u, int wr, int wc, int fr, int fq) const {
        asm volatile("" : "+v"(fr), "+v"(fq));
        if (u.pn < 4) {
            const int h = u.pn;
            EPI_ROWS_BEGIN
                const float rs = rstd16(ssq, row); const int blk = row >> 4; const int c0 = h * 128 + wc * 32 + fq * 8; f32x4 qt[2], kh[2];
#pragma unroll
                for (int n = 0; n < 2; ++n) { const int cl = c0 + 4 * n; const f32x4 lbv = *(const f32x4*)(lb + cl);
                    f32x4 dec; float kt[4];
#pragma unroll
                    for (int j = 0; j < 4; ++j) { const float q = acc[ai][0][m][n][j] * rs, fz = acc[ai][1][m][n][j] * rs;
                        const float f = lbv[j] + (1.f - lbv[j]) * sigmoidf_(fz); float b = __logf(f);
#pragma unroll
                        for (int d = 1; d < 16; d <<= 1) { const float t = __shfl_up(b, d, 16); if (fr >= d) b += t; }
                        const float bend = __shfl(b, 15, 16); const float kk = 1.f - f;
                        qt[n][j] = q * __expf(b); kh[n][j] = kk * __expf(-b); kt[j] = kk * __expf(bend - b); dec[j] = __expf(bend); }
#pragma unroll
                    for (int j = 0; j < 4; ++j) KTT[(size_t)blk * 8192 + (cl + j) * 16 + fr] = bf1(kt[j]);
                    if (fr == 15) *(f32x4*)(LDEC + (size_t)blk * 512 + cl) = dec; }
                u32x4 wq, wk; wq.x = cvt_pk_bf16(qt[0].x, qt[0].y); wq.y = cvt_pk_bf16(qt[0].z, qt[0].w); wq.z = cvt_pk_bf16(qt[1].x, qt[1].y); wq.w = cvt_pk_bf16(qt[1].z, qt[1].w);
                wk.x = cvt_pk_bf16(kh[0].x, kh[0].y); wk.y = cvt_pk_bf16(kh[0].z, kh[0].w); wk.z = cvt_pk_bf16(kh[1].x, kh[1].y); wk.w = cvt_pk_bf16(kh[1].z, kh[1].w);
                *(u32x4*)(QT + (size_t)row * 512 + c0) = wq; *(u32x4*)(KH + (size_t)row * 512 + c0) = wk;
            EPI_ROWS_END
        } else if (u.pn < 6) {
            EPI_ROWS_BEGIN
                const float rs = rstd16(ssq, row); const int blk = row >> 4;
#pragma unroll
                for (int bj = 0; bj < 2; ++bj)
#pragma unroll
                    for (int n = 0; n < 2; ++n) { const int cl = (u.pn - 4) * 256 + bj * 128 + wc * 32 + fq * 8 + n * 4;
#pragma unroll
                        for (int j = 0; j < 4; ++j) VTT[(size_t)blk * 8192 + (cl + j) * 16 + fr] = bf1(acc[ai][bj][m][n][j] * rs); }
            EPI_ROWS_END
        } else {
            bf16_t* dst = u.pn < 8 ? GB : UB; const int t0 = (u.pn < 8 ? u.pn - 6 : u.pn - 8) * 256; const bool sg = u.pn < 8;
            EPI_ROWS_BEGIN
                const float rs = rstd16(ssq, row);
#pragma unroll
                for (int bj = 0; bj < 2; ++bj) { f32x4 v0 = acc[ai][bj][m][0] * rs, v1 = acc[ai][bj][m][1] * rs;
                    if (sg) { v0.x = sigmoidf_(v0.x); v0.y = sigmoidf_(v0.y); v0.z = sigmoidf_(v0.z); v0.w = sigmoidf_(v0.w); v1.x = sigmoidf_(v1.x); v1.y = sigmoidf_(v1.y); v1.z = sigmoidf_(v1.z); v1.w = sigmoidf_(v1.w); }
                    u32x4 w4; w4.x = cvt_pk_bf16(v0.x, v0.y); w4.y = cvt_pk_bf16(v0.z, v0.w); w4.z = cvt_pk_bf16(v1.x, v1.y); w4.w = cvt_pk_bf16(v1.z, v1.w);
                    *(u32x4*)(dst + (size_t)row * 512 + t0 + bj * 128 + wc * 32 + fq * 8) = w4; }
            EPI_ROWS_END
        }
    }
};
struct EpiGLU {
    static constexpr bool PERM = false, AFTER_DRAIN = false;
    const bf16_t* ZB; const float* bglu; bf16_t* MIX;
    __device__ __forceinline__ void operator()(const f32x4 (&acc)[2][2][4][2], const Unit& u, int wr, int wc, int fr, int fq) const {
        asm volatile("" : "+v"(fr), "+v"(fq));
        EPI_ROWS_BEGIN
#pragma unroll
            for (int bj = 0; bj < 2; ++bj)
#pragma unroll
                for (int n = 0; n < 2; ++n) { const int col = u.pn * 256 + bj * 128 + wc * 32 + n * 16 + fq * 4;
                    const u32x2 zz = *(const u32x2*)(ZB + (size_t)row * 512 + col); const f32x4 bv = *(const f32x4*)(bglu + col); const f32x4 a = acc[ai][bj][m][n] + bv; f32x4 o;
                    o.x = __uint_as_float(zz.x << 16) * sigmoidf_(a.x); o.y = __uint_as_float(zz.x & 0xffff0000u) * sigmoidf_(a.y);
                    o.z = __uint_as_float(zz.y << 16) * sigmoidf_(a.z); o.w = __uint_as_float(zz.y & 0xffff0000u) * sigmoidf_(a.w);
                    st_bf4(MIX + (size_t)row * 1024 + 512 + col, o); }
        EPI_ROWS_END
    }
};
struct EpiCD {
    static constexpr bool PERM = false, AFTER_DRAIN = false;
    const float* ssq; const float* vnorm; const float* kvnorm; const f32x2* rope; bf16_t* MIX; bf16_t* VG; float* SSV; bf16_t* CQB; float* SSCQ; bf16_t* CKVG; float* SSCKV; float* KPEB; float* SSK; float* out;
    __device__ __forceinline__ void operator()(const f32x4 (&acc)[2][2][4][2], const Unit& u, int wr, int wc, int fr, int fq) const {
        asm volatile("" : "+v"(fr), "+v"(fq));
        if (u.pn < 2) {
            EPI_ROWS_BEGIN
                const float rs = rstd16(ssq, row);
#pragma unroll
                for (int bj = 0; bj < 2; ++bj)
#pragma unroll
                    for (int n = 0; n < 2; ++n) { const int cl = u.pn * 256 + bj * 128 + wc * 32 + n * 16 + fq * 4; const f32x4 v = acc[ai][bj][m][n] * rs; f32x4 g;
                        g.x = gelu_tanh(v.x); g.y = gelu_tanh(v.y); g.z = gelu_tanh(v.z); g.w = gelu_tanh(v.w); st_bf4(MIX + (size_t)row * 1024 + cl, g); }
            EPI_ROWS_END
        } else if (u.pn < 4) {
            EPI_ROWS_BEGIN
                const float rs = rstd16(ssq, row); float ss = 0.f;
#pragma unroll
                for (int bj = 0; bj < 2; ++bj)
#pragma unroll
                    for (int n = 0; n < 2; ++n) { const int cl = (u.pn - 2) * 256 + bj * 128 + wc * 32 + n * 16 + fq * 4; const f32x4 v = acc[ai][bj][m][n] * rs; f32x4 g;
                        g.x = gelu_tanh(v.x); g.y = gelu_tanh(v.y); g.z = gelu_tanh(v.z); g.w = gelu_tanh(v.w); ss += sum4(g * g);
                        st_bf4(VG + (size_t)row * 512 + cl, g * *(const f32x4*)(vnorm + cl)); }
                ss += __shfl_xor(ss, 16); ss += __shfl_xor(ss, 32);
                if (fq == 0) SSV[(size_t)row * 8 + (u.pn - 2) * 4 + wc] = ss;
            EPI_ROWS_END
        } else if (u.pn == 4) {
            EPI_ROWS_BEGIN
                const float rs = rstd16(ssq, row); float ss = 0.f;
#pragma unroll
                for (int bj = 0; bj < 2; ++bj)
#pragma unroll
                    for (int n = 0; n < 2; ++n) { const int cl = bj * 128 + wc * 32 + n * 16 + fq * 4; const f32x4 v = acc[ai][bj][m][n] * rs; ss += sum4(v * v); st_bf4(CQB + (size_t)row * 256 + cl, v); }
                ss += __shfl_xor(ss, 16); ss += __shfl_xor(ss, 32);
                if (fq == 0) SSCQ[(size_t)row * 4 + wc] = ss;
            EPI_ROWS_END
        } else {
            EPI_ROWS_BEGIN
                const float rs = rstd16(ssq, row); const int kvr = kvrow_of(row); float ss = 0.f;
                float* ock = row < MP ? out + OUT_CKV_P + (size_t)row * 128 : out + OUT_CKV_S + (size_t)(row - MP) * 128;
#pragma unroll
                for (int n = 0; n < 2; ++n) { const int cl = wc * 32 + n * 16 + fq * 4; const f32x4 v = acc[ai][0][m][n] * rs; ss += sum4(v * v);
                    const f32x4 g = v * *(const f32x4*)(kvnorm + cl); st_bf4(CKVG + (size_t)kvr * 128 + cl, g); *(f32x4*)(ock + cl) = g; }
                ss += __shfl_xor(ss, 16); ss += __shfl_xor(ss, 32);
                if (fq == 0) SSCKV[(size_t)row * 4 + wc] = ss;
                if (wc == 0) {
                    const int pos = pos_of(row); float* okp = row < MP ? out + OUT_KPE_P + (size_t)row * 32 : out + OUT_KPE_S + (size_t)(row - MP) * 32;
                    const f32x4 x1 = acc[ai][1][m][0] * rs, x2 = acc[ai][1][m][1] * rs; f32x4 o1, o2; float s2 = 0.f;
#pragma unroll
                    for (int j = 0; j < 4; ++j) { const f32x2 cs = rope[pos * 16 + fq * 4 + j]; o1[j] = x1[j] * cs.x - x2[j] * cs.y; o2[j] = x1[j] * cs.y + x2[j] * cs.x; }
                    s2 = sum4(o1 * o1) + sum4(o2 * o2); s2 += __shfl_xor(s2, 16); s2 += __shfl_xor(s2, 32);
                    *(f32x4*)(okp + fq * 4) = o1; *(f32x4*)(okp + 16 + fq * 4) = o2;
                    *(f32x4*)(KPEB + (size_t)kvr * 32 + fq * 4) = o1; *(f32x4*)(KPEB + (size_t)kvr * 32 + 16 + fq * 4) = o2;
                    if (fq == 0) SSK[kvr] = s2;
                }
            EPI_ROWS_END
        }
    }
};
struct EpiQ {
    static constexpr bool PERM = false, AFTER_DRAIN = false;
    const float* SSCQ; const float* qgain; const f32x2* rope; bf16_t* QF; float* SSQN; float* SSQR;
    __device__ __forceinline__ void operator()(const f32x4 (&acc)[2][2][4][2], const Unit& u, int wr, int wc, int fr, int fq) const {
        asm volatile("" : "+v"(fr), "+v"(fq));
        if (u.pn < 2) {
            const int head = u.pn * 4 + wc;
            EPI_ROWS_BEGIN
                const float rs = rsqrtf(sum4(*(const f32x4*)(SSCQ + (size_t)row * 4)) * (1.f / 256.f) + EPS); float ss = 0.f;
#pragma unroll
                for (int bj = 0; bj < 2; ++bj)
#pragma unroll
                    for (int n = 0; n < 2; ++n) { const int d = bj * 32 + n * 16 + fq * 4; const f32x4 v = acc[ai][bj][m][n] * rs; ss += sum4(v * v);
                        st_bf4(QF + (size_t)row * 768 + head * 96 + d, v * *(const f32x4*)(qgain + d)); }
                ss += __shfl_xor(ss, 16); ss += __shfl_xor(ss, 32);
                if (fq == 0) SSQN[(size_t)row * 8 + head] = ss;
            EPI_ROWS_END
        } else {
            EPI_ROWS_BEGIN
                const float rs = rsqrtf(sum4(*(const f32x4*)(SSCQ + (size_t)row * 4)) * (1.f / 256.f) + EPS); const int pos = pos_of(row);
#pragma unroll
                for (int bj = 0; bj < 2; ++bj) { const int head = 2 * wc + bj; const f32x4 x1 = acc[ai][bj][m][0] * rs, x2 = acc[ai][bj][m][1] * rs; f32x4 o1, o2;
#pragma unroll
                    for (int j = 0; j < 4; ++j) { const f32x2 cs = rope[pos * 16 + fq * 4 + j]; o1[j] = x1[j] * cs.x - x2[j] * cs.y; o2[j] = x1[j] * cs.y + x2[j] * cs.x; }
                    float ss = sum4(x1 * x1) + sum4(x2 * x2); ss += __shfl_xor(ss, 16); ss += __shfl_xor(ss, 32);
                    st_bf4(QF + (size_t)row * 768 + head * 96 + 64 + fq * 4, o1 * *(const f32x4*)(qgain + 64 + fq * 4));
                    st_bf4(QF + (size_t)row * 768 + head * 96 + 80 + fq * 4, o2 * *(const f32x4*)(qgain + 80 + fq * 4));
                    if (fq == 0) SSQR[(size_t)row * 8 + head] = ss; }
            EPI_ROWS_END
        }
    }
};
struct EpiKV {
    static constexpr bool PERM = false, AFTER_DRAIN = false;
    const float* SSCKV; const float* SSK; const float* KPEB; const float* kgain; bf16_t* KF; bf16_t* VT;
    __device__ __forceinline__ float rstd_kv(int kvr) const {
        int row;
        if (kvr < MP) row = kvr; else { const int rel = kvr - MP, b = rel / 1056, j = rel - b * 1056; if (j < 1024) return 1.f; row = MP + b * 32 + (j - 1024); }
        return rsqrtf(sum4(*(const f32x4*)(SSCKV + (size_t)row * 4)) * (1.f / 128.f) + EPS);
    }
    __device__ __forceinline__ void operator()(const f32x4 (&acc)[2][2][4][2], const Unit& u, int wr, int wc, int fr, int fq) const {
        asm volatile("" : "+v"(fr), "+v"(fq));
        if (u.pn < 2) {
            const int head = u.pn * 4 + wc;
            EPI_ROWS_BEGIN
                const float rs = rstd_kv(row); float ss = 0.f;
#pragma unroll
                for (int bj = 0; bj < 2; ++bj)
#pragma unroll
                    for (int n = 0; n < 2; ++n) { const f32x4 v = acc[ai][bj][m][n] * rs; ss += sum4(v * v); }
                ss += __shfl_xor(ss, 16); ss += __shfl_xor(ss, 32);
                const float rk = rsqrtf((ss + SSK[row]) * (1.f / 96.f) + EPS);
#pragma unroll
                for (int bj = 0; bj < 2; ++bj)
#pragma unroll
                    for (int n = 0; n < 2; ++n) { const int d = bj * 32 + n * 16 + fq * 4; st_bf4(KF + (size_t)row * 768 + head * 96 + d, acc[ai][bj][m][n] * (rs * rk) * *(const f32x4*)(kgain + d)); }
                const f32x4 p0 = *(const f32x4*)(KPEB + (size_t)row * 32 + fq * 8), p1 = *(const f32x4*)(KPEB + (size_t)row * 32 + fq * 8 + 4);
                st_bf4(KF + (size_t)row * 768 + head * 96 + 64 + fq * 8, p0 * rk * *(const f32x4*)(kgain + 64 + fq * 8));
                st_bf4(KF + (size_t)row * 768 + head * 96 + 68 + fq * 8, p1 * rk * *(const f32x4*)(kgain + 68 + fq * 8));
            EPI_ROWS_END
        } else {
            EPI_ROWS_BEGIN
                const float rs = rstd_kv(row); int seq0, key, L;
                if (row < MP) { seq0 = row & ~2047; key = row & 2047; L = 2048; } else { const int rel = row - MP, b = rel / 1056; seq0 = MP + b * 1056; key = rel - b * 1056; L = 1056; }
                bf16_t* base = VT + (size_t)seq0 * 512 + key;
#pragma unroll
                for (int bj = 0; bj < 2; ++bj)
#pragma unroll
                    for (int n = 0; n < 2; ++n) { const int c = (u.pn - 2) * 256 + bj * 128 + wc * 32 + n * 16 + fq * 4;
#pragma unroll
                        for (int j = 0; j < 4; ++j) base[(size_t)(c + j) * L] = bf1(acc[ai][bj][m][n][j] * rs); }
            EPI_ROWS_END
        }
    }
};

struct Args { const float* in[41]; float* out; unsigned char* ws; int ph_lo, ph_hi; };

__device__ __forceinline__ void tr_item(const float* W, int ldw, int col0, const float* gain, bf16_t* WT, int K, int drow0, int k0, LAS float* scr, int lane, bool zero) {
    const int c = lane & 7;
    if (zero) {
#pragma unroll
        for (int j = 0; j < 4; ++j) { const int n = (lane >> 3) + 8 * j; *(u32x4*)(WT + (size_t)(drow0 + n) * K + k0 + 8 * c) = (u32x4){0u, 0u, 0u, 0u}; }
        return;
    }
    float tv[32];
#pragma unroll
    for (int i = 0; i < 32; ++i) { const int kk = 2 * i + (lane >> 5); tv[i] = W[(size_t)(k0 + kk) * ldw + col0 + (lane & 31)]; }
    if (gain) {
#pragma unroll
        for (int i = 0; i < 32; ++i) tv[i] *= gain[k0 + 2 * i + (lane >> 5)]; }
#pragma unroll
    for (int i = 0; i < 32; ++i) scr[(2 * i + (lane >> 5)) * 33 + (lane & 31)] = tv[i];
    LDSWAIT();
#pragma unroll
    for (int j = 0; j < 4; ++j) { const int n = (lane >> 3) + 8 * j; const LAS float* s = scr + (8 * c) * 33 + n;
        u32x4 o; o.x = cvt_pk_bf16(s[0 * 33], s[1 * 33]); o.y = cvt_pk_bf16(s[2 * 33], s[3 * 33]); o.z = cvt_pk_bf16(s[4 * 33], s[5 * 33]); o.w = cvt_pk_bf16(s[6 * 33], s[7 * 33]);
        *(u32x4*)(WT + (size_t)(drow0 + n) * K + k0 + 8 * c) = o; }
    LDSWAIT();
}
__device__ __forceinline__ void sincos_d(double a, double& s, double& c) {
    const double q = rint(a * 0.6366197723675814); double r = fma(-q, 1.5707963267948966, a); r = fma(-q, 6.123233995736766e-17, r);
    const double r2 = r * r;
    const double sr = r * (1.0 + r2 * (-1.0 / 6 + r2 * (1.0 / 120 + r2 * (-1.0 / 5040 + r2 * (1.0 / 362880 + r2 * (-1.0 / 39916800 + r2 * (1.0 / 6227020800.0 + r2 * (-1.0 / 1307674368000.0))))))));
    const double cr = 1.0 + r2 * (-0.5 + r2 * (1.0 / 24 + r2 * (-1.0 / 720 + r2 * (1.0 / 40320 + r2 * (-1.0 / 3628800 + r2 * (1.0 / 479001600 + r2 * (-1.0 / 87178291200.0 + r2 * (1.0 / 20922789888000.0))))))));
    const int n = ((int)q) & 3;
    s = (n == 0) ? sr : (n == 1) ? cr : (n == 2) ? -sr : -cr;
    c = (n == 0) ? cr : (n == 1) ? -sr : (n == 2) ? -cr : sr;
}
__device__ __forceinline__ double exp_d(double x) {
    const double y = x * 0.0625; double t = 1.0 + y * (1.0 + y * (0.5 + y * (1.0 / 6 + y * (1.0 / 24 + y * (1.0 / 120 + y * (1.0 / 720 + y * (1.0 / 5040 + y * (1.0 / 40320 + y * (1.0 / 362880 + y * (1.0 / 3628800 + y * (1.0 / 39916800 + y * (1.0 / 479001600 + y * (1.0 / 6227020800.0)))))))))))));
    t *= t; t *= t; t *= t; t *= t; return t;
}

constexpr int I_GU = 16 * 176, I_DN = 44 * 32, I_AB = 16 * 80, I_ABO = 16 * 32, I_GLU = 8 * 16, I_CD = 16 * 48, I_CDO = 16 * 32, I_UQ = 4 * 24, I_UKV = 2 * 32;
constexpr int NIT = 4 * I_GU + 4 * I_DN + I_AB + I_ABO + I_GLU + I_CD + I_CDO + I_UQ + I_UKV;
constexpr int I_L0 = I_AB + I_ABO + I_GLU, I_L1 = I_CD + I_CDO + I_UQ + I_UKV, IT_MISC = 4 * I_GU + 4 * I_DN;
constexpr int NIT_A = I_GU + I_DN + I_L0, NIT_B1 = I_GU + I_DN, NIT_B2 = I_GU + I_DN + I_L1, NIT_B3 = I_GU + I_DN;
__device__ __forceinline__ int item_of(int set, int idx) {
    if (idx < I_GU) return set * I_GU + idx; idx -= I_GU;
    if (idx < I_DN) return 4 * I_GU + set * I_DN + idx; idx -= I_DN;
    return set == 0 ? IT_MISC + idx : IT_MISC + I_L0 + idx;
}
__device__ __forceinline__ void weight_item(const Args& a, unsigned char* ws, int it, LAS float* scr, int lane) {
        int r = it;
        if (r < 4 * I_GU) { const int w = r / I_GU; r -= w * I_GU; const int l = w >> 1, f2 = w & 1; const int kb = r / 176, nbk = r % 176, pn = nbk >> 3, t32 = nbk & 7, bj = t32 >> 2;
            const float* Wg = gp(a.in[f2 ? 13 : 8]) + (size_t)l * 1024 * FF; const float* Wu = gp(a.in[f2 ? 14 : 9]) + (size_t)l * 1024 * FF; const float* gn = gp(a.in[f2 ? 12 : 7]) + l * 1024;
            tr_item(bj ? Wu : Wg, FF, pn * 128 + (t32 & 3) * 32, gn, (bf16_t*)(ws + W_GU0 + w * SZ_GU), 1024, nbk * 32, kb * 64, scr, lane, false); return; }
        r -= 4 * I_GU;
        if (r < 4 * I_DN) { const int w = r / I_DN; r -= w * I_DN; const int l = w >> 1, f2 = w & 1; const int kb = r / 32, nbk = r % 32;
            tr_item(gp(a.in[f2 ? 15 : 10]) + (size_t)l * FF * 1024, 1024, nbk * 32, nullptr, (bf16_t*)(ws + W_DN0 + w * SZ_DN), FF, nbk * 32, kb * 64, scr, lane, false); return; }
        r -= 4 * I_DN;
        if (r < I_AB) { const int kb = r / 80, nbk = r % 80, pn = nbk >> 3; int col0 = nbk * 32; if (pn < 4) { const int bj = (nbk & 7) >> 2; col0 = bj * 512 + pn * 128 + (nbk & 3) * 32; }
            tr_item(gp(a.in[16]), 2560, col0, gp(a.in[11]), (bf16_t*)(ws + W_AB), 1024, nbk * 32, kb * 64, scr, lane, false); return; }
        r -= I_AB;
        if (r < I_ABO) { const int kb = r / 32, nbk = r % 32; tr_item(gp(a.in[29]), 1024, nbk * 32, nullptr, (bf16_t*)(ws + W_ABO), 1024, nbk * 32, kb * 64, scr, lane, false); return; }
        r -= I_ABO;
        if (r < I_GLU) { const int kb = r / 16, nbk = r % 16; tr_item(gp(a.in[27]), 512, nbk * 32, nullptr, (bf16_t*)(ws + W_GLU), 512, nbk * 32, kb * 64, scr, lane, false); return; }
        r -= I_GLU;
        if (r < I_CD) { const int kb = r / 48, nbk = r % 48; tr_item(gp(a.in[30]), 1440, nbk * 32, gp(a.in[11]) + 1024, (bf16_t*)(ws + W_CD), 1024, nbk * 32, kb * 64, scr, lane, nbk >= 45); return; }
        r -= I_CD;
        if (r < I_CDO) { const int kb = r / 32, nbk = r % 32; tr_item(gp(a.in[40]), 1024, nbk * 32, nullptr, (bf16_t*)(ws + W_CDO), 1024, nbk * 32, kb * 64, scr, lane, false); return; }
        r -= I_CDO;
        if (r < I_UQ) { const int kb = r / 24, nbk = r % 24, pn = nbk >> 3, t32 = nbk & 7, bj = t32 >> 2, wc = t32 & 3; const int col0 = pn < 2 ? (pn * 4 + wc) * 96 + 32 * bj : (2 * wc + bj) * 96 + 64;
            tr_item(gp(a.in[35]), 768, col0, gp(a.in[34]), (bf16_t*)(ws + W_UQ), 256, nbk * 32, kb * 64, scr, lane, false); return; }
        r -= I_UQ;
        { const int kb = r / 32, nbk = r % 32, pn = nbk >> 3, t32 = nbk & 7, bj = t32 >> 2, wc = t32 & 3; int col0;
            if (pn < 2) col0 = (pn * 4 + wc) * 128 + 32 * bj; else { const int tc0 = t32 * 32; col0 = ((pn - 2) * 4 + (tc0 >> 6)) * 128 + 64 + (tc0 & 63); }
            tr_item(gp(a.in[37]), 1024, col0, nullptr, (bf16_t*)(ws + W_UKV), 128, nbk * 32, kb * 64, scr, lane, false); }
}

__device__ __forceinline__ void prologue(const Args& a, LAS unsigned char* lds, int G, const int wvs) {
    int tid_; asm volatile("v_mbcnt_lo_u32_b32 %0, -1, 0\n\tv_mbcnt_hi_u32_b32 %0, -1, %0" : "=v"(tid_)); tid_ += wvs * 64;
    const int tid = tid_, lane = tid & 63, wave = tid >> 6, bid = blockIdx.x;
    unsigned char* ws = gp(a.ws);
    LAS float* scr = (LAS float*)(lds + wave * 16384);
    const int gw = bid * 8 + wave, NGW = G * 8;
    if (G == 256) { for (int idx = gw; idx < NIT_A; idx += NGW) weight_item(a, ws, item_of(0, idx), scr, lane); }
    else { for (int it = gw; it < NIT; it += NGW) weight_item(a, ws, it, scr, lane); }
    { bf16_t* XB = (bf16_t*)(ws + A_XB); float* SSQ = (float*)(ws + A_SSQ);
      for (int row0 = gw * 2; row0 < M; row0 += NGW * 2) {
          const float* s0 = row0 < MP ? gp(a.in[0]) + (size_t)row0 * D : gp(a.in[1]) + (size_t)(row0 - MP) * D; const float* s1 = s0 + D;
          f32x4 v0[4], v1[4]; float ss0 = 0.f, ss1 = 0.f;
#pragma unroll
          for (int j = 0; j < 4; ++j) { v0[j] = ((const f32x4*)s0)[lane + 64 * j]; v1[j] = ((const f32x4*)s1)[lane + 64 * j]; }
#pragma unroll
          for (int j = 0; j < 4; ++j) { ss0 += sum4(v0[j] * v0[j]); ss1 += sum4(v1[j] * v1[j]); st_bf4(XB + (size_t)row0 * D + (lane + 64 * j) * 4, v0[j]); st_bf4(XB + (size_t)(row0 + 1) * D + (lane + 64 * j) * 4, v1[j]); }
#pragma unroll
          for (int o = 1; o < 64; o <<= 1) { ss0 += __shfl_xor(ss0, o); ss1 += __shfl_xor(ss1, o); }
          if (lane < 4) ((f32x4*)(SSQ + (size_t)row0 * 16))[lane] = (f32x4){lane == 0 ? ss0 : 0.f, 0.f, 0.f, 0.f};
          else if (lane < 8) ((f32x4*)(SSQ + (size_t)(row0 + 1) * 16))[lane - 4] = (f32x4){lane == 4 ? ss1 : 0.f, 0.f, 0.f, 0.f};
      } }
    const int gid = bid * 512 + tid, NT = G * 512;
    for (int i = gid; i < 65536; i += NT) {
        const int g = i >> 11, c = (i >> 4) & 127, h = i & 15, p = c & 63;
        const double lr = fmin((double)gp(a.in[19])[g * 64 + p], -1e-4), li = (double)gp(a.in[20])[g * 64 + p], dt = exp_d((double)gp(a.in[21])[g]);
        double sn, cs; sincos_d(li * dt, sn, cs); const double er = exp_d(lr * dt); const double br = er * cs, bi = er * sn;
        const double nr = br - 1.0, ni = bi, den = lr * lr + li * li; const double fr_ = (nr * lr + ni * li) / den, fi_ = (ni * lr - nr * li) / den;
        const double Br = (double)gp(a.in[22])[(g * 64 + p) * 16 + h], Bi = (double)gp(a.in[23])[(g * 64 + p) * 16 + h];
        const double vr = fr_ * Br - fi_ * Bi, vi = fr_ * Bi + fi_ * Br;
        ((bf16_t*)(ws + T_BBT))[i] = bf1((float)(c < 64 ? vr : vi));
        if (h == 0 && c < 64) ((f32x2*)(ws + T_LAMBAR))[g * 64 + p] = (f32x2){(float)br, (float)bi};
    }
    for (int i = gid; i < 65536; i += NT) {
        const int g = i >> 11, h = (i >> 7) & 15, k = i & 127;
        ((bf16_t*)(ws + T_CCT))[i] = bf1(k < 64 ? gp(a.in[24])[(g * 16 + h) * 64 + k] : -gp(a.in[25])[(g * 16 + h) * 64 + (k - 64)]);
    }
    for (int i = gid; i < 32768; i += NT) {
        const int pos = i >> 4, k = i & 15; const double inv = exp_d(-(double)k * (9.210340371976184 / 16.0)); double sn, cs; sincos_d((double)pos * inv, sn, cs);
        ((f32x2*)(ws + T_ROPE))[i] = (f32x2){(float)cs, (float)sn};
    }
    for (int i = gid; i < 512; i += NT) {
        const float l0 = gp(a.in[17])[i], l1 = gp(a.in[17])[512 + i], l2 = gp(a.in[17])[1024 + i]; const float mx = fmaxf(l0, fmaxf(l1, l2));
        const float e0 = __expf(l0 - mx), e1 = __expf(l1 - mx), e2 = __expf(l2 - mx); ((float*)(ws + T_LB))[i] = e0 / (e0 + e1 + e2);
    }
    if (gid == 0) {
        float gq = 0.f, gk = 0.f; for (int d = 0; d < 96; ++d) { gq = fmaxf(gq, fabsf(gp(a.in[38])[d])); gk = fmaxf(gk, fabsf(gp(a.in[39])[d])); }
        ((float*)(ws + A_CTL))[60] = 9.797958971132712f * gq * gk * 1.001f * 1.4426950408889634f; }
    for (int i = gid; i < 65536; i += NT) {
        const int t = (i >> 7) & 127, s = i & 127; ((bf16_t*)(ws + T_WS))[i] = bf1(s <= t ? gp(a.in[32])[i] : 0.f);
    }
}

__device__ __forceinline__ void hgrn_task(const int wvs, unsigned char* ws, unsigned char* ldsg, int rowbase, int nblk, const float* S0, float* Sout, int h) {
    int tid_; asm volatile("v_mbcnt_lo_u32_b32 %0, -1, 0\n\tv_mbcnt_hi_u32_b32 %0, -1, %0" : "=v"(tid_)); tid_ += wvs * 64;
    const int tid = tid_, lane = tid & 63, w = tid >> 6, fr = lane & 15, fq = lane >> 4;
    constexpr int PITCH = 136;
    const bf16_t* QT = (const bf16_t*)(ws + R_QT); const bf16_t* KH = (const bf16_t*)(ws + R_KH); const bf16_t* KTT = (const bf16_t*)(ws + R_KTT); const bf16_t* VTT = (const bf16_t*)(ws + R_VTT);
    const float* LDEC = (const float*)(ws + R_LDEC); bf16_t* OB = (bf16_t*)(ws + R_OB);
    f32x4 S[8];
#pragma unroll
    for (int vt = 0; vt < 8; ++vt)
#pragma unroll
        for (int j = 0; j < 4; ++j) S[vt][j] = S0 ? S0[(size_t)(16 * w + 4 * fq + j) * 128 + 16 * vt + fr] : 0.f;
    const u32x2 z2 = {0u, 0u};
    bf16x8 qf[4], kf[4]; u32x2 vown, ktf, vf[8]; f32x4 dec;
#define HG_LOAD(Q, K, VO, KT, VF, DE, rb_) do { const int rbx = (rb_); const size_t gbx = (size_t)(rbx >> 4) * 8192; \
        _Pragma("unroll") for (int ks = 0; ks < 4; ++ks) { Q[ks] = *(const bf16x8*)(QT + (size_t)(rbx + fr) * 512 + h * 128 + ks * 32 + fq * 8); K[ks] = *(const bf16x8*)(KH + (size_t)(rbx + fr) * 512 + h * 128 + ks * 32 + fq * 8); } \
        VO = *(const u32x2*)(VTT + gbx + (size_t)(h * 128 + 16 * w + fr) * 16 + 4 * fq); KT = *(const u32x2*)(KTT + gbx + (size_t)(h * 128 + 16 * w + fr) * 16 + 4 * fq); \
        _Pragma("unroll") for (int vt = 0; vt < 8; ++vt) VF[vt] = *(const u32x2*)(VTT + gbx + (size_t)(h * 128 + 16 * vt + fr) * 16 + 4 * fq); \
        DE = *(const f32x4*)(LDEC + (size_t)(rbx >> 4) * 512 + h * 128 + 16 * w + 4 * fq); } while (0)
    HG_LOAD(qf, kf, vown, ktf, vf, dec, rowbase);
    for (int blk = 0; blk < nblk; ++blk) {
        const int rb = rowbase + 16 * blk;
        bf16_t* sl = (bf16_t*)(ldsg + (blk & 1) * (128 * PITCH * 2));
#pragma unroll
        for (int vt = 0; vt < 8; ++vt) st_bf4(sl + (16 * vt + fr) * PITCH + 16 * w + 4 * fq, S[vt]);
        bf16x8 qn[4], kn[4]; u32x2 vown_n, ktf_n, vfn[8]; f32x4 dec_n;
        HG_LOAD(qn, kn, vown_n, ktf_n, vfn, dec_n, rowbase + 16 * (blk + 1 < nblk ? blk + 1 : blk));
        __syncthreads();
        f32x4 o = {0.f, 0.f, 0.f, 0.f}, pt = {0.f, 0.f, 0.f, 0.f};
#pragma unroll
        for (int ks = 0; ks < 4; ++ks) { const bf16x8 sf = *(const bf16x8*)(sl + (16 * w + fr) * PITCH + ks * 32 + fq * 8); o = mfma16(qf[ks], sf, o); pt = mfma16(kf[ks], qf[ks], pt); }
#pragma unroll
        for (int j = 0; j < 4; ++j) if (4 * fq + j > fr) pt[j] = 0.f;
        u32x2 pp; pp.x = cvt_pk_bf16(pt[0], pt[1]); pp.y = cvt_pk_bf16(pt[2], pt[3]);
        o = mfma16(mk8(pp, z2), mk8(vown, z2), o);
#pragma unroll
        for (int j = 0; j < 4; ++j) OB[(size_t)(rb + 4 * fq + j) * 512 + h * 128 + 16 * w + fr] = bf1(o[j]);
        const bf16x8 ka = mk8(ktf, z2);
#pragma unroll
        for (int vt = 0; vt < 8; ++vt) { S[vt] = S[vt] * dec; S[vt] = mfma16(ka, mk8(vf[vt], z2), S[vt]); }
#pragma unroll
        for (int ks = 0; ks < 4; ++ks) { qf[ks] = qn[ks]; kf[ks] = kn[ks]; }
        vown = vown_n; ktf = ktf_n; dec = dec_n;
#pragma unroll
        for (int vt = 0; vt < 8; ++vt) vf[vt] = vfn[vt];
    }
#undef HG_LOAD
#pragma unroll
    for (int vt = 0; vt < 8; ++vt)
#pragma unroll
        for (int j = 0; j < 4; ++j) Sout[(size_t)(16 * w + 4 * fq + j) * 128 + 16 * vt + fr] = S[vt][j];
    __syncthreads();
}

__device__ __forceinline__ void hgrn_prompt(const int wvs, unsigned char* ws, unsigned char* ldsg, int rowbase, float* Sout, int h) {
    int tid_; asm volatile("v_mbcnt_lo_u32_b32 %0, -1, 0\n\tv_mbcnt_hi_u32_b32 %0, -1, %0" : "=v"(tid_)); tid_ += wvs * 64;
    const int tid = tid_, lane = tid & 63, w = tid >> 6, fr = lane & 15, fq = lane >> 4;
    constexpr int PITCH = 136, SBUF = 128 * PITCH * 2, QP = 136, SLOT = 2 * 16 * QP * 2 + 2 * 4096 + 512, NBLK = 128, DEP = 8;
    const bf16_t* QT = (const bf16_t*)(ws + R_QT); const bf16_t* KH = (const bf16_t*)(ws + R_KH); const bf16_t* KTT = (const bf16_t*)(ws + R_KTT); const bf16_t* VTT = (const bf16_t*)(ws + R_VTT);
    const float* LDEC = (const float*)(ws + R_LDEC); bf16_t* OB = (bf16_t*)(ws + R_OB);
    unsigned char* ring = ldsg + 2 * SBUF;
    const int t2 = tid & 255; const bool lo = tid < 256;
    const bf16_t* gA = (lo ? QT : KH) + (size_t)(rowbase + (t2 >> 4)) * 512 + h * 128 + (t2 & 15) * 8;
    const bf16_t* gB = (lo ? VTT : KTT) + (size_t)(rowbase >> 4) * 8192 + (size_t)h * 128 * 16 + t2 * 8;
    const float* gD = LDEC + (size_t)(rowbase >> 4) * 512 + h * 128 + (tid & 31) * 4;
    const int lA = (lo ? 0 : 16 * QP * 2) + ((t2 >> 4) * QP + (t2 & 15) * 8) * 2, lB = 2 * 16 * QP * 2 + (lo ? 0 : 4096) + t2 * 16, lD = 2 * 16 * QP * 2 + 8192 + (tid & 31) * 16;
    u32x4 ra[DEP], rb_[DEP]; f32x4 rd[DEP];
#pragma unroll
    for (int s = 0; s < DEP; ++s) { ra[s] = *(const u32x4*)(gA + (size_t)s * 8192); rb_[s] = *(const u32x4*)(gB + (size_t)s * 8192); rd[s] = *(const f32x4*)(gD + (size_t)s * 512); }
    f32x4 S[8];
#pragma unroll
    for (int vt = 0; vt < 8; ++vt) S[vt] = (f32x4){0.f, 0.f, 0.f, 0.f};
    const u32x2 z2 = {0u, 0u};
    *(u32x4*)(ring + lA) = ra[0]; *(u32x4*)(ring + lB) = rb_[0]; if (tid < 32) *(f32x4*)(ring + lD) = rd[0];
    ra[0] = *(const u32x4*)(gA + (size_t)DEP * 8192); rb_[0] = *(const u32x4*)(gB + (size_t)DEP * 8192); rd[0] = *(const f32x4*)(gD + (size_t)DEP * 512);
    for (int b0 = 0; b0 < NBLK; b0 += DEP) {
#pragma unroll
        for (int s = 0; s < DEP; ++s) {
            const int blk = b0 + s, rb = rowbase + 16 * blk;
            bf16_t* sl = (bf16_t*)(ldsg + (blk & 1) * SBUF);
#pragma unroll
            for (int vt = 0; vt < 8; ++vt) st_bf4(sl + (16 * vt + fr) * PITCH + 16 * w + 4 * fq, S[vt]);
            asm volatile("s_waitcnt lgkmcnt(0)" ::: "memory"); __builtin_amdgcn_s_barrier(); asm volatile("" ::: "memory");
            { constexpr int dummy = 0; (void)dummy; const int sn = (s + 1) % DEP; unsigned char* slot = ring + ((blk + 1) & 1) * SLOT;
              *(u32x4*)(slot + lA) = ra[sn]; *(u32x4*)(slot + lB) = rb_[sn]; if (tid < 32) *(f32x4*)(slot + lD) = rd[sn];
              const int nb = blk + 1 + DEP < NBLK ? blk + 1 + DEP : NBLK - 1;
              ra[sn] = *(const u32x4*)(gA + (size_t)nb * 8192); rb_[sn] = *(const u32x4*)(gB + (size_t)nb * 8192); rd[sn] = *(const f32x4*)(gD + (size_t)nb * 512); }
            const unsigned char* cur = ring + (blk & 1) * SLOT; const bf16_t* Qs = (const bf16_t*)cur; const bf16_t* Ks = (const bf16_t*)(cur + 16 * QP * 2); const bf16_t* Vs = (const bf16_t*)(cur + 2 * 16 * QP * 2); const bf16_t* KTs = Vs + 2048;
            const f32x4 dec = *(const f32x4*)(cur + 2 * 16 * QP * 2 + 8192 + (16 * w + 4 * fq) * 4);
            f32x4 o = {0.f, 0.f, 0.f, 0.f}, pt = {0.f, 0.f, 0.f, 0.f};
#pragma unroll
            for (int ks = 0; ks < 4; ++ks) { const bf16x8 qf = *(const bf16x8*)(Qs + fr * QP + ks * 32 + fq * 8), kf = *(const bf16x8*)(Ks + fr * QP + ks * 32 + fq * 8);
                const bf16x8 sf = *(const bf16x8*)(sl + (16 * w + fr) * PITCH + ks * 32 + fq * 8); o = mfma16(qf, sf, o); pt = mfma16(kf, qf, pt); }
#pragma unroll
            for (int j = 0; j < 4; ++j) if (4 * fq + j > fr) pt[j] = 0.f;
            u32x2 pp; pp.x = cvt_pk_bf16(pt[0], pt[1]); pp.y = cvt_pk_bf16(pt[2], pt[3]);
            o = mfma16(mk8(pp, z2), mk8(*(const u32x2*)(Vs + (16 * w + fr) * 16 + 4 * fq), z2), o);
#pragma unroll
            for (int j = 0; j < 4; ++j) OB[(size_t)(rb + 4 * fq + j) * 512 + h * 128 + 16 * w + fr] = bf1(o[j]);
            const bf16x8 ka = mk8(*(const u32x2*)(KTs + (16 * w + fr) * 16 + 4 * fq), z2);
#pragma unroll
            for (int vt = 0; vt < 8; ++vt) { S[vt] = S[vt] * dec; S[vt] = mfma16(ka, mk8(*(const u32x2*)(Vs + (16 * vt + fr) * 16 + 4 * fq), z2), S[vt]); }
        }
    }
#pragma unroll
    for (int vt = 0; vt < 8; ++vt)
#pragma unroll
        for (int j = 0; j < 4; ++j) Sout[(size_t)(16 * w + 4 * fq + j) * 128 + 16 * vt + fr] = S[vt][j];
    __syncthreads();
}

__device__ __forceinline__ void s5_task(const int wvs, unsigned char* ws, unsigned char* ldsw, const float* dvec, int rowbase, int nblk, const float* x0re, const float* x0im, float* ore, float* oim, int g) {
    int tid_; asm volatile("v_mbcnt_lo_u32_b32 %0, -1, 0\n\tv_mbcnt_hi_u32_b32 %0, -1, %0" : "=v"(tid_)); tid_ += wvs * 64;
    const int lane = tid_ & 63, fr = lane & 15, fq = lane >> 4;
    constexpr int BP = 132, XP = 136;
    float* buf = (float*)ldsw; bf16_t* xb = (bf16_t*)(ldsw + 16 * BP * 4);
    const bf16_t* UB = (const bf16_t*)(ws + R_UB); bf16_t* ZB = (bf16_t*)(ws + R_ZB);
    const f32x2 lam = ((const f32x2*)(ws + T_LAMBAR))[g * 64 + lane];
    float xr = x0re ? x0re[lane] : 0.f, xi = x0im ? x0im[lane] : 0.f;
    const u32x2 z2 = {0u, 0u};
    bf16x8 Bf[8], Cf[4];
#pragma unroll
    for (int nt = 0; nt < 8; ++nt) Bf[nt] = mk8(*(const u32x2*)((const bf16_t*)(ws + T_BBT) + (size_t)(g * 128 + 16 * nt + fr) * 16 + 4 * fq), z2);
#pragma unroll
    for (int ks = 0; ks < 4; ++ks) Cf[ks] = *(const bf16x8*)((const bf16_t*)(ws + T_CCT) + (size_t)(g * 16 + fr) * 128 + 32 * ks + 8 * fq);
    const float dv = dvec[g * 16 + fr];
    u32x2 ucur = *(const u32x2*)(UB + (size_t)(rowbase + fr) * 512 + g * 16 + 4 * fq);
    unsigned short uv[4];
#pragma unroll
    for (int j = 0; j < 4; ++j) uv[j] = UB[(size_t)(rowbase + 4 * fq + j) * 512 + g * 16 + fr];
    for (int blk = 0; blk < nblk; ++blk) {
        const int rb = rowbase + 16 * blk; const int rbn = rowbase + 16 * (blk + 1 < nblk ? blk + 1 : blk);
        const bf16x8 uf = mk8(ucur, z2);
        const u32x2 unext = *(const u32x2*)(UB + (size_t)(rbn + fr) * 512 + g * 16 + 4 * fq);
        unsigned short uvn[4];
#pragma unroll
        for (int j = 0; j < 4; ++j) uvn[j] = UB[(size_t)(rbn + 4 * fq + j) * 512 + g * 16 + fr];
#pragma unroll
        for (int nt = 0; nt < 8; ++nt) { const f32x4 d = mfma16(uf, Bf[nt], (f32x4){0.f, 0.f, 0.f, 0.f});
#pragma unroll
            for (int j = 0; j < 4; ++j) buf[(4 * fq + j) * BP + 16 * nt + fr] = d[j]; }
        LDSWAIT();
#pragma unroll
        for (int t = 0; t < 16; ++t) { const float br = buf[t * BP + lane], bi = buf[t * BP + 64 + lane];
            const float nr = lam.x * xr - lam.y * xi + br, ni = lam.x * xi + lam.y * xr + bi; xr = nr; xi = ni;
            xb[t * XP + lane] = bf1(nr); xb[t * XP + 64 + lane] = bf1(ni); }
        LDSWAIT();
        f32x4 y = {0.f, 0.f, 0.f, 0.f};
#pragma unroll
        for (int ks = 0; ks < 4; ++ks) y = mfma16(*(const bf16x8*)(xb + fr * XP + 32 * ks + 8 * fq), Cf[ks], y);
#pragma unroll
        for (int j = 0; j < 4; ++j) { const size_t idx = (size_t)(rb + 4 * fq + j) * 512 + g * 16 + fr; ZB[idx] = bf1(gelu_tanh(y[j] + dv * bf2f(uv[j]))); }
        LDSWAIT();
        ucur = unext;
#pragma unroll
        for (int j = 0; j < 4; ++j) uv[j] = uvn[j];
    }
    ore[lane] = xr; oim[lane] = xi;
}

__device__ __forceinline__ void spatial_unit(const int wvs, const Args& a, unsigned char* ldsg, int rb, int L, int gg, float* vout  ) {
    unsigned char* ws = gp(a.ws);
    int tid_; asm volatile("v_mbcnt_lo_u32_b32 %0, -1, 0\n\tv_mbcnt_hi_u32_b32 %0, -1, %0" : "=v"(tid_)); tid_ += wvs * 64;
    const int tid = tid_, lane = tid & 63, w = tid >> 6, fr = lane & 15, fq = lane >> 4;
    const int TP = L + 8, cm = (L >> 3) - 1;
    bf16_t* T = (bf16_t*)ldsg; const bf16_t* VG = (const bf16_t*)(ws + R_VG); const float* SSV = (const float*)(ws + A_SSV); bf16_t* MIX = (bf16_t*)(ws + R_MIX);
    for (int it = tid; it < L * 16; it += 512) { const int s = it >> 4, dg = it & 15; const int row = rb + s;
        const f32x4 p0 = *(const f32x4*)(SSV + (size_t)row * 8), p1 = *(const f32x4*)(SSV + (size_t)row * 8 + 4); const float rs = rsqrtf((sum4(p0) + sum4(p1)) * (1.f / 512.f) + EPS);
        const u32x4 raw = *(const u32x4*)(VG + (size_t)row * 512 + gg * 128 + dg * 8); float v[8];
        v[0] = __uint_as_float(raw.x << 16) * rs; v[1] = __uint_as_float(raw.x & 0xffff0000u) * rs; v[2] = __uint_as_float(raw.y << 16) * rs; v[3] = __uint_as_float(raw.y & 0xffff0000u) * rs;
        v[4] = __uint_as_float(raw.z << 16) * rs; v[5] = __uint_as_float(raw.z & 0xffff0000u) * rs; v[6] = __uint_as_float(raw.w << 16) * rs; v[7] = __uint_as_float(raw.w & 0xffff0000u) * rs;
#pragma unroll
        for (int i = 0; i < 8; ++i) T[(dg * 8 + i) * TP + ((((s >> 3) ^ (dg & cm)) << 3) | (s & 7))] = bf1(v[i]);
        if (vout) { *(f32x4*)(vout + (size_t)s * 512 + gg * 128 + dg * 8) = (f32x4){v[0], v[1], v[2], v[3]}; *(f32x4*)(vout + (size_t)s * 512 + gg * 128 + dg * 8 + 4) = (f32x4){v[4], v[5], v[6], v[7]}; }
    }
    __syncthreads();
    if (16 * w < L) {
        const bf16_t* WS = (const bf16_t*)(ws + T_WS) + (size_t)gg * 16384;
        f32x4 acc[8];
#pragma unroll
        for (int dt = 0; dt < 8; ++dt) acc[dt] = (f32x4){0.f, 0.f, 0.f, 0.f};
        const int nks = (16 * w + 15) / 32 + 1;
        for (int ks = 0; ks < nks; ++ks) { const bf16x8 af = *(const bf16x8*)(WS + (size_t)(16 * w + fr) * 128 + 32 * ks + 8 * fq);
#pragma unroll
            for (int dt = 0; dt < 8; ++dt) acc[dt] = mfma16(af, *(const bf16x8*)(T + (16 * dt + fr) * TP + (((4 * ks + fq) ^ ((2 * dt + (fr >> 3)) & cm)) << 3)), acc[dt]); }
#pragma unroll
        for (int j = 0; j < 4; ++j) { const int t = 16 * w + 4 * fq + j; const float bs = gp(a.in[33])[gg * 128 + t];
#pragma unroll
            for (int dt = 0; dt < 8; ++dt) { const size_t idx = (size_t)(rb + t) * 1024 + gg * 128 + 16 * dt + fr; MIX[idx] = bf1(bf2f(MIX[idx]) * (acc[dt][j] + bs)); } }
    }
    __syncthreads();
}

__device__ __forceinline__ void attn_task(const int wvs, unsigned char* ws, int qrow0, int kvrow0, int nkeys, int L, int head) {
    int tid_; asm volatile("v_mbcnt_lo_u32_b32 %0, -1, 0\n\tv_mbcnt_hi_u32_b32 %0, -1, %0" : "=v"(tid_)); tid_ += wvs * 64;
    const int lane = tid_ & 63, fr = lane & 15, fq = lane >> 4;
    const bf16_t* QF = (const bf16_t*)(ws + R_QF); const bf16_t* KF = (const bf16_t*)(ws + R_KF); const bf16_t* VT = (const bf16_t*)(ws + R_VT);
    const float* SSQN = (const float*)(ws + A_SSQN); const float* SSQR = (const float*)(ws + A_SSQR); bf16_t* MIX = (bf16_t*)(ws + R_MIX);
    const int qrow = qrow0 + fr;
    bf16x8 qf[3];
#pragma unroll
    for (int ks = 0; ks < 3; ++ks) qf[ks] = *(const bf16x8*)(QF + (size_t)qrow * 768 + head * 96 + ks * 32 + fq * 8);
    const float sc = rsqrtf((SSQN[(size_t)qrow * 8 + head] + SSQR[(size_t)qrow * 8 + head]) * (1.f / 96.f) + EPS) * (0.10206207261596575f * 1.4426950408889634f);
    float mrun = -INFINITY, lrun = 0.f; f32x4 o[4];
#pragma unroll
    for (int dt = 0; dt < 4; ++dt) o[dt] = (f32x4){0.f, 0.f, 0.f, 0.f};
    const bf16_t* kp = KF + (size_t)(kvrow0 + fr) * 768 + head * 96 + fq * 8;
    const bf16_t* vp = VT + (size_t)kvrow0 * 512 + (size_t)(head * 64 + fr) * L + 4 * fq;
    bf16x8 ka[2][3]; u32x2 va[4][2];
#define AT_LOAD(KA, VA, k0_) do { const int kx = (k0_); \
        _Pragma("unroll") for (int hf = 0; hf < 2; ++hf) _Pragma("unroll") for (int ks = 0; ks < 3; ++ks) KA[hf][ks] = *(const bf16x8*)(kp + (size_t)(kx + 16 * hf) * 768 + ks * 32); \
        _Pragma("unroll") for (int dt = 0; dt < 4; ++dt) _Pragma("unroll") for (int hf = 0; hf < 2; ++hf) VA[dt][hf] = *(const u32x2*)(vp + (size_t)dt * 16 * L + kx + 16 * hf); } while (0)
    AT_LOAD(ka, va, 0);
    for (int k0 = 0; k0 < nkeys; k0 += 32) {
        bf16x8 kn[2][3]; u32x2 vn[4][2];
        AT_LOAD(kn, vn, (k0 + 32 < nkeys ? k0 + 32 : k0));
        f32x4 st[2];
#pragma unroll
        for (int hf = 0; hf < 2; ++hf) { st[hf] = (f32x4){0.f, 0.f, 0.f, 0.f};
#pragma unroll
            for (int ks = 0; ks < 3; ++ks) st[hf] = mfma16(ka[hf][ks], qf[ks], st[hf]); }
        const f32x4 s0 = st[0] * sc, s1 = st[1] * sc;
        float mx = fmaxf(fmaxf(fmaxf(s0.x, s0.y), fmaxf(s0.z, s0.w)), fmaxf(fmaxf(s1.x, s1.y), fmaxf(s1.z, s1.w)));
        mx = fmaxf(mx, __shfl_xor(mx, 16)); mx = fmaxf(mx, __shfl_xor(mx, 32));
        const float mnew = fmaxf(mrun, mx), alpha = exp2f(mrun - mnew); mrun = mnew;
        f32x4 p0, p1;
#pragma unroll
        for (int j = 0; j < 4; ++j) { p0[j] = exp2f(s0[j] - mnew); p1[j] = exp2f(s1[j] - mnew); }
        float ls = sum4(p0) + sum4(p1); ls += __shfl_xor(ls, 16); ls += __shfl_xor(ls, 32);
        lrun = lrun * alpha + ls;
        u32x2 pa, pb; pa.x = cvt_pk_bf16(p0[0], p0[1]); pa.y = cvt_pk_bf16(p0[2], p0[3]); pb.x = cvt_pk_bf16(p1[0], p1[1]); pb.y = cvt_pk_bf16(p1[2], p1[3]);
        const bf16x8 pf = mk8(pa, pb);
#pragma unroll
        for (int dt = 0; dt < 4; ++dt) { o[dt] = o[dt] * alpha; o[dt] = mfma16(mk8(va[dt][0], va[dt][1]), pf, o[dt]); }
#pragma unroll
        for (int hf = 0; hf < 2; ++hf) {
#pragma unroll
            for (int ks = 0; ks < 3; ++ks) ka[hf][ks] = kn[hf][ks];
#pragma unroll
            for (int dt = 0; dt < 4; ++dt) va[dt][hf] = vn[dt][hf]; }
    }
#undef AT_LOAD
    const float inv = 1.f / lrun;
#pragma unroll
    for (int dt = 0; dt < 4; ++dt) st_bf4(MIX + (size_t)qrow * 1024 + 512 + head * 64 + 16 * dt + 4 * fq, o[dt] * inv);
}

__device__ __forceinline__ void attn_unit(const int wvs, unsigned char* ws, unsigned char* ldsg, int b, int head, int qb) {
    int tid_; asm volatile("v_mbcnt_lo_u32_b32 %0, -1, 0\n\tv_mbcnt_hi_u32_b32 %0, -1, %0" : "=v"(tid_)); tid_ += wvs * 64;
    const int tid = tid_, lane = tid & 63, w = tid >> 6, fr = lane & 15, fq = lane >> 4;
    constexpr int KP = 104, VP = 72, KB_BYTES = 64 * KP * 2, VB_BYTES = 64 * VP * 2;
    const bf16_t* QF = (const bf16_t*)(ws + R_QF); const bf16_t* KF = (const bf16_t*)(ws + R_KF); const bf16_t* VT = (const bf16_t*)(ws + R_VT);
    const float* SSQN = (const float*)(ws + A_SSQN); const float* SSQR = (const float*)(ws + A_SSQR); bf16_t* MIX = (bf16_t*)(ws + R_MIX);
    const int kvrow0 = b * 2048, qrow = b * 2048 + qb * 128 + w * 16 + fr;
    const int ntiles = 2 * qb + 2, mytiles = 2 * qb + 1 + (w >> 2);
    bf16x8 qf[3];
#pragma unroll
    for (int ks = 0; ks < 3; ++ks) qf[ks] = *(const bf16x8*)(QF + (size_t)qrow * 768 + head * 96 + ks * 32 + fq * 8);
    const float sc = rsqrtf((SSQN[(size_t)qrow * 8 + head] + SSQR[(size_t)qrow * 8 + head]) * (1.f / 96.f) + EPS) * (0.10206207261596575f * 1.4426950408889634f);
    float mrun = -INFINITY, lrun = 0.f; f32x4 o[4];
#pragma unroll
    for (int dt = 0; dt < 4; ++dt) o[dt] = (f32x4){0.f, 0.f, 0.f, 0.f};
    const int kr0 = tid / 12, kc0 = tid - kr0 * 12, id1 = tid + 512, kr1 = id1 / 12, kc1 = id1 - kr1 * 12; const bool has1 = tid < 256;
    const bf16_t* kg0 = KF + (size_t)(kvrow0 + kr0) * 768 + head * 96 + kc0 * 8; const bf16_t* kg1 = KF + (size_t)(kvrow0 + kr1) * 768 + head * 96 + kc1 * 8;
    const bf16_t* vg = VT + (size_t)kvrow0 * 512 + (size_t)(head * 64 + (tid >> 3)) * 2048 + (tid & 7) * 8;
    const int kl0 = kr0 * KP + kc0 * 8, kl1 = kr1 * KP + kc1 * 8, vl = (tid >> 3) * VP + (tid & 7) * 8;
    u32x4 rk0, rk1 = {0u, 0u, 0u, 0u}, rv;
    rk0 = *(const u32x4*)kg0; if (has1) rk1 = *(const u32x4*)kg1; rv = *(const u32x4*)vg;
    { bf16_t* kb = (bf16_t*)ldsg; bf16_t* vb = (bf16_t*)(ldsg + 2 * KB_BYTES);
      *(u32x4*)(kb + kl0) = rk0; if (has1) *(u32x4*)(kb + kl1) = rk1; *(u32x4*)(vb + vl) = rv; }
    asm volatile("s_waitcnt lgkmcnt(0)" ::: "memory"); __builtin_amdgcn_s_barrier(); asm volatile("" ::: "memory");
    for (int j = 0; j < ntiles; ++j) {
        const bool more = j + 1 < ntiles;
        if (more) { rk0 = *(const u32x4*)(kg0 + (size_t)(j + 1) * 64 * 768); if (has1) rk1 = *(const u32x4*)(kg1 + (size_t)(j + 1) * 64 * 768); rv = *(const u32x4*)(vg + (j + 1) * 64); }
        if (j < mytiles) {
            const bf16_t* kb = (const bf16_t*)(ldsg + (j & 1) * KB_BYTES); const bf16_t* vb = (const bf16_t*)(ldsg + 2 * KB_BYTES + (j & 1) * VB_BYTES);
            f32x4 st[4];
#pragma unroll
            for (int g = 0; g < 4; ++g) { st[g] = (f32x4){0.f, 0.f, 0.f, 0.f};
#pragma unroll
                for (int ks = 0; ks < 3; ++ks) st[g] = mfma16(*(const bf16x8*)(kb + (16 * g + fr) * KP + ks * 32 + fq * 8), qf[ks], st[g]); }
            float mx = -INFINITY;
#pragma unroll
            for (int g = 0; g < 4; ++g) { st[g] = st[g] * sc; mx = fmaxf(mx, fmaxf(fmaxf(st[g].x, st[g].y), fmaxf(st[g].z, st[g].w))); }
            mx = fmaxf(mx, __shfl_xor(mx, 16)); mx = fmaxf(mx, __shfl_xor(mx, 32));
            const float mnew = fmaxf(mrun, mx), alpha = __builtin_amdgcn_exp2f(mrun - mnew); mrun = mnew;
            float ls = 0.f;
#pragma unroll
            for (int g = 0; g < 4; ++g) {
#pragma unroll
                for (int jj = 0; jj < 4; ++jj) { st[g][jj] = __builtin_amdgcn_exp2f(st[g][jj] - mnew); ls += st[g][jj]; } }
            ls += __shfl_xor(ls, 16); ls += __shfl_xor(ls, 32);
            lrun = lrun * alpha + ls;
#pragma unroll
            for (int dt = 0; dt < 4; ++dt) o[dt] = o[dt] * alpha;
#pragma unroll
            for (int s = 0; s < 2; ++s) {
                u32x2 pa, pb; pa.x = cvt_pk_bf16(st[2 * s][0], st[2 * s][1]); pa.y = cvt_pk_bf16(st[2 * s][2], st[2 * s][3]); pb.x = cvt_pk_bf16(st[2 * s + 1][0], st[2 * s + 1][1]); pb.y = cvt_pk_bf16(st[2 * s + 1][2], st[2 * s + 1][3]);
                const bf16x8 pf = mk8(pa, pb);
#pragma unroll
                for (int dt = 0; dt < 4; ++dt) { const u32x2 v0 = *(const u32x2*)(vb + (16 * dt + fr) * VP + 32 * s + 4 * fq), v1 = *(const u32x2*)(vb + (16 * dt + fr) * VP + 32 * s + 16 + 4 * fq);
                    o[dt] = mfma16(mk8(v0, v1), pf, o[dt]); }
            }
        }
        if (more) { bf16_t* kb = (bf16_t*)(ldsg + ((j + 1) & 1) * KB_BYTES); bf16_t* vb = (bf16_t*)(ldsg + 2 * KB_BYTES + ((j + 1) & 1) * VB_BYTES);
            *(u32x4*)(kb + kl0) = rk0; if (has1) *(u32x4*)(kb + kl1) = rk1; *(u32x4*)(vb + vl) = rv; }
        asm volatile("s_waitcnt lgkmcnt(0)" ::: "memory"); __builtin_amdgcn_s_barrier(); asm volatile("" ::: "memory");
    }
    const float inv = 1.f / lrun;
#pragma unroll
    for (int dt = 0; dt < 4; ++dt) st_bf4(MIX + (size_t)qrow * 1024 + 512 + head * 64 + 16 * dt + 4 * fq, o[dt] * inv);
}

__device__ __forceinline__ void attn_unit2(const int wvs, unsigned char* ws, unsigned char* ldsg, int b, int head, int qb) {
    int tid_; asm volatile("v_mbcnt_lo_u32_b32 %0, -1, 0\n\tv_mbcnt_hi_u32_b32 %0, -1, %0" : "=v"(tid_)); tid_ += wvs * 64;
    const int tid = tid_, lane = tid & 63, w = tid >> 6, fr = lane & 15, fq = lane >> 4;
    constexpr int KP = 104, VP = 72, KB_BYTES = 64 * KP * 2, VB_BYTES = 64 * VP * 2;
    const bf16_t* QF = (const bf16_t*)(ws + R_QF); const bf16_t* KF = (const bf16_t*)(ws + R_KF); const bf16_t* VT = (const bf16_t*)(ws + R_VT);
    const float* SSQN = (const float*)(ws + A_SSQN); const float* SSQR = (const float*)(ws + A_SSQR); bf16_t* MIX = (bf16_t*)(ws + R_MIX);
    const int kvrow0 = b * 2048, qrow0 = b * 2048 + qb * 256 + w * 32 + fr;
    const int ntiles = 4 * qb + 4, mytiles = 4 * qb + 1 + (w >> 1);
    const float nsm = -((const float*)(ws + A_CTL))[60];
    bf16x8 qf[2][3]; float sc[2], mrun[2], lrun[2]; f32x4 o[2][4];
#pragma unroll
    for (int r = 0; r < 2; ++r) { const int qrow = qrow0 + 16 * r;
#pragma unroll
        for (int ks = 0; ks < 3; ++ks) qf[r][ks] = *(const bf16x8*)(QF + (size_t)qrow * 768 + head * 96 + ks * 32 + fq * 8);
        sc[r] = rsqrtf((SSQN[(size_t)qrow * 8 + head] + SSQR[(size_t)qrow * 8 + head]) * (1.f / 96.f) + EPS) * (0.10206207261596575f * 1.4426950408889634f);
#pragma unroll
        for (int ks = 0; ks < 3; ++ks) { const u32x4 qw = __builtin_bit_cast(u32x4, qf[r][ks]); u32x4 qs;
            qs.x = cvt_pk_bf16(__uint_as_float(qw.x << 16) * sc[r], __uint_as_float(qw.x & 0xffff0000u) * sc[r]); qs.y = cvt_pk_bf16(__uint_as_float(qw.y << 16) * sc[r], __uint_as_float(qw.y & 0xffff0000u) * sc[r]);
            qs.z = cvt_pk_bf16(__uint_as_float(qw.z << 16) * sc[r], __uint_as_float(qw.z & 0xffff0000u) * sc[r]); qs.w = cvt_pk_bf16(__uint_as_float(qw.w << 16) * sc[r], __uint_as_float(qw.w & 0xffff0000u) * sc[r]);
            qf[r][ks] = __builtin_bit_cast(bf16x8, qs); }
        mrun[r] = 0.f; lrun[r] = 0.f;
#pragma unroll
        for (int dt = 0; dt < 4; ++dt) o[r][dt] = (f32x4){0.f, 0.f, 0.f, 0.f}; }
    const int kr0 = tid / 12, kc0 = tid - kr0 * 12, id1 = tid + 512, kr1 = id1 / 12, kc1 = id1 - kr1 * 12; const bool has1 = tid < 256;
    const bf16_t* kg0 = KF + (size_t)(kvrow0 + kr0) * 768 + head * 96 + kc0 * 8; const bf16_t* kg1 = KF + (size_t)(kvrow0 + kr1) * 768 + head * 96 + kc1 * 8;
    const bf16_t* vg = VT + (size_t)kvrow0 * 512 + (size_t)(head * 64 + (tid >> 3)) * 2048 + (tid & 7) * 8;
    const int kl0 = kr0 * KP + kc0 * 8, kl1 = kr1 * KP + kc1 * 8, vl = (tid >> 3) * VP + (tid & 7) * 8;
#define AT_COMPUTE \
        if (j < mytiles) { \
            const bf16_t* kb = (const bf16_t*)(ldsg + (j & 1) * KB_BYTES); const bf16_t* vb = (const bf16_t*)(ldsg + 2 * KB_BYTES + (j & 1) * VB_BYTES); \
            f32x4 st[2][4]; \
_Pragma("unroll") \
            for (int g = 0; g < 4; ++g) { st[0][g] = (f32x4){nsm, nsm, nsm, nsm}; st[1][g] = (f32x4){nsm, nsm, nsm, nsm}; \
_Pragma("unroll") \
                for (int ks = 0; ks < 3; ++ks) { const bf16x8 kf = *(const bf16x8*)(kb + (16 * g + fr) * KP + ks * 32 + fq * 8); st[0][g] = mfma16(kf, qf[0][ks], st[0][g]); st[1][g] = mfma16(kf, qf[1][ks], st[1][g]); } } \
_Pragma("unroll") \
            for (int r = 0; r < 2; ++r) { \
                float ls = 0.f; \
_Pragma("unroll") \
                for (int g = 0; g < 4; ++g) { \
_Pragma("unroll") \
                    for (int jj = 0; jj < 4; ++jj) { st[r][g][jj] = __builtin_amdgcn_exp2f(st[r][g][jj]); ls += st[r][g][jj]; } } \
                lrun[r] += ls; \
            } \
_Pragma("unroll") \
            for (int s = 0; s < 2; ++s) { \
                bf16x8 pf[2]; \
_Pragma("unroll") \
                for (int r = 0; r < 2; ++r) { u32x2 pa, pb; pa.x = cvt_pk_bf16(st[r][2 * s][0], st[r][2 * s][1]); pa.y = cvt_pk_bf16(st[r][2 * s][2], st[r][2 * s][3]); \
                    pb.x = cvt_pk_bf16(st[r][2 * s + 1][0], st[r][2 * s + 1][1]); pb.y = cvt_pk_bf16(st[r][2 * s + 1][2], st[r][2 * s + 1][3]); pf[r] = mk8(pa, pb); } \
_Pragma("unroll") \
                for (int dt = 0; dt < 4; ++dt) { const u32x2 v0 = *(const u32x2*)(vb + (16 * dt + fr) * VP + 32 * s + 4 * fq), v1 = *(const u32x2*)(vb + (16 * dt + fr) * VP + 32 * s + 16 + 4 * fq); \
                    const bf16x8 vf = mk8(v0, v1); o[0][dt] = mfma16(vf, pf[0], o[0][dt]); o[1][dt] = mfma16(vf, pf[1], o[1][dt]); } \
            } \
        }
    u32x4 ak0, ak1 = {0u, 0u, 0u, 0u}, av, bk0, bk1 = {0u, 0u, 0u, 0u}, bv;
    ak0 = *(const u32x4*)kg0; if (has1) ak1 = *(const u32x4*)kg1; av = *(const u32x4*)vg;
    { bf16_t* kb = (bf16_t*)ldsg; bf16_t* vb = (bf16_t*)(ldsg + 2 * KB_BYTES);
      *(u32x4*)(kb + kl0) = ak0; if (has1) *(u32x4*)(kb + kl1) = ak1; *(u32x4*)(vb + vl) = av; }
    ak0 = *(const u32x4*)(kg0 + (size_t)64 * 768); if (has1) ak1 = *(const u32x4*)(kg1 + (size_t)64 * 768); av = *(const u32x4*)(vg + 64);
    asm volatile("s_waitcnt lgkmcnt(0)" ::: "memory"); __builtin_amdgcn_s_barrier(); asm volatile("" ::: "memory");
#define AT_STEP(JJ, LK0, LK1, LV, WK0, WK1, WV) { const int j = (JJ); \
        { const int jn = j + 2 < ntiles ? j + 2 : ntiles - 1; LK0 = *(const u32x4*)(kg0 + (size_t)jn * 64 * 768); if (has1) LK1 = *(const u32x4*)(kg1 + (size_t)jn * 64 * 768); LV = *(const u32x4*)(vg + jn * 64); } \
        AT_COMPUTE \
        { bf16_t* kb = (bf16_t*)(ldsg + ((j + 1) & 1) * KB_BYTES); bf16_t* vb = (bf16_t*)(ldsg + 2 * KB_BYTES + ((j + 1) & 1) * VB_BYTES); \
          *(u32x4*)(kb + kl0) = WK0; if (has1) *(u32x4*)(kb + kl1) = WK1; *(u32x4*)(vb + vl) = WV; } \
        asm volatile("s_waitcnt lgkmcnt(0)" ::: "memory"); __builtin_amdgcn_s_barrier(); asm volatile("" ::: "memory"); }
    for (int j2 = 0; j2 < ntiles; j2 += 2) {
        AT_STEP(j2, bk0, bk1, bv, ak0, ak1, av)
        AT_STEP(j2 + 1, ak0, ak1, av, bk0, bk1, bv)
    }
#undef AT_STEP
#undef AT_COMPUTE
#pragma unroll
    for (int r = 0; r < 2; ++r) { float lt = lrun[r]; lt += __shfl_xor(lt, 16); lt += __shfl_xor(lt, 32); const float inv = 1.f / lt;
#pragma unroll
        for (int dt = 0; dt < 4; ++dt) st_bf4(MIX + (size_t)(qrow0 + 16 * r) * 1024 + 512 + head * 64 + 16 * dt + 4 * fq, o[r][dt] * inv); }
}

__device__ __forceinline__ void attn_sample(const int wvs, unsigned char* ws, unsigned char* ldsg, int b, int head) {
    int tid_; asm volatile("v_mbcnt_lo_u32_b32 %0, -1, 0\n\tv_mbcnt_hi_u32_b32 %0, -1, %0" : "=v"(tid_)); tid_ += wvs * 64;
    const int lane = tid_ & 63, w = tid_ >> 6, fr = lane & 15, fq = lane >> 4, sub = w & 1, kq = w >> 1;
    const bf16_t* QF = (const bf16_t*)(ws + R_QF); const bf16_t* KF = (const bf16_t*)(ws + R_KF); const bf16_t* VT = (const bf16_t*)(ws + R_VT);
    const float* SSQN = (const float*)(ws + A_SSQN); const float* SSQR = (const float*)(ws + A_SSQR); bf16_t* MIX = (bf16_t*)(ws + R_MIX);
    constexpr int L = 1056;
    const int qrow = MP + b * 32 + sub * 16 + fr, kvrow0 = MP + b * L;
    const float nsm = -((const float*)(ws + A_CTL))[60];
    const float sc = rsqrtf((SSQN[(size_t)qrow * 8 + head] + SSQR[(size_t)qrow * 8 + head]) * (1.f / 96.f) + EPS) * (0.10206207261596575f * 1.4426950408889634f);
    bf16x8 qf[3];
#pragma unroll
    for (int ks = 0; ks < 3; ++ks) { const u32x4 qw = *(const u32x4*)(QF + (size_t)qrow * 768 + head * 96 + ks * 32 + fq * 8); u32x4 qs;
        qs.x = cvt_pk_bf16(__uint_as_float(qw.x << 16) * sc, __uint_as_float(qw.x & 0xffff0000u) * sc); qs.y = cvt_pk_bf16(__uint_as_float(qw.y << 16) * sc, __uint_as_float(qw.y & 0xffff0000u) * sc);
        qs.z = cvt_pk_bf16(__uint_as_float(qw.z << 16) * sc, __uint_as_float(qw.z & 0xffff0000u) * sc); qs.w = cvt_pk_bf16(__uint_as_float(qw.w << 16) * sc, __uint_as_float(qw.w & 0xffff0000u) * sc);
        qf[ks] = __builtin_bit_cast(bf16x8, qs); }
    f32x4 o[4]; float lsum = 0.f;
#pragma unroll
    for (int dt = 0; dt < 4; ++dt) o[dt] = (f32x4){0.f, 0.f, 0.f, 0.f};
    const int s0 = kq == 0 ? 0 : 9 + 8 * (kq - 1), s1 = 9 + 8 * kq;
    const bf16_t* kp = KF + (size_t)(kvrow0 + fr) * 768 + head * 96 + fq * 8;
    const bf16_t* vp = VT + (size_t)kvrow0 * 512 + (size_t)(head * 64 + fr) * L + 4 * fq;
    bf16x8 ka[2][3]; u32x2 va[4][2];
#define AS_LOAD(KA, VA, k0_) do { const int kx = (k0_); \
        _Pragma("unroll") for (int hf = 0; hf < 2; ++hf) _Pragma("unroll") for (int ks = 0; ks < 3; ++ks) KA[hf][ks] = *(const bf16x8*)(kp + (size_t)(kx + 16 * hf) * 768 + ks * 32); \
        _Pragma("unroll") for (int dt = 0; dt < 4; ++dt) _Pragma("unroll") for (int hf = 0; hf < 2; ++hf) VA[dt][hf] = *(const u32x2*)(vp + (size_t)dt * 16 * L + kx + 16 * hf); } while (0)
    AS_LOAD(ka, va, 32 * s0);
    for (int s = s0; s < s1; ++s) {
        bf16x8 kn[2][3]; u32x2 vn[4][2];
        AS_LOAD(kn, vn, 32 * (s + 1 < s1 ? s + 1 : s));
        f32x4 st[2];
#pragma unroll
        for (int hf = 0; hf < 2; ++hf) { st[hf] = (f32x4){nsm, nsm, nsm, nsm};
#pragma unroll
            for (int ks = 0; ks < 3; ++ks) st[hf] = mfma16(ka[hf][ks], qf[ks], st[hf]); }
#pragma unroll
        for (int hf = 0; hf < 2; ++hf)
#pragma unroll
            for (int j = 0; j < 4; ++j) { st[hf][j] = __builtin_amdgcn_exp2f(st[hf][j]); lsum += st[hf][j]; }
        u32x2 pa, pb; pa.x = cvt_pk_bf16(st[0][0], st[0][1]); pa.y = cvt_pk_bf16(st[0][2], st[0][3]); pb.x = cvt_pk_bf16(st[1][0], st[1][1]); pb.y = cvt_pk_bf16(st[1][2], st[1][3]);
        const bf16x8 pf = mk8(pa, pb);
#pragma unroll
        for (int dt = 0; dt < 4; ++dt) o[dt] = mfma16(mk8(va[dt][0], va[dt][1]), pf, o[dt]);
#pragma unroll
        for (int hf = 0; hf < 2; ++hf) {
#pragma unroll
            for (int ks = 0; ks < 3; ++ks) ka[hf][ks] = kn[hf][ks];
#pragma unroll
            for (int dt = 0; dt < 4; ++dt) va[dt][hf] = vn[dt][hf]; }
    }
#undef AS_LOAD
    float* part = (float*)ldsg + (size_t)(w * 64 + lane) * 17;
#pragma unroll
    for (int dt = 0; dt < 4; ++dt)
#pragma unroll
        for (int j = 0; j < 4; ++j) part[dt * 4 + j] = o[dt][j];
    part[16] = lsum;
    __syncthreads();
    if (kq == 0) {
#pragma unroll
        for (int q2 = 1; q2 < 4; ++q2) { const float* pp = (const float*)ldsg + (size_t)((sub + 2 * q2) * 64 + lane) * 17;
#pragma unroll
            for (int dt = 0; dt < 4; ++dt)
#pragma unroll
                for (int j = 0; j < 4; ++j) o[dt][j] += pp[dt * 4 + j];
            lsum += pp[16]; }
        lsum += __shfl_xor(lsum, 16); lsum += __shfl_xor(lsum, 32);
        const float inv = 1.f / lsum;
#pragma unroll
        for (int dt = 0; dt < 4; ++dt) st_bf4(MIX + (size_t)qrow * 1024 + 512 + head * 64 + 16 * dt + 4 * fq, o[dt] * inv);
    }
    __syncthreads();
}

struct OneUnit { int pm, pn; bool has;
    __device__ __forceinline__ bool next(int i, Unit& u) const { if (i != 0 || !has) return false; u.pm = pm; u.pn = pn; return true; }
    __device__ __forceinline__ void a_ready(const Unit&) const {}
    __device__ __forceinline__ void done(const Unit&) const {} };
struct EpiPart { static constexpr bool PERM = false, AFTER_DRAIN = false; float* P;
    __device__ __forceinline__ void operator()(const f32x4 (&acc)[2][2][4][2], const Unit& u, int wr, int wc, int fr, int fq) const {
        asm volatile("" : "+v"(fr), "+v"(fq));
        const int t = (wr * 4 + wc) * 64 + fq * 16 + fr;
#pragma unroll
        for (int ai = 0; ai < 2; ++ai)
#pragma unroll
            for (int bj = 0; bj < 2; ++bj)
#pragma unroll
                for (int m = 0; m < 4; ++m)
#pragma unroll
                    for (int n = 0; n < 2; ++n) *(f32x4*)(P + ((size_t)((((ai * 2 + bj) * 4 + m) * 2 + n) * 512 + t)) * 4) = acc[ai][bj][m][n];
    } };
__device__ __forceinline__ void res_gemm(const int wvs, LAS unsigned char* ldsl, const bf16_t* A, const bf16_t* Bt, int K, int KS, const EpiRes& E, float* part, unsigned* cnt, int G, int bid) {
    const int NS = K / KS, NSU = 16 * NS;
    if (G < NSU || G * 8 < 1024) {
        pg8::Gemm g{A, Bt, M, 1024, K}; pg8::StaticOrder S; S.init(M, 1024, G, bid); pg8::gemm_phase<EpiRes, pg8::StaticOrder, true, true>(ldsl, g, S, E, wvs); return; }
    { const int su = bid, unit = su / NS, sl = su - unit * NS;
      pg8::Gemm g{A + (size_t)MP * K + (size_t)sl * KS, Bt + (size_t)sl * KS, MS, 1024, K, KS}; OneUnit S{unit >> 2, unit & 3, su < NSU};
      EpiPart EP{part + (size_t)su * 65536};
      pg8::gemm_phase<EpiPart, OneUnit, false, true>(ldsl, g, S, EP, wvs);
      int tid_; asm volatile("v_mbcnt_lo_u32_b32 %0, -1, 0\n\tv_mbcnt_hi_u32_b32 %0, -1, %0" : "=v"(tid_)); tid_ += wvs * 64;
      if (su < NSU) { asm volatile("s_waitcnt vmcnt(0)" ::: "memory"); __syncthreads();
          if (tid_ == 0) { __builtin_amdgcn_fence(__ATOMIC_RELEASE, "agent"); asm volatile("s_waitcnt vmcnt(0)" ::: "memory"); __hip_atomic_fetch_add(cnt, 1u, __ATOMIC_RELAXED, __HIP_MEMORY_SCOPE_AGENT); } } }
    { pg8::Gemm g{A, Bt, MP, 1024, K}; pg8::StaticOrder S; S.init(MP, 1024, G, bid); pg8::gemm_phase<EpiRes, pg8::StaticOrder, true, true>(ldsl, g, S, E, wvs); }
    { int lane_; asm volatile("v_mbcnt_lo_u32_b32 %0, -1, 0\n\tv_mbcnt_hi_u32_b32 %0, -1, %0" : "=v"(lane_));
      const int gw = bid * 8 + wvs;
      if (gw < 1024) {
          if (lane_ == 0) { while (__hip_atomic_load(cnt, __ATOMIC_RELAXED, __HIP_MEMORY_SCOPE_AGENT) < (unsigned)NSU) __builtin_amdgcn_s_sleep(2); }
          __builtin_amdgcn_fence(__ATOMIC_ACQUIRE, "agent"); asm volatile("s_waitcnt vmcnt(0)" ::: "memory");
          const int unit = gw >> 6, am = (gw >> 3) & 7, wv = gw & 7, ai = am >> 2, m = am & 3, t = wv * 64 + lane_, wr = wv >> 2, wc = wv & 3, fr = lane_ & 15, fq = lane_ >> 4;
          f32x4 v[2][2];
#pragma unroll
          for (int bj = 0; bj < 2; ++bj)
#pragma unroll
              for (int n = 0; n < 2; ++n) v[bj][n] = (f32x4){0.f, 0.f, 0.f, 0.f};
#pragma unroll 4
          for (int s = 0; s < NS; ++s) { const float* P = part + (size_t)(unit * NS + s) * 65536;
#pragma unroll
              for (int bj = 0; bj < 2; ++bj)
#pragma unroll
                  for (int n = 0; n < 2; ++n) v[bj][n] += *(const f32x4*)(P + ((size_t)((((ai * 2 + bj) * 4 + m) * 2 + n) * 512 + t)) * 4); }
          E.do_row((128 + (unit >> 2)) * 256 + ai * 128 + wr * 64 + m * 16 + fr, unit & 3, wc, fq, v[0][0], v[0][1], v[1][0], v[1][1]);
      } }
}

__device__ __forceinline__ void grid_bar(unsigned* ctl, unsigned k, const int wvs) {
    int tid_; asm volatile("v_mbcnt_lo_u32_b32 %0, -1, 0\n\tv_mbcnt_hi_u32_b32 %0, -1, %0" : "=v"(tid_)); tid_ += wvs * 64;
    asm volatile("s_waitcnt vmcnt(0) lgkmcnt(0)" ::: "memory");
    __syncthreads();
    if (tid_ == 0) {
        const unsigned G = gridDim.x;
        __builtin_amdgcn_fence(__ATOMIC_RELEASE, "agent");
        asm volatile("s_waitcnt vmcnt(0)" ::: "memory");
        if ((G & 7u) == 0u) {
            const unsigned x = blockIdx.x & 7u, gs = G >> 3; unsigned* arr = ctl + 256 + 64 * x; unsigned* rel = ctl + 1024 + 64 * x; unsigned* top = ctl + 128;
            const unsigned old = __hip_atomic_fetch_add(arr, 1u, __ATOMIC_RELAXED, __HIP_MEMORY_SCOPE_AGENT);
            if (old + 1u == gs * k) {
                __hip_atomic_fetch_add(top, 1u, __ATOMIC_RELAXED, __HIP_MEMORY_SCOPE_AGENT);
                while (__hip_atomic_load(top, __ATOMIC_RELAXED, __HIP_MEMORY_SCOPE_AGENT) < 8u * k) __builtin_amdgcn_s_sleep(1);
                __hip_atomic_fetch_add(rel, 1u, __ATOMIC_RELAXED, __HIP_MEMORY_SCOPE_AGENT);
            } else { while (__hip_atomic_load(rel, __ATOMIC_RELAXED, __HIP_MEMORY_SCOPE_AGENT) < k) __builtin_amdgcn_s_sleep(1); }
        } else {
            __hip_atomic_fetch_add(ctl, 1u, __ATOMIC_RELAXED, __HIP_MEMORY_SCOPE_AGENT);
            while (__hip_atomic_load(ctl, __ATOMIC_RELAXED, __HIP_MEMORY_SCOPE_AGENT) < G * k) __builtin_amdgcn_s_sleep(2);
        }
        __builtin_amdgcn_fence(__ATOMIC_ACQUIRE, "agent");
        asm volatile("s_waitcnt vmcnt(0)" ::: "memory");
    }
    __syncthreads();
}

#define XB_TMO      128
#define XB_XCNT(j)  (256  + 64 * (j))
#define XB_XSUB(j)  (1280 + 64 * (j))
#define XB_XGEN(j)  (2304 + 64 * (j))
#define XB_TOP      3328
#define XB_TOPGEN   3392
#define XCD_BAR_WORDS 3456
#define XB_SPIN_CAP (1u << 18)

__device__ __forceinline__ unsigned xb_ld(unsigned* p)              { return __hip_atomic_load(p, __ATOMIC_RELAXED, __HIP_MEMORY_SCOPE_AGENT); }
__device__ __forceinline__ unsigned xb_add(unsigned* p, unsigned v) { return __hip_atomic_fetch_add(p, v, __ATOMIC_RELAXED, __HIP_MEMORY_SCOPE_AGENT); }
__device__ __forceinline__ unsigned xb_xcc_id() { return (unsigned)__builtin_amdgcn_s_getreg((3 << 11) | 20) & 0xFu; }
#define XB_SPIN(cond, bar) do { unsigned _sp = 0; while (cond) { __builtin_amdgcn_s_sleep(1); \
    if ((++_sp & 255u) == 0u) { if (xb_ld(&(bar)[XB_TMO])) break; if (_sp > XB_SPIN_CAP) { atomicAdd(&(bar)[XB_TMO], 1u); break; } } } } while (0)

struct XcdBarrier {
    unsigned* bar; unsigned x;
    volatile LAS unsigned* st;
};

__device__ __forceinline__ XcdBarrier xcd_barrier_post(unsigned* bar, volatile LAS unsigned* st, const bool is_t0) {
    XcdBarrier b; b.bar = bar; b.x = xb_xcc_id(); b.st = st;
    if (is_t0) (void)xb_add(&bar[XB_XCNT(b.x)], 1u);
    return b;
}
__device__ __forceinline__ void xcd_barrier_complete(unsigned* bar, unsigned x, unsigned& nloc, unsigned& nx) {
    const unsigned G = gridDim.x * gridDim.y * gridDim.z;
    unsigned sum, cnt, mine, sp = 0u;
    for (;;) {
        sum = 0u; cnt = 0u; mine = 0u;
#pragma unroll
        for (unsigned j = 0; j < 16; ++j) { const unsigned c = xb_ld(&bar[XB_XCNT(j)]); sum += c; cnt += (c > 0u) ? 1u : 0u; mine = (j == x) ? c : mine; }
        if (sum == G) break;
        __builtin_amdgcn_s_sleep(1);
        if ((++sp & 255u) == 0u) { if (xb_ld(&bar[XB_TMO])) break; if (sp > XB_SPIN_CAP) { atomicAdd(&bar[XB_TMO], 1u); break; } }
    }
    nloc = mine > 0u ? mine : 1u; nx = cnt > 0u ? cnt : 1u;
}

__device__ __forceinline__ void xcd_barrier(const XcdBarrier& b, const int wvs) {
    int tid_; asm volatile("v_mbcnt_lo_u32_b32 %0, -1, 0\n\tv_mbcnt_hi_u32_b32 %0, -1, %0" : "=v"(tid_)); tid_ += wvs * 64;
    asm volatile("s_waitcnt vmcnt(0)" ::: "memory");
    __syncthreads();
    if (tid_ == 0) {
        unsigned* bar = b.bar;
        __builtin_amdgcn_s_waitcnt(0);
        unsigned nloc = b.st[0], nx = b.st[1];
        if (nloc == 0u) { xcd_barrier_complete(bar, b.x, nloc, nx); b.st[0] = nloc; b.st[1] = nx; }
        const unsigned old = xb_add(&bar[XB_XSUB(b.x)], 1u);
        const unsigned gen = old / nloc;
        if (old + 1u == (gen + 1u) * nloc) {
            __builtin_amdgcn_fence(__ATOMIC_RELEASE, "agent");
            asm volatile("s_waitcnt vmcnt(0)" ::: "memory");
            const unsigned og = xb_add(&bar[XB_TOP], 1u);
            const unsigned tg = og / nx;
            if (og + 1u == (tg + 1u) * nx) xb_add(&bar[XB_TOPGEN], 1u);
            else XB_SPIN(xb_ld(&bar[XB_TOPGEN]) == tg, bar);
            __builtin_amdgcn_fence(__ATOMIC_ACQUIRE, "agent");
            xb_add(&bar[XB_XGEN(b.x)], 1u);
            asm volatile("s_waitcnt vmcnt(0)" ::: "memory");
        } else {
            XB_SPIN(xb_ld(&bar[XB_XGEN(b.x)]) == gen, bar);
            __builtin_amdgcn_fence(__ATOMIC_ACQUIRE, "agent");
            asm volatile("s_waitcnt vmcnt(0)" ::: "memory");
        }
    }
    __syncthreads();
}

__global__ void __launch_bounds__(512, 2) mk_fwd(Args args) {
    extern __shared__ __attribute__((aligned(16))) unsigned char lds[];
    const int wvs = __builtin_amdgcn_readfirstlane((int)threadIdx.x >> 6);
    if (threadIdx.x < 8) ((LAS unsigned*)((LAS unsigned char*)lds + 131072))[threadIdx.x] = 0u;
    __syncthreads();
    const XcdBarrier xbar = xcd_barrier_post((unsigned*)(args.ws + A_CTL), (volatile LAS unsigned*)((LAS unsigned char*)lds + 131072), threadIdx.x == 0);
    const int lo = args.ph_lo, hi = args.ph_hi;
#if MK_PER_PHASE
#define SEAM(k) do { } while (0)
#else
#define SEAM(k) do { if (lo <= (k) && (k) + 1 < hi) { if ((k) == 0) cg::this_grid().sync(); else { xcd_barrier(xbar, wvs); } } } while (0)
#endif
#define IN(k) (lo <= (k) && (k) < hi)
#define PH_VARS size_t zoff_ = 0; asm volatile("" : "+s"(zoff_)); unsigned char* ws = args.ws + zoff_; float* out = args.out + zoff_; \
    LAS unsigned char* ldsl = (LAS unsigned char*)lds; const int bid = blockIdx.x, G = gridDim.x; \
    bf16_t* XB = (bf16_t*)(ws + A_XB); float* SSQ = (float*)(ws + A_SSQ); bf16_t* ACT = (bf16_t*)(ws + R_ACT); bf16_t* MIX = (bf16_t*)(ws + R_MIX); float* Y = out + OUT_Y; \
    (void)XB; (void)SSQ; (void)ACT; (void)MIX; (void)Y; (void)ldsl; (void)bid; (void)G;
#define PH_TID int tid_; asm volatile("v_mbcnt_lo_u32_b32 %0, -1, 0\n\tv_mbcnt_hi_u32_b32 %0, -1, %0" : "=v"(tid_)); tid_ += wvs * 64; const int lane = tid_ & 63, wave = tid_ >> 6; (void)lane; (void)wave;

    if (IN(0)) for (int rep_ = 0; rep_ < (REP_PH == 0 ? 2 : 1); ++rep_) { PH_VARS prologue(args, ldsl, G, wvs); } SEAM(0);

#define HOST_ITEMS(set, nset, first_idle) do { if (G == 256 && bid >= (first_idle)) { PH_TID \
        for (int idx = (bid - (first_idle)) * 8 + wave; idx < (nset); idx += (256 - (first_idle)) * 8) weight_item(args, ws, item_of((set), idx), (LAS float*)(ldsl + wave * 16384), lane); } } while (0)
#define FFN_UP(ph, widx) if (IN(ph)) for (int rep_ = 0; rep_ < (REP_PH == (ph) ? 2 : 1); ++rep_) { PH_VARS pg8::Gemm g{XB, (const bf16_t*)(ws + W_GU0 + (size_t)(widx) * SZ_GU), M, 5632, 1024}; pg8::StaticOrder S; S.init(M, 5632, G, bid); \
        EpiGU E{SSQ, ACT}; pg8::gemm_phase<EpiGU, pg8::StaticOrder, true, true>(ldsl, g, S, E, wvs); \
        if ((ph) == 1) HOST_ITEMS(1, NIT_B1, 88); if ((ph) == 7) HOST_ITEMS(3, NIT_B3, 88); } SEAM(ph);
#define FFN_DN(ph, widx, x0, x1) if (IN(ph)) for (int rep_ = 0; rep_ < (REP_PH == (ph) ? 2 : 1); ++rep_) { PH_VARS \
        EpiRes E{x0, x1, Y, XB, SSQ, 0.5f}; res_gemm(wvs, ldsl, ACT, (const bf16_t*)(ws + W_DN0 + (size_t)(widx) * SZ_DN), FF, 256, E, (float*)(ws + R_PART), (unsigned*)(ws + A_CTL) + 8 + (ph), G, bid); } SEAM(ph);
#define MIX_OUT(ph, woff) if (IN(ph)) { PH_VARS \
        EpiRes E{Y, Y + (size_t)MP * D, Y, XB, SSQ, 1.0f}; res_gemm(wvs, ldsl, MIX, (const bf16_t*)(ws + (woff)), 1024, 256, E, (float*)(ws + R_PART), (unsigned*)(ws + A_CTL) + 8 + (ph), G, bid); } SEAM(ph);

    FFN_UP(1, 0)
    FFN_DN(2, 0, gp(args.in[0]), gp(args.in[1]))
    if (IN(3)) { PH_VARS pg8::Gemm g{XB, (const bf16_t*)(ws + W_AB), M, 2560, 1024}; pg8::StaticOrder S; S.init(M, 2560, G, bid);
        EpiAB E{SSQ, (const float*)(ws + T_LB), (bf16_t*)(ws + R_QT), (bf16_t*)(ws + R_KH), (bf16_t*)(ws + R_KTT), (bf16_t*)(ws + R_VTT), (bf16_t*)(ws + R_GB), (bf16_t*)(ws + R_UB), (float*)(ws + R_LDEC)};
        pg8::gemm_phase<EpiAB, pg8::StaticOrder, true, true>(ldsl, g, S, E, wvs); HOST_ITEMS(2, NIT_B2, 40); } SEAM(3);
    if (IN(4)) for (int rep_ = 0; rep_ < (REP_PH == 4 ? 2 : 1); ++rep_) { PH_VARS PH_TID
        for (int task = bid; task < 256; task += G) {
            if (task < 128) {
                { const int b = task >> 2, h = task & 3; hgrn_task(wvs, ws, lds, MP + b * 32, 2, gp(args.in[2]) + (size_t)(b * 4 + h) * 16384, out + OUT_HGRN_S + (size_t)(b * 4 + h) * 16384, h); }
                { const int id = task * 8 + wave, b = id >> 5, g = id & 31; s5_task(wvs, ws, lds + wave * 16384, gp(args.in[26]), MP + b * 32, 2, gp(args.in[3]) + (size_t)(b * 32 + g) * 64, gp(args.in[4]) + (size_t)(b * 32 + g) * 64,
                          out + OUT_S5RE_S + (size_t)(b * 32 + g) * 64, out + OUT_S5IM_S + (size_t)(b * 32 + g) * 64, g); }
                __syncthreads();
            } else if (task < 192) {
                const int i = task - 128, b = i >> 2, h = i & 3; for (int r2 = 0; r2 < (REP_PH == 40 ? 2 : 1); ++r2) hgrn_prompt(wvs, ws, lds, b * 2048, out + OUT_HGRN_P + (size_t)(b * 4 + h) * 16384, h);
            } else {
                if (wave < 4) { const int id = (task - 192) * 4 + wave, b = id >> 5, g = id & 31; for (int r2 = 0; r2 < (REP_PH == 41 ? 2 : 1); ++r2) s5_task(wvs, ws, lds + wave * 16384, gp(args.in[26]), b * 2048, 128, nullptr, nullptr, out + OUT_S5RE_P + (size_t)(b * 32 + g) * 64, out + OUT_S5IM_P + (size_t)(b * 32 + g) * 64, g); }
                __syncthreads();
            }
            if (task < 64 && G == 256) {
                if (wave < 4) { const int id = 256 + task * 4 + wave, b = id >> 5, g = id & 31; s5_task(wvs, ws, lds + wave * 16384, gp(args.in[26]), b * 2048, 128, nullptr, nullptr, out + OUT_S5RE_P + (size_t)(b * 32 + g) * 64, out + OUT_S5IM_P + (size_t)(b * 32 + g) * 64, g); }
                __syncthreads();
            }
        }
        if (G != 256) {
            for (int t2 = bid; t2 < 64; t2 += G) { if (wave < 4) { const int id = 256 + t2 * 4 + wave, b = id >> 5, g = id & 31; s5_task(wvs, ws, lds + wave * 16384, gp(args.in[26]), b * 2048, 128, nullptr, nullptr, out + OUT_S5RE_P + (size_t)(b * 32 + g) * 64, out + OUT_S5IM_P + (size_t)(b * 32 + g) * 64, g); } __syncthreads(); }
        }
    } SEAM(4);
    if (IN(5)) { PH_VARS
        { pg8::Gemm g{(const bf16_t*)(ws + R_ZB), (const bf16_t*)(ws + W_GLU), M, 512, 512}; pg8::StaticOrder S; S.init(M, 512, G, bid);
          EpiGLU E{(const bf16_t*)(ws + R_ZB), gp(args.in[28]), MIX}; pg8::gemm_phase<EpiGLU, pg8::StaticOrder, true, true>(ldsl, g, S, E, wvs); }
        PH_TID
        const bf16_t* OB = (const bf16_t*)(ws + R_OB); const bf16_t* GB = (const bf16_t*)(ws + R_GB);
        const f32x4 og0 = *(const f32x4*)(gp(args.in[18]) + (lane & 15) * 8), og1 = *(const f32x4*)(gp(args.in[18]) + (lane & 15) * 8 + 4);
        const int nx5 = (264 > G && 264 - G < G / 2) ? 264 - G : 0;
        for (int row = (bid - nx5) * 8 + wave; row < M; row += (G - nx5) * 8) { if (bid < nx5) break;
            const u32x4 ov = *(const u32x4*)(OB + (size_t)row * 512 + lane * 8), gv = *(const u32x4*)(GB + (size_t)row * 512 + lane * 8);
            f32x4 a0, a1, g0, g1;
            a0.x = __uint_as_float(ov.x << 16); a0.y = __uint_as_float(ov.x & 0xffff0000u); a0.z = __uint_as_float(ov.y << 16); a0.w = __uint_as_float(ov.y & 0xffff0000u);
            a1.x = __uint_as_float(ov.z << 16); a1.y = __uint_as_float(ov.z & 0xffff0000u); a1.z = __uint_as_float(ov.w << 16); a1.w = __uint_as_float(ov.w & 0xffff0000u);
            g0.x = __uint_as_float(gv.x << 16); g0.y = __uint_as_float(gv.x & 0xffff0000u); g0.z = __uint_as_float(gv.y << 16); g0.w = __uint_as_float(gv.y & 0xffff0000u);
            g1.x = __uint_as_float(gv.z << 16); g1.y = __uint_as_float(gv.z & 0xffff0000u); g1.z = __uint_as_float(gv.w << 16); g1.w = __uint_as_float(gv.w & 0xffff0000u);
            float ss = sum4(a0 * a0) + sum4(a1 * a1);
            ss += __shfl_xor(ss, 1); ss += __shfl_xor(ss, 2); ss += __shfl_xor(ss, 4); ss += __shfl_xor(ss, 8);
            const float rs = rsqrtf(ss * (1.f / 128.f) + EPS);
            const f32x4 r0 = a0 * rs * og0 * g0, r1 = a1 * rs * og1 * g1;
            u32x4 w4; w4.x = cvt_pk_bf16(r0.x, r0.y); w4.y = cvt_pk_bf16(r0.z, r0.w); w4.z = cvt_pk_bf16(r1.x, r1.y); w4.w = cvt_pk_bf16(r1.z, r1.w);
            *(u32x4*)(MIX + (size_t)row * 1024 + lane * 8) = w4;
        }
    } SEAM(5);
    MIX_OUT(6, W_ABO)
    FFN_UP(7, 1)
    FFN_DN(8, 1, Y, Y + (size_t)MP * D)
    FFN_UP(9, 2)
    FFN_DN(10, 2, Y, Y + (size_t)MP * D)
    if (IN(11)) { PH_VARS pg8::Gemm g{XB, (const bf16_t*)(ws + W_CD), M, 1536, 1024}; pg8::StaticOrder S; S.init(M, 1536, G, bid);
        EpiCD E{SSQ, gp(args.in[31]), gp(args.in[36]), (const f32x2*)(ws + T_ROPE), MIX, (bf16_t*)(ws + R_VG), (float*)(ws + A_SSV), (bf16_t*)(ws + R_CQB), (float*)(ws + A_SSCQ), (bf16_t*)(ws + R_CKVG), (float*)(ws + A_SSCKV), (float*)(ws + R_KPEB), (float*)(ws + A_SSK), out};
        pg8::gemm_phase<EpiCD, pg8::StaticOrder, true, true>(ldsl, g, S, E, wvs);
        PH_TID
        bf16_t* CKVG = (bf16_t*)(ws + R_CKVG); float* KPEB = (float*)(ws + R_KPEB); float* SSK = (float*)(ws + A_SSK);
        const int nx11 = (792 % G != 0 && 792 % G < G / 2) ? 792 % G : 0;
        for (int r = (bid - nx11) * 8 + wave; r < 32 * 1024; r += (G - nx11) * 8) { if (bid < nx11) break; const int b = r >> 10, j = r & 1023, kvr = MP + b * 1056 + j;
            const f32x2 c2 = *(const f32x2*)(gp(args.in[5]) + (size_t)r * 128 + lane * 2); ((unsigned*)(CKVG + (size_t)kvr * 128))[lane] = cvt_pk_bf16(c2.x, c2.y);
            float kv = 0.f; if (lane < 32) { kv = gp(args.in[6])[(size_t)r * 32 + lane]; KPEB[(size_t)kvr * 32 + lane] = kv; }
            float ss = kv * kv;
#pragma unroll
            for (int o = 1; o < 64; o <<= 1) ss += __shfl_xor(ss, o);
            if (lane == 0) SSK[kvr] = ss; }
    } SEAM(11);
    if (IN(12)) { PH_VARS
        { pg8::Gemm g{(const bf16_t*)(ws + R_CQB), (const bf16_t*)(ws + W_UQ), M, 768, 256}; pg8::StaticOrder S; S.init(M, 768, G, bid);
          EpiQ E{(const float*)(ws + A_SSCQ), gp(args.in[38]), (const f32x2*)(ws + T_ROPE), (bf16_t*)(ws + R_QF), (float*)(ws + A_SSQN), (float*)(ws + A_SSQR)};
          pg8::gemm_phase<EpiQ, pg8::StaticOrder, true, true>(ldsl, g, S, E, wvs); }
        { pg8::Gemm g{(const bf16_t*)(ws + R_CKVG), (const bf16_t*)(ws + W_UKV), KVR, 1024, 128}; const int nq2 = (396 > G && 396 - G < G) ? 396 - G : 0;
          pg8::StaticOrder S; S.init(KVR, 1024, G, (bid + G - nq2) % G);
          EpiKV E{(const float*)(ws + A_SSCKV), (const float*)(ws + A_SSK), (const float*)(ws + R_KPEB), gp(args.in[39]), (bf16_t*)(ws + R_KF), (bf16_t*)(ws + R_VT)};
          pg8::gemm_phase<EpiKV, pg8::StaticOrder, true, true>(ldsl, g, S, E, wvs); }
        PH_TID
        const float* SSCKV = (const float*)(ws + A_SSCKV);
        const int nx12 = (396 > G && 396 - G < G && (396 - G) % 8 == 0 && G - (396 - G) >= 32) ? 396 - G + 16 : 0;
        for (int row = (bid - nx12) * 8 + wave; row < M; row += (G - nx12) * 8) { if (bid < nx12) break; const float rs = rsqrtf(sum4(*(const f32x4*)(SSCKV + (size_t)row * 4)) * (1.f / 128.f) + EPS);
            float* p = row < MP ? out + OUT_CKV_P + (size_t)row * 128 : out + OUT_CKV_S + (size_t)(row - MP) * 128; f32x2 v = *(f32x2*)(p + lane * 2); v.x *= rs; v.y *= rs; *(f32x2*)(p + lane * 2) = v; }
    } SEAM(12);
    if (IN(13)) { PH_VARS PH_TID
        for (int un = bid; un < 1024 + 128; un += G) {
            if (un < 1024) { const int gg = un & 3, ch = (un >> 2) & 15, b = un >> 6; spatial_unit(wvs, args, lds, b * 2048 + ch * 128, 128, gg, ch == 15 ? out + OUT_GV_P + (size_t)b * 128 * 512 : nullptr); }
            else { const int i = un - 1024, gg = i & 3, b = i >> 2; spatial_unit(wvs, args, lds, MP + b * 32, 32, gg, out + OUT_GV_S + (size_t)b * 32 * 512); }
        }
        const int gw = bid * 8 + wave, NGW = G * 8;
        for (int rep_ = 0; rep_ < (REP_PH == 13 ? 2 : 1); ++rep_) {
        if ((G & 7) == 0) { const int x = bid & 7, y = bid >> 3, PW = G >> 3;
            for (int slot = y; slot < 64; slot += PW) { const int combo = x * 16 + (slot >> 2), qbl = slot & 3, b = combo >> 3, head = combo & 7;
                attn_unit2(wvs, ws, lds, b, head, qbl); attn_unit2(wvs, ws, lds, b, head, 7 - qbl); } }
        else { for (int pu = bid; pu < 512; pu += G) { const int qbl = pu & 3, head = (pu >> 2) & 7, b = pu >> 5; attn_unit2(wvs, ws, lds, b, head, qbl); attn_unit2(wvs, ws, lds, b, head, 7 - qbl); } }
        for (int r3 = 0; r3 < (REP_PH == 14 ? 2 : 1); ++r3) for (int t = bid; t < 256; t += G) attn_sample(wvs, ws, lds, t >> 3, t & 7);
        }
    } SEAM(13);
    MIX_OUT(14, W_CDO)
    FFN_UP(15, 3)
    FFN_DN(16, 3, Y, Y + (size_t)MP * D)
}

extern "C" void kernel_launch(void* const* d_in, const int* in_sizes, int n_in, void* d_out, int out_size, void* d_ws, size_t ws_size, hipStream_t stream) {
    static int grid = 0;
    if (grid == 0) {
        if (n_in != 41 || (size_t)out_size != OUT_TOTAL || ws_size < WS_END) { fprintf(stderr, "kernel_launch: unexpected shapes: n_in %d out %d ws %zu (need %zu)\n", n_in, out_size, ws_size, (size_t)WS_END); grid = -1; return; }
        int dev = 0, cus = 0, per_cu = 0;
        hipGetDevice(&dev); hipDeviceGetAttribute(&cus, hipDeviceAttributeMultiprocessorCount, dev);
        hipFuncSetAttribute((const void*)mk_fwd, hipFuncAttributeMaxDynamicSharedMemorySize, LDS_BYTES);
        hipOccupancyMaxActiveBlocksPerMultiprocessor(&per_cu, (const void*)mk_fwd, 512, LDS_BYTES);
        if (per_cu < 1) { fprintf(stderr, "kernel_launch: occupancy query says %d blocks per CU\n", per_cu); per_cu = 1; }
        (void)hipGetLastError();
        grid = cus * 1;
    }
    if (grid < 0) return;
    Args a{};
    for (int i = 0; i < 41; ++i) a.in[i] = (const float*)d_in[i];
    a.out = (float*)d_out; a.ws = (unsigned char*)d_ws;
#if MK_PER_PHASE
    for (int ph = 0; ph < NPH; ++ph) { a.ph_lo = ph; a.ph_hi = ph + 1; hipLaunchKernelGGL(mk_fwd, dim3(grid), dim3(512), LDS_BYTES, stream, a); }
#else
    a.ph_lo = 0; a.ph_hi = NPH;
    hipMemsetAsync((unsigned char*)d_ws + A_CTL, 0, 16384, stream);
    void* kargs[] = {&a};
    hipError_t e = hipLaunchCooperativeKernel((const void*)mk_fwd, dim3(grid), dim3(512), kargs, LDS_BYTES, stream);
    if (e != hipSuccess) fprintf(stderr, "kernel_launch: cooperative launch failed: %s (grid %d)\n", hipGetErrorString(e), grid);
#endif
}
```
